# Optimizing an MI355X kernel written in HIP

```python
import math
import jax, jax.numpy as jnp
from jax import lax
import numpy as np

D_MODEL = 1024
BATCH = 4
SEQ = 4096
DEPTH = 1
DEC_BATCH = 128
DEC_SEQ = 4
PAST_LEN = 2048
PAGE_SIZE = 128

HEAD_DIM = 64
MIX_W = D_MODEL
RW_W = MIX_W // 2
ATT_W = MIX_W - RW_W
RW_HEADS = RW_W // HEAD_DIM
ATT_HEADS = ATT_W // HEAD_DIM
IDX_HEADS = 4
IDX_DIM = 64
MAX_TOPK = 256
Q_BLOCK = 128
W_LORA = 64
A_LORA = 64
G_LORA = 128
GN_EPS = 64e-5
LN_EPS = 1e-5
D_FF = 11 * D_MODEL // 4
CONV_W = 3
NUM_BUCKETS = 32
MAX_DISTANCE = 128
DEEPNORM_ALPHA = (2 * DEPTH) ** 0.25
DEEPNORM_BETA = (8 * DEPTH) ** -0.25
SHIFT_COLS = 3 * RW_W + W_LORA + A_LORA + G_LORA
ATT_COLS = 3 * ATT_W + IDX_HEADS * IDX_DIM + IDX_DIM + IDX_HEADS
IN_COLS = SHIFT_COLS + ATT_COLS

kernel_name = 'rwkv7_dsa_hybrid_step'


def layer_norm(x, g, b):
    xf = x.astype(jnp.float32)
    mu = jnp.mean(xf, axis=-1, keepdims=True)
    var = jnp.mean(jnp.square(xf - mu), axis=-1, keepdims=True)
    return ((xf - mu) * lax.rsqrt(var + LN_EPS) * g + b).astype(x.dtype)


def t5_bucket(dist):
    n = jnp.maximum(dist, 0)
    max_exact = NUM_BUCKETS // 2
    nf = jnp.maximum(n, 1).astype(jnp.float32)
    large = max_exact + (jnp.log(nf / max_exact) / math.log(MAX_DISTANCE / max_exact)
                         * (NUM_BUCKETS - max_exact)).astype(jnp.int32)
    large = jnp.minimum(large, NUM_BUCKETS - 1)
    return jnp.where(n < max_exact, n, large)


def rwkv7_group(p, w0, w_up, a0, a_up, g_up, k_k, k_a, r_k, gn_g, gn_b, wkv0):
    B, T, _ = p.shape
    r = p[..., :RW_W]
    k = p[..., RW_W:2 * RW_W]
    v = p[..., 2 * RW_W:3 * RW_W]
    o = 3 * RW_W
    wd = p[..., o:o + W_LORA]
    o += W_LORA
    ad = p[..., o:o + A_LORA]
    o += A_LORA
    gd = p[..., o:o + G_LORA]
    w_log = -jax.nn.softplus(-(w0 + jnp.tanh(wd) @ w_up)) - 0.5
    decay = jnp.exp(-jnp.exp(w_log.astype(jnp.float32)))
    a = jax.nn.sigmoid(a0 + ad @ a_up)
    g = jax.nn.sigmoid(gd) @ g_up
    heads = lambda t: t.reshape(B, T, RW_HEADS, HEAD_DIM).astype(jnp.float32)
    kk = heads(k * k_k)
    kk = kk * lax.rsqrt(jnp.maximum(jnp.sum(kk * kk, axis=-1, keepdims=True), 1e-24))
    k = heads(k * (1 + (a - 1) * k_a))
    r, v, a, decay = heads(r), heads(v), heads(a), heads(decay)

    def step(S, inp):
        r_t, w_t, k_t, v_t, kk_t, a_t = inp
        sa = jnp.einsum('bhij,bhj->bhi', S, -kk_t)
        S = (S * w_t[:, :, None, :] + sa[..., None] * (kk_t * a_t)[:, :, None, :]
             + v_t[..., None] * k_t[:, :, None, :])
        return S, jnp.einsum('bhij,bhj->bhi', S, r_t)

    xs = tuple(jnp.moveaxis(t, 1, 0) for t in (r, decay, k, v, kk, a))
    S_fin, y = lax.scan(step, wkv0.astype(jnp.float32), xs)
    y = jnp.moveaxis(y, 0, 1)
    mu = jnp.mean(y, axis=-1, keepdims=True)
    var = jnp.mean(jnp.square(y - mu), axis=-1, keepdims=True)
    yn = ((y - mu) * lax.rsqrt(var + GN_EPS)).reshape(B, T, RW_W) * gn_g + gn_b
    bonus = (jnp.sum(r * k * r_k, axis=-1, keepdims=True) * v).reshape(B, T, RW_W)
    out = (yn + bonus) * g
    return out.astype(p.dtype), S_fin.astype(p.dtype)


def dsa_attend(q, qi, wi, q_pos, k_all, v_all, ki_all, rel_bias, topk):
    L = k_all.shape[1]
    scores = jnp.einsum('bthd,bsd->bths', qi, ki_all) * IDX_DIM ** -0.5
    index = jnp.einsum('bth,bths->bts', wi, jax.nn.relu(scores)).astype(jnp.float32)
    visible = jnp.arange(L, dtype=jnp.int32)[None, :] <= q_pos[:, None]
    index = jnp.where(visible[None], index, -jnp.inf)
    _, sel = lax.top_k(index, topk)
    gather = jax.vmap(lambda rows, ids: rows[ids])
    k_sel = gather(k_all, sel)
    v_sel = gather(v_all, sel)
    dist = q_pos[None, :, None] - sel
    bias = jnp.moveaxis(rel_bias[t5_bucket(dist)], -1, 2).astype(jnp.float32)
    logits = jnp.einsum('bthd,btkhd->bthk', q, k_sel).astype(jnp.float32) * HEAD_DIM ** -0.5 + bias
    logits = jnp.where((dist >= 0)[:, :, None, :], logits, -jnp.inf)
    p = jax.nn.softmax(logits, axis=-1).astype(v_all.dtype)
    return jnp.einsum('bthk,btkhd->bthd', p, v_sel)


def attention_group(q, k, v, qi, ki, wi, past_k, past_v, past_ki, rel_bias):
    B, T = q.shape[0], q.shape[1]
    if past_k is None:
        k_all, v_all, ki_all = k, v, ki
        past_len = 0
    else:
        k_all = jnp.concatenate([past_k.astype(k.dtype), k], axis=1)
        v_all = jnp.concatenate([past_v.astype(v.dtype), v], axis=1)
        ki_all = jnp.concatenate([past_ki.astype(ki.dtype), ki], axis=1)
        past_len = past_k.shape[1]
    topk = min(MAX_TOPK, (past_len + T) // 4)
    q_pos = past_len + jnp.arange(T, dtype=jnp.int32)

    def attend(args):
        qb, qib, wib, pb = args
        return dsa_attend(qb, qib, wib, pb, k_all, v_all, ki_all, rel_bias, topk)

    if T > Q_BLOCK:
        nb = T // Q_BLOCK
        blocks = lambda t: jnp.moveaxis(t.reshape((B, nb, Q_BLOCK) + t.shape[2:]), 1, 0)
        out = lax.map(attend, (blocks(q), blocks(qi), blocks(wi), q_pos.reshape(nb, Q_BLOCK)))
        out = jnp.moveaxis(out, 0, 1)
    else:
        out = attend((q, qi, wi, q_pos))
    return out.reshape(B, T, ATT_W)


def decoder_layer(x, shift_prev, wkv_prev, conv_prev, past_k, past_v, past_ki, rel_bias,
                  w_in, shift_mu, rw_w0, rw_w_up, rw_a0, rw_a_up, rw_g_up, rw_k_k, rw_k_a, rw_r_k,
                  rw_gn_g, rw_gn_b, w_out, ln1_g, ln1_b, ffn_w_up, ffn_conv_w, ffn_conv_b,
                  ffn_w_down, ln2_g, ln2_b):
    B, T, _ = x.shape
    proj = x @ w_in
    p_rw = proj[..., :SHIFT_COLS]
    padded = jnp.concatenate([shift_prev.astype(proj.dtype), p_rw], axis=1)
    p_shift = p_rw + (padded[:, :-1] - p_rw) * shift_mu
    new_shift = padded[:, -1:]
    rw_out, new_wkv = rwkv7_group(p_shift, rw_w0, rw_w_up, rw_a0, rw_a_up, rw_g_up, rw_k_k, rw_k_a,
                                  rw_r_k, rw_gn_g, rw_gn_b, wkv_prev)
    o = SHIFT_COLS
    q = proj[..., o:o + ATT_W].reshape(B, T, ATT_HEADS, HEAD_DIM)
    o += ATT_W
    k = proj[..., o:o + ATT_W].reshape(B, T, ATT_HEADS, HEAD_DIM)
    o += ATT_W
    v = proj[..., o:o + ATT_W].reshape(B, T, ATT_HEADS, HEAD_DIM)
    o += ATT_W
    qi = proj[..., o:o + IDX_HEADS * IDX_DIM].reshape(B, T, IDX_HEADS, IDX_DIM)
    o += IDX_HEADS * IDX_DIM
    ki = proj[..., o:o + IDX_DIM]
    o += IDX_DIM
    wi = proj[..., o:o + IDX_HEADS] * IDX_HEADS ** -0.5
    att_out = attention_group(q, k, v, qi, ki, wi, past_k, past_v, past_ki, rel_bias)
    mix = jnp.concatenate([rw_out, att_out], axis=-1) @ w_out
    x = layer_norm(DEEPNORM_ALPHA * x + mix, ln1_g, ln1_b)
    up = x @ ffn_w_up
    u_conv, u_lin = up[..., :D_FF], up[..., D_FF:]
    padded = jnp.concatenate([conv_prev.astype(up.dtype), u_conv], axis=1)
    conv = sum(padded[:, j:j + T] * ffn_conv_w[j] for j in range(CONV_W)) + ffn_conv_b
    h = jax.nn.silu(conv) * u_lin
    x = layer_norm(DEEPNORM_ALPHA * x + h @ ffn_w_down, ln2_g, ln2_b)
    new_conv = padded[:, T:]
    return x, (k, v, ki, new_wkv, new_shift, new_conv)


def setup_inputs(seed: int = 0) -> dict:
    key = jax.random.key(seed)
    ks = jax.random.split(key, 40)
    f32 = jnp.float32
    nrm = lambda i, shape, s=1.0: jax.random.normal(ks[i], shape, f32) * s
    n_pages = PAST_LEN // PAGE_SIZE
    n_used = DEC_BATCH * n_pages
    n_pool = n_used + max(1, n_used // 4)
    page_table = jax.random.permutation(ks[0], n_pool)[:n_used].reshape(DEC_BATCH, n_pages).astype(jnp.int32)
    return {
        'x_prompt': nrm(1, (BATCH, SEQ, D_MODEL)),
        'x_sample': nrm(2, (DEC_BATCH, DEC_SEQ, D_MODEL)),
        'cache_k': nrm(3, (DEPTH, n_pool, PAGE_SIZE, ATT_HEADS, HEAD_DIM)),
        'cache_v': nrm(4, (DEPTH, n_pool, PAGE_SIZE, ATT_HEADS, HEAD_DIM)),
        'cache_kidx': nrm(5, (DEPTH, n_pool, PAGE_SIZE, IDX_DIM)),
        'page_table': page_table,
        'state_wkv': nrm(6, (DEPTH, DEC_BATCH, RW_HEADS, HEAD_DIM, HEAD_DIM), 0.5),
        'state_shift': nrm(7, (DEPTH, DEC_BATCH, 1, SHIFT_COLS)),
        'state_conv': nrm(8, (DEPTH, DEC_BATCH, CONV_W - 1, D_FF)),
        'rel_bias': nrm(9, (NUM_BUCKETS, ATT_HEADS), 0.5),
        'w_in': nrm(10, (DEPTH, D_MODEL, IN_COLS), D_MODEL ** -0.5),
        'shift_mu': jax.random.uniform(ks[11], (DEPTH, SHIFT_COLS), f32),
        'rw_w0': jax.random.uniform(ks[12], (DEPTH, RW_W), f32, -4.0, 2.0),
        'rw_w_up': nrm(13, (DEPTH, W_LORA, RW_W), 0.5 * W_LORA ** -0.5),
        'rw_a0': nrm(14, (DEPTH, RW_W), 0.5),
        'rw_a_up': nrm(15, (DEPTH, A_LORA, RW_W), A_LORA ** -0.5),
        'rw_g_up': nrm(16, (DEPTH, G_LORA, RW_W), G_LORA ** -0.5),
        'rw_k_k': 0.85 + nrm(17, (DEPTH, RW_W), 0.05),
        'rw_k_a': 1.0 + nrm(18, (DEPTH, RW_W), 0.05),
        'rw_r_k': nrm(19, (DEPTH, RW_HEADS, HEAD_DIM), 0.1),
        'rw_gn_g': 1.0 + nrm(20, (DEPTH, RW_W), 0.05),
        'rw_gn_b': nrm(21, (DEPTH, RW_W), 0.02),
        'w_out': nrm(22, (DEPTH, MIX_W, D_MODEL), DEEPNORM_BETA * MIX_W ** -0.5),
        'ln1_g': 1.0 + nrm(23, (DEPTH, D_MODEL), 0.05),
        'ln1_b': nrm(24, (DEPTH, D_MODEL), 0.02),
        'ffn_w_up': nrm(25, (DEPTH, D_MODEL, 2 * D_FF), D_MODEL ** -0.5),
        'ffn_conv_w': nrm(26, (DEPTH, CONV_W, D_FF), CONV_W ** -0.5),
        'ffn_conv_b': nrm(27, (DEPTH, D_FF), 0.02),
        'ffn_w_down': nrm(28, (DEPTH, D_FF, D_MODEL), DEEPNORM_BETA * D_FF ** -0.5),
        'ln2_g': 1.0 + nrm(29, (DEPTH, D_MODEL), 0.05),
        'ln2_b': nrm(30, (DEPTH, D_MODEL), 0.02),
    }


def reference(x_prompt, x_sample, cache_k, cache_v, cache_kidx, page_table, state_wkv, state_shift,
              state_conv, rel_bias, w_in, shift_mu, rw_w0, rw_w_up, rw_a0, rw_a_up, rw_g_up, rw_k_k,
              rw_k_a, rw_r_k, rw_gn_g, rw_gn_b, w_out, ln1_g, ln1_b, ffn_w_up, ffn_conv_w, ffn_conv_b,
              ffn_w_down, ln2_g, ln2_b):
    n_pages = page_table.shape[1]
    past_len = n_pages * PAGE_SIZE

    def from_pages(pool):
        g = pool[page_table]
        return g.reshape((g.shape[0], past_len) + g.shape[3:])

    yp, ys = x_prompt, x_sample
    bp = x_prompt.shape[0]
    outs_p, outs_s = [], []
    for l in range(DEPTH):
        lw = (w_in[l], shift_mu[l], rw_w0[l], rw_w_up[l], rw_a0[l], rw_a_up[l], rw_g_up[l], rw_k_k[l],
              rw_k_a[l], rw_r_k[l], rw_gn_g[l], rw_gn_b[l], w_out[l], ln1_g[l], ln1_b[l], ffn_w_up[l],
              ffn_conv_w[l], ffn_conv_b[l], ffn_w_down[l], ln2_g[l], ln2_b[l])
        yp, st_p = decoder_layer(
            yp, jnp.zeros((bp, 1, SHIFT_COLS), yp.dtype),
            jnp.zeros((bp, RW_HEADS, HEAD_DIM, HEAD_DIM), yp.dtype),
            jnp.zeros((bp, CONV_W - 1, D_FF), yp.dtype), None, None, None, rel_bias, *lw)
        ys, st_s = decoder_layer(
            ys, state_shift[l], state_wkv[l], state_conv[l], from_pages(cache_k[l]),
            from_pages(cache_v[l]), from_pages(cache_kidx[l]), rel_bias, *lw)
        outs_p.append(st_p)
        outs_s.append(st_s)
    st = lambda outs, i: jnp.stack([o[i] for o in outs])
    return (yp, ys, st(outs_p, 0), st(outs_p, 1), st(outs_p, 2), st(outs_p, 3), st(outs_p, 4), st(outs_p, 5),
            st(outs_s, 0), st(outs_s, 1), st(outs_s, 2), st(outs_s, 3), st(outs_s, 4), st(outs_s, 5))
```

```cpp
#include <hip/hip_runtime.h>
#include <cstdio>
#include <cstdint>
namespace pg8 {
#define PG8_LAS __attribute__((address_space(3)))
typedef unsigned short bf16_t;
typedef short bf16x8 __attribute__((ext_vector_type(8)));
typedef float f32x4 __attribute__((ext_vector_type(4)));
typedef unsigned u32x4 __attribute__((ext_vector_type(4)));
constexpr int BM = 256, BK = 64, HALF = 128, HTB = HALF * BK * 2  , STAGE_BYTES = 8 * HTB, NXCD = 8, WGM = 8;

__host__ __device__ __forceinline__ int lds_byte(int r, int c) { const int st = (r >> 4) * 2 + (c >> 5), rr = r & 15, cc = c & 31, ob = rr * 64 + cc * 2; return st * 1024 + (ob ^ (((ob >> 9) & 1) << 5)); }
__host__ __device__ __forceinline__ void stage_rc(int b, int& R, int& C) { const int st = b / 1024, sb = b % 1024, swz = sb ^ (((sb >> 9) & 1) << 5); R = (st >> 1) * 16 + swz / 64; C = (st & 1) * 32 + (swz % 64) / 2; }
__host__ __device__ __forceinline__ int perm32(int rho) { const int n = rho >> 4, i = rho & 15; return 8 * (i >> 2) + 4 * n + (i & 3); }

struct Unit { int pm, pn; };
struct Gemm { const bf16_t* A; const bf16_t* Bt; int M, N, K; };

struct StaticOrder {
    int nM, nN, nwg, G, c;
    __host__ __device__ void init(int M, int N, int G_, int c_) { nM = M / BM; nN = N / BM; nwg = nM * nN; G = G_; c = c_; }
    __host__ __device__ bool next(int i, Unit& u) const {
        const long L = (long)i * G + c; if (L >= nwg) return false;
        int wgid = (int)L; { const int q = nwg / NXCD, r = nwg % NXCD, xcd = wgid % NXCD, off = wgid / NXCD; wgid = (xcd < r ? xcd * (q + 1) : r * (q + 1) + (xcd - r) * q) + off; }
        const int nig = WGM * nN, gid = wgid / nig, fm = gid * WGM, gsz = (nM - fm) < WGM ? (nM - fm) : WGM;
        u.pm = fm + ((wgid % nig) % gsz); u.pn = (wgid % nig) / gsz; return true;
    }
    __device__ __forceinline__ void a_ready(const Unit&) const {}
    __device__ __forceinline__ void done(const Unit&) const {}
};

__device__ __forceinline__ unsigned cvt_pk_bf16(float lo, float hi) { unsigned r; asm volatile("v_cvt_pk_bf16_f32 %0, %1, %2" : "=v"(r) : "v"(lo), "v"(hi)); return r; }
typedef float f32x2 __attribute__((ext_vector_type(2)));
template <class Epi, class Sched, bool ALIGN_EPI = false, bool SP2 = false>
__device__ __forceinline__ void gemm_phase(PG8_LAS unsigned char* lds, const Gemm g, const Sched& S, const Epi& E) {
    const int tid = threadIdx.x, wid = __builtin_amdgcn_readfirstlane(tid >> 6), lane = tid & 63, wr = wid >> 2, wc = wid & 3, fr = lane & 15, fq = lane >> 4;
    const int K = g.K, nt = K / BK;
    unsigned voffA[2], voffB[2];
#pragma unroll
    for (int i = 0; i < 2; ++i) { int R, C; stage_rc(tid * 16 + i * 8192, R, C); const int Rb = Epi::PERM ? ((R & ~31) + perm32(R & 31)) : R;
        voffA[i] = (unsigned)(R * K + C) * 2u; voffB[i] = (unsigned)(Rb * K + C) * 2u; }
    const size_t kstep = (size_t)(BK * 2);
    const size_t hstep = (size_t)HALF * K * 2;
    const size_t tstep = 2 * hstep;
    const unsigned ldsw = (unsigned)wid * 1024u;
    const int aoff = lds_byte(wr * 64 + fr, fq * 8), boff = lds_byte(wc * 32 + fr, fq * 8);
#define PG8_SA(b, h) (((b) * 2 + (h)) * HTB)
#define PG8_SB(b, h) ((4 + (b) * 2 + (h)) * HTB)
#define PG8_STAGE(bufoff, gbase, voff) do { _Pragma("unroll") for (int _i = 0; _i < 2; ++_i) \
        __builtin_amdgcn_global_load_lds((const unsigned*)((const char*)(gbase) + (voff)[_i]), (PG8_LAS unsigned*)(lds + (bufoff) + ldsw + _i * 8192), 16, 0, 0); } while (0)
#define PG8_LDA(dst, b, h) do { _Pragma("unroll") for (int m = 0; m < 4; ++m) _Pragma("unroll") for (int k = 0; k < 2; ++k) dst[m][k] = *(const PG8_LAS bf16x8*)(lds + PG8_SA(b, h) + aoff + m * 2048 + k * 1024); } while (0)
#define PG8_LDB(dst, b, h) do { _Pragma("unroll") for (int n = 0; n < 2; ++n) _Pragma("unroll") for (int k = 0; k < 2; ++k) dst[n][k] = *(const PG8_LAS bf16x8*)(lds + PG8_SB(b, h) + boff + n * 2048 + k * 1024); } while (0)
#define PG8_MMA(ai, bj, At, Bt) do { __builtin_amdgcn_s_setprio(1); _Pragma("unroll") for (int m = 0; m < 4; ++m) _Pragma("unroll") for (int n = 0; n < 2; ++n) _Pragma("unroll") for (int k = 0; k < 2; ++k) \
        acc[ai][bj][m][n] = __builtin_amdgcn_mfma_f32_16x16x32_bf16(Bt[n][k], At[m][k], acc[ai][bj][m][n], 0, 0, 0); __builtin_amdgcn_s_setprio(0); } while (0)
#define PG8_WAIT_V(n) asm volatile("s_waitcnt vmcnt(" #n ")" ::: "memory")
#define PG8_WAIT_L(n) asm volatile("s_waitcnt lgkmcnt(" #n ")" ::: "memory")
#define PG8_BAR __builtin_amdgcn_s_barrier()
#define PG8_SCHED __builtin_amdgcn_sched_barrier(0)
    Unit cur, nxt; int ui = 0;
    if (!S.next(0, cur)) return;
    f32x4 acc[2][2][4][2];
#pragma unroll
    for (int a = 0; a < 2; ++a)
#pragma unroll
        for (int b = 0; b < 2; ++b)
#pragma unroll
            for (int m = 0; m < 4; ++m)
#pragma unroll
                for (int n = 0; n < 2; ++n) acc[a][b][m][n] = (f32x4){0.f, 0.f, 0.f, 0.f};
    bf16x8 At[4][2], B0[2][2], B1[2][2];
    const char* cA = (const char*)g.A + (size_t)cur.pm * tstep; const char* cB = (const char*)g.Bt + (size_t)cur.pn * tstep;
    S.a_ready(cur);
    if constexpr (SP2) {
        PG8_STAGE(PG8_SB(0, 0), cB, voffB); PG8_STAGE(PG8_SB(0, 1), cB + hstep, voffB); PG8_STAGE(PG8_SA(0, 0), cA, voffA); PG8_STAGE(PG8_SA(0, 1), cA + hstep, voffA);
        if (wr == 1) PG8_BAR;
        PG8_WAIT_V(2); PG8_BAR;
        PG8_STAGE(PG8_SB(1, 0), cB + kstep, voffB); PG8_STAGE(PG8_SA(1, 0), cA + kstep, voffA); PG8_STAGE(PG8_SB(1, 1), cB + hstep + kstep, voffB);
        PG8_WAIT_V(6); PG8_BAR;
    } else {
        PG8_STAGE(PG8_SB(0, 0), cB, voffB); PG8_STAGE(PG8_SA(0, 0), cA, voffA); PG8_STAGE(PG8_SB(0, 1), cB + hstep, voffB); PG8_STAGE(PG8_SA(0, 1), cA + hstep, voffA);
        if (wr == 1) PG8_BAR;
        PG8_WAIT_V(4); PG8_BAR;
        PG8_STAGE(PG8_SB(1, 0), cB + kstep, voffB); PG8_STAGE(PG8_SA(1, 0), cA + kstep, voffA); PG8_STAGE(PG8_SB(1, 1), cB + hstep + kstep, voffB);
        PG8_WAIT_V(6); PG8_BAR;
    }
    for (;;) {
        const bool has_next = S.next(ui + 1, nxt);
        const char* nA = has_next ? (const char*)g.A + (size_t)nxt.pm * tstep : cA; const char* nB = has_next ? (const char*)g.Bt + (size_t)nxt.pn * tstep : cB;
        for (int t = 0; t < nt; t += 2) {
            const bool last = (t == nt - 2);
            const char* a1 = cA + (size_t)(t + 1) * kstep;
            const char* a2 = last ? nA : cA + (size_t)(t + 2) * kstep; const char* b2 = last ? nB : cB + (size_t)(t + 2) * kstep;
            const char* a3 = a2 + kstep; const char* b3 = b2 + kstep;
            if (last && has_next) S.a_ready(nxt);
            if constexpr (SP2) {
            PG8_LDB(B0, 0, 0); PG8_LDB(B1, 0, 1); PG8_SCHED; PG8_LDA(At, 0, 0); PG8_STAGE(PG8_SA(1, 1), a1 + hstep, voffA);
            PG8_WAIT_V(8); PG8_WAIT_L(0); PG8_BAR; PG8_MMA(0, 0, At, B0); PG8_MMA(0, 1, At, B1); PG8_BAR; PG8_SCHED;
            PG8_LDA(At, 0, 1); PG8_STAGE(PG8_SB(0, 0), b2, voffB); PG8_STAGE(PG8_SB(0, 1), b2 + hstep, voffB); PG8_STAGE(PG8_SA(0, 0), a2, voffA);
            PG8_WAIT_V(8); PG8_WAIT_L(0); PG8_BAR; PG8_MMA(1, 0, At, B0); PG8_MMA(1, 1, At, B1); PG8_BAR; PG8_SCHED;
            PG8_LDB(B0, 1, 0); PG8_LDB(B1, 1, 1); PG8_SCHED; PG8_LDA(At, 1, 0); PG8_STAGE(PG8_SA(0, 1), a2 + hstep, voffA);
            PG8_WAIT_V(8); PG8_WAIT_L(0); PG8_BAR; PG8_MMA(0, 0, At, B0); PG8_MMA(0, 1, At, B1); PG8_BAR; PG8_SCHED;
            PG8_LDA(At, 1, 1); PG8_STAGE(PG8_SB(1, 0), b3, voffB); PG8_STAGE(PG8_SB(1, 1), b3 + hstep, voffB); PG8_STAGE(PG8_SA(1, 0), a3, voffA);
            PG8_WAIT_V(8); PG8_WAIT_L(0); PG8_BAR; PG8_MMA(1, 0, At, B0); PG8_MMA(1, 1, At, B1); PG8_BAR; PG8_SCHED;
            } else {
            PG8_LDB(B0, 0, 0); PG8_SCHED; PG8_LDA(At, 0, 0); PG8_STAGE(PG8_SA(1, 1), a1 + hstep, voffA);
            PG8_WAIT_L(8); PG8_BAR; PG8_WAIT_L(0); PG8_MMA(0, 0, At, B0); PG8_BAR; PG8_SCHED;
            PG8_LDB(B1, 0, 1); PG8_STAGE(PG8_SB(0, 0), b2, voffB);
            PG8_BAR; PG8_WAIT_L(0); PG8_MMA(0, 1, At, B1); PG8_BAR;
            PG8_LDA(At, 0, 1); PG8_STAGE(PG8_SA(0, 0), a2, voffA);
            PG8_BAR; PG8_WAIT_L(0); PG8_MMA(1, 0, At, B0); PG8_BAR; PG8_SCHED;
            PG8_STAGE(PG8_SB(0, 1), b2 + hstep, voffB);
            PG8_WAIT_V(6); PG8_BAR; PG8_MMA(1, 1, At, B1); PG8_BAR;
            PG8_LDB(B0, 1, 0); PG8_SCHED; PG8_LDA(At, 1, 0); PG8_STAGE(PG8_SA(0, 1), a2 + hstep, voffA);
            PG8_WAIT_L(8); PG8_BAR; PG8_WAIT_L(0); PG8_MMA(0, 0, At, B0); PG8_BAR; PG8_SCHED;
            PG8_LDB(B1, 1, 1); PG8_STAGE(PG8_SB(1, 0), b3, voffB);
            PG8_BAR; PG8_WAIT_L(0); PG8_MMA(0, 1, At, B1); PG8_BAR;
            PG8_LDA(At, 1, 1); PG8_STAGE(PG8_SA(1, 0), a3, voffA);
            PG8_BAR; PG8_WAIT_L(0); PG8_MMA(1, 0, At, B0); PG8_BAR; PG8_SCHED;
            PG8_STAGE(PG8_SB(1, 1), b3 + hstep, voffB);
            PG8_WAIT_V(6); PG8_BAR; PG8_MMA(1, 1, At, B1); PG8_BAR;
            }
        }
        if constexpr (ALIGN_EPI) { if (wr == 0) PG8_BAR; }
        if constexpr (!Epi::AFTER_DRAIN) { E(acc, cur, wr, wc, fr, fq); S.done(cur); }
        if (!has_next) break;
#pragma unroll
        for (int a = 0; a < 2; ++a)
#pragma unroll
            for (int b = 0; b < 2; ++b)
#pragma unroll
                for (int m = 0; m < 4; ++m)
#pragma unroll
                    for (int n = 0; n < 2; ++n) acc[a][b][m][n] = (f32x4){0.f, 0.f, 0.f, 0.f};
        cur = nxt; cA = nA; cB = nB; ++ui;
        if constexpr (ALIGN_EPI) { if (wr == 1) PG8_BAR; }
    }
    PG8_WAIT_V(0);
    if constexpr (!ALIGN_EPI) { if (wr == 0) PG8_BAR; }
    PG8_BAR;
    if constexpr (Epi::AFTER_DRAIN) { E.fused(acc, cur, wr, wc, fr, fq, lds, wid, lane); S.done(cur); }
#undef PG8_SA
#undef PG8_SB
#undef PG8_STAGE
#undef PG8_LDA
#undef PG8_LDB
#undef PG8_MMA
#undef PG8_WAIT_V
#undef PG8_WAIT_L
#undef PG8_BAR
#undef PG8_SCHED
}
}
#define GAS __attribute__((address_space(1)))
#define LAS __attribute__((address_space(3)))
typedef unsigned short bf16;
typedef unsigned v4u __attribute__((ext_vector_type(4)));
typedef float f32x4 __attribute__((ext_vector_type(4)));
typedef short bf16x8 __attribute__((ext_vector_type(8)));
typedef GAS unsigned gu32;
typedef GAS unsigned long long gu64;
#define RLX_AGENT __ATOMIC_RELAXED, __HIP_MEMORY_SCOPE_AGENT
#define LDS_WAIT() asm volatile("s_waitcnt lgkmcnt(0)" ::: "memory")
#define VM_WAIT() asm volatile("s_waitcnt vmcnt(0)" ::: "memory")
__device__ __forceinline__ unsigned long long rt() { return __builtin_amdgcn_s_memrealtime(); }
__device__ __forceinline__ unsigned f2bf(float f) { unsigned u = __builtin_bit_cast(unsigned, f); return (u + 0x7fffu + ((u >> 16) & 1u)) >> 16; }
__device__ __forceinline__ unsigned pk2(float lo, float hi) { return f2bf(lo) | (f2bf(hi) << 16); }

#define XB_TMO      128
#define XB_XCNT(j)  (256  + 64 * (j))
#define XB_XSUB(j)  (1280 + 64 * (j))
#define XB_XGEN(j)  (2304 + 64 * (j))
#define XB_TOP      3328
#define XB_TOPGEN   3392
#define XCD_BAR_WORDS 3456
#define XB_SPIN_CAP (1u << 18)

__device__ __forceinline__ unsigned xb_ld(unsigned* p)              { return __hip_atomic_load(p, __ATOMIC_RELAXED, __HIP_MEMORY_SCOPE_AGENT); }
__device__ __forceinline__ unsigned xb_add(unsigned* p, unsigned v) { return __hip_atomic_fetch_add(p, v, __ATOMIC_RELAXED, __HIP_MEMORY_SCOPE_AGENT); }
__device__ __forceinline__ unsigned xb_xcc_id() { return (unsigned)__builtin_amdgcn_s_getreg((3 << 11) | 20) & 0xFu; }
#define XB_SPIN(cond, bar) do { unsigned _sp = 0; while (cond) { __builtin_amdgcn_s_sleep(1); \
    if ((++_sp & 255u) == 0u) { if (xb_ld(&(bar)[XB_TMO])) break; if (_sp > XB_SPIN_CAP) { atomicAdd(&(bar)[XB_TMO], 1u); break; } } } } while (0)

struct XcdBarrier {
    unsigned* bar; unsigned x;
    volatile LAS unsigned* st;
};

__device__ __forceinline__ XcdBarrier xcd_barrier_post(unsigned* bar, volatile LAS unsigned* st) {
    XcdBarrier b; b.bar = bar; b.x = xb_xcc_id(); b.st = st;
    if (threadIdx.x == 0) (void)xb_add(&bar[XB_XCNT(b.x)], 1u);
    return b;
}
__device__ __forceinline__ void xcd_barrier_complete(unsigned* bar, unsigned x, unsigned& nloc, unsigned& nx) {
    const unsigned G = gridDim.x * gridDim.y * gridDim.z;
    unsigned sum, cnt, mine, sp = 0u;
    for (;;) {
        sum = 0u; cnt = 0u; mine = 0u;
#pragma unroll
        for (unsigned j = 0; j < 16; ++j) { const unsigned c = xb_ld(&bar[XB_XCNT(j)]); sum += c; cnt += (c > 0u) ? 1u : 0u; mine = (j == x) ? c : mine; }
        if (sum == G) break;
        __builtin_amdgcn_s_sleep(1);
        if ((++sp & 255u) == 0u) { if (xb_ld(&bar[XB_TMO])) break; if (sp > XB_SPIN_CAP) { atomicAdd(&bar[XB_TMO], 1u); break; } }
    }
    nloc = mine > 0u ? mine : 1u; nx = cnt > 0u ? cnt : 1u;
}

__device__ __forceinline__ void xcd_barrier(const XcdBarrier& b) {
    asm volatile("s_waitcnt vmcnt(0)" ::: "memory");
    __syncthreads();
    if (threadIdx.x == 0) {
        unsigned* bar = b.bar;
        __builtin_amdgcn_s_waitcnt(0);
        unsigned nloc = b.st[0], nx = b.st[1];
        if (nloc == 0u) { xcd_barrier_complete(bar, b.x, nloc, nx); b.st[0] = nloc; b.st[1] = nx; }
        const unsigned old = xb_add(&bar[XB_XSUB(b.x)], 1u);
        const unsigned gen = old / nloc;
        if (old + 1u == (gen + 1u) * nloc) {
            __builtin_amdgcn_fence(__ATOMIC_RELEASE, "agent");
            asm volatile("s_waitcnt vmcnt(0)" ::: "memory");
            const unsigned og = xb_add(&bar[XB_TOP], 1u);
            const unsigned tg = og / nx;
            if (og + 1u == (tg + 1u) * nx) xb_add(&bar[XB_TOPGEN], 1u);
            else XB_SPIN(xb_ld(&bar[XB_TOPGEN]) == tg, bar);
            __builtin_amdgcn_fence(__ATOMIC_ACQUIRE, "agent");
            xb_add(&bar[XB_XGEN(b.x)], 1u);
            asm volatile("s_waitcnt vmcnt(0)" ::: "memory");
        } else {
            XB_SPIN(xb_ld(&bar[XB_XGEN(b.x)]) == gen, bar);
            __builtin_amdgcn_fence(__ATOMIC_ACQUIRE, "agent");
            asm volatile("s_waitcnt vmcnt(0)" ::: "memory");
        }
    }
    __syncthreads();
}
constexpr int TP = 4096, BP = 4, MP = BP * TP;
constexpr int BS = 128, TS = 4, MS = BS * TS;
constexpr int MT = MP + MS;
constexpr int DM = 1024, RW = 512, SC = 1792, NINP = 3840, FF = 2816, NUP = 5632;
constexpr int PAST = 2048, NPAGES = 16, LS = PAST + TS;
constexpr float ALPHA = 1.189207115002721f;
constexpr float LN_EPS = 1e-5f, GN_EPS = 64e-5f;
constexpr float QSCALE = 0.125f * 1.4426950408889634f;
constexpr float LOG2E = 1.4426950408889634f;
constexpr size_t O_YP = 0, O_YS = 16777216, O_KP = 17301504, O_VP = 25690112, O_KIP = 34078720, O_WKVP = 35127296, O_SHP = 35258368, O_CVP = 35265536,
                 O_KS = 35288064, O_VS = 35550208, O_KIS = 35812352, O_WKVS = 35845120, O_SHS = 40039424, O_CVS = 40268800, O_END = 40989696;

namespace pg8 {
__device__ __forceinline__ u32x4 pack8(const f32x4 a, const f32x4 b) { u32x4 w; w.x = cvt_pk_bf16(a[0], a[1]); w.y = cvt_pk_bf16(a[2], a[3]); w.z = cvt_pk_bf16(b[0], b[1]); w.w = cvt_pk_bf16(b[2], b[3]); return w; }
struct EpiIn {
    static constexpr bool PERM = true, AFTER_DRAIN = false;
    float* prw; bf16_t* qb; bf16_t* kb; bf16_t* vb; float* qi; float* wi; float* out;
    __device__ __forceinline__ void operator()(const f32x4 (&acc)[2][2][4][2], const Unit& u, int wr, int wc, int fr, int fq) const {
        const int pn = u.pn; const bool samp = u.pm >= 64;
#pragma unroll
        for (int ai = 0; ai < 2; ++ai)
#pragma unroll
            for (int m = 0; m < 4; ++m) {
                const int row = u.pm * BM + ai * HALF + wr * 64 + m * 16 + fr;
                const int rs = row - MP;
#pragma unroll
                for (int bj = 0; bj < 2; ++bj) {
                    const int col = pn * BM + bj * HALF + wc * 32 + 8 * fq;
                    const f32x4 v0 = acc[ai][bj][m][0], v1 = acc[ai][bj][m][1];
                    if (pn < 7) {
                        float* p = prw + (size_t)row * SC + col; *(f32x4*)p = v0; *(f32x4*)(p + 4) = v1;
                        const bool last = samp ? ((rs & 3) == 3) : ((row & (TP - 1)) == TP - 1);
                        if (last) { float* o = samp ? out + O_SHS + (size_t)(rs >> 2) * SC + col : out + O_SHP + (size_t)(row >> 12) * SC + col; *(f32x4*)o = v0; *(f32x4*)(o + 4) = v1; }
                    } else if (pn < 9) {
                        const int c = col - 1792; *(u32x4*)(qb + (size_t)row * RW + c) = pack8(v0 * QSCALE, v1 * QSCALE);
                    } else if (pn < 11) {
                        const int c = col - 2304; float* o = samp ? out + O_KS + (size_t)rs * RW + c : out + O_KP + (size_t)row * RW + c; *(f32x4*)o = v0; *(f32x4*)(o + 4) = v1;
                        *(u32x4*)(kb + (size_t)row * RW + c) = pack8(v0, v1);
                    } else if (pn < 13) {
                        const int c = col - 2816; float* o = samp ? out + O_VS + (size_t)rs * RW + c : out + O_VP + (size_t)row * RW + c; *(f32x4*)o = v0; *(f32x4*)(o + 4) = v1;
                        *(u32x4*)(vb + (size_t)row * RW + c) = pack8(v0, v1);
                    } else if (pn == 13) {
                        const int c = col - 3328; float* o = qi + (size_t)row * 256 + c; *(f32x4*)o = v0; *(f32x4*)(o + 4) = v1;
                    } else {
                        const int c = col - 3584;
                        if (c < 64) { float* o = samp ? out + O_KIS + (size_t)rs * 64 + c : out + O_KIP + (size_t)row * 64 + c; *(f32x4*)o = v0; *(f32x4*)(o + 4) = v1; }
                        else if (c == 64) { *(f32x4*)(wi + (size_t)row * 4) = v0 * 0.5f; }
                    }
                }
            }
    }
};
struct EpiRes {
    static constexpr bool PERM = true, AFTER_DRAIN = false;
    const float* resP; const float* resS; float* out;
    __device__ __forceinline__ void operator()(const f32x4 (&acc)[2][2][4][2], const Unit& u, int wr, int wc, int fr, int fq) const {
        const bool samp = u.pm >= 64;
#pragma unroll
        for (int ai = 0; ai < 2; ++ai)
#pragma unroll
            for (int m = 0; m < 4; ++m) {
                const int row = u.pm * BM + ai * HALF + wr * 64 + m * 16 + fr;
                const float* rr = samp ? resS + (size_t)(row - MP) * DM : resP + (size_t)row * DM;
#pragma unroll
                for (int bj = 0; bj < 2; ++bj) {
                    const int col = u.pn * BM + bj * HALF + wc * 32 + 8 * fq;
                    const f32x4 r0 = *(const f32x4*)(rr + col), r1 = *(const f32x4*)(rr + col + 4);
                    float* o = out + (size_t)row * DM + col;
                    *(f32x4*)o = r0 * ALPHA + acc[ai][bj][m][0]; *(f32x4*)(o + 4) = r1 * ALPHA + acc[ai][bj][m][1];
                }
            }
    }
};
struct EpiUp {
    static constexpr bool PERM = true, AFTER_DRAIN = false;
    bf16_t* uc; bf16_t* ul; float* out;
    __device__ __forceinline__ void operator()(const f32x4 (&acc)[2][2][4][2], const Unit& u, int wr, int wc, int fr, int fq) const {
        const bool samp = u.pm >= 64;
#pragma unroll
        for (int ai = 0; ai < 2; ++ai)
#pragma unroll
            for (int m = 0; m < 4; ++m) {
                const int row = u.pm * BM + ai * HALF + wr * 64 + m * 16 + fr;
                const int c = u.pn * HALF + wc * 32 + 8 * fq;
                *(u32x4*)(uc + (size_t)row * FF + c) = pack8(acc[ai][0][m][0], acc[ai][0][m][1]);
                *(u32x4*)(ul + (size_t)row * FF + c) = pack8(acc[ai][1][m][0], acc[ai][1][m][1]);
                if (samp) { const int rs = row - MP, t = rs & 3; if (t >= 2) { float* o = out + O_CVS + ((size_t)(rs >> 2) * 2 + (t - 2)) * FF + c; *(f32x4*)o = acc[ai][0][m][0]; *(f32x4*)(o + 4) = acc[ai][0][m][1]; } }
                else { const int t = row & (TP - 1); if (t >= TP - 2) { float* o = out + O_CVP + ((size_t)(row >> 12) * 2 + (t - (TP - 2))) * FF + c; *(f32x4*)o = acc[ai][0][m][0]; *(f32x4*)(o + 4) = acc[ai][0][m][1]; } }
            }
    }
};
}
constexpr size_t MiB = 1u << 20;
constexpr size_t WS_CTL = 0, CTL_ZERO_BYTES = 1 * MiB;
constexpr size_t WS_WIN = 2 * MiB;
constexpr size_t WS_WOUT = 10 * MiB;
constexpr size_t WS_WUP = 12 * MiB;
constexpr size_t WS_WDN = 24 * MiB;
constexpr size_t WS_XB = 32 * MiB;
constexpr size_t WS_PRW = 66 * MiB;
constexpr size_t WS_QB = 182 * MiB;
constexpr size_t WS_KB = 199 * MiB;
constexpr size_t WS_VB = 216 * MiB;
constexpr size_t WS_QI = 233 * MiB;
constexpr size_t WS_WI = 250 * MiB;
constexpr size_t WS_SCAN = 251 * MiB;
constexpr size_t WS_G = 454 * MiB;
constexpr size_t WS_RKR = 488 * MiB;
constexpr size_t WS_YS = 489 * MiB;
constexpr size_t WS_MASK = 523 * MiB;
constexpr size_t WS_SEL = 532 * MiB;
constexpr size_t WS_MIX = 533 * MiB;
constexpr size_t WS_Z = 567 * MiB;
constexpr size_t WS_X1 = 634 * MiB;
constexpr size_t WS_X1B = 701 * MiB;
constexpr size_t WS_UC = 735 * MiB;
constexpr size_t WS_UL = 826 * MiB;
constexpr size_t WS_H = 917 * MiB;
constexpr size_t WS_END = 1008 * MiB;
constexpr int CW_BAR = 4096;
constexpr int SREC = 392;

constexpr int RING_BYTES = 131072, LDSCTL_OFF = RING_BYTES, MISC_OFF = LDSCTL_OFF + 320, LDS_BYTES = 147456;
constexpr int NWAVES = 8, NTHR = 512;
constexpr int NPHASE = 12;

__device__ __forceinline__ float bf2f(unsigned short h) { return __builtin_bit_cast(float, (unsigned)h << 16); }
__device__ __forceinline__ float wave_sum(float v) {
#pragma unroll
    for (int o = 1; o < 64; o <<= 1) v += __shfl_xor(v, o);
    return v;
}
template <int CTRL> __device__ __forceinline__ float dppf(float x) { return __builtin_bit_cast(float, __builtin_amdgcn_update_dpp(0, __builtin_bit_cast(int, x), CTRL, 0xf, 0xf, true)); }
__device__ __forceinline__ float sum16(float x) {
    x += dppf<0xB1>(x); x += dppf<0x4E>(x); x += dppf<0x141>(x); x += dppf<0x140>(x); return x;
}
__device__ __forceinline__ float sum8(float x) {
    x += dppf<0xB1>(x); x += dppf<0x4E>(x); x += dppf<0x141>(x); return x;
}
__device__ __forceinline__ bf16x8 pack_bf8(const f32x4 a, const f32x4 b) {
    v4u w; w.x = pk2(a[0], a[1]); w.y = pk2(a[2], a[3]); w.z = pk2(b[0], b[1]); w.w = pk2(b[2], b[3]); return __builtin_bit_cast(bf16x8, w);
}
typedef float f32x16 __attribute__((ext_vector_type(16)));
typedef float f32x2 __attribute__((ext_vector_type(2)));

struct Ctx {
    LAS unsigned char* lds; int tid, lane, wave, vcu, G;
    const void* const* in_; float* out; unsigned char* ws;
};
#define INF(k) ((const float*)in[k])

template <int MODE> __device__ __forceinline__ void p0_tr_item(const float* W, int K, int N, int nblk, bf16* WT, LAS float* scr, int item, int lane) {
    const int kb = item / nblk, nb = item % nblk, k0 = 64 * kb, n0 = 32 * nb;
    const int nl0 = lane & 31; const bool okn = (n0 + nl0) < N;
#pragma unroll 8
    for (int i = 0; i < 32; ++i) { const int kk = 2 * i + (lane >> 5); scr[kk * 33 + nl0] = okn ? W[(size_t)(k0 + kk) * N + n0 + nl0] : 0.f; }
    asm volatile("s_waitcnt lgkmcnt(0)" ::: "memory");
    const int c = lane & 7;
#pragma unroll
    for (int j = 0; j < 4; ++j) { const int nl = (lane >> 3) + 8 * j; const int n = n0 + nl; const LAS float* s = scr + (8 * c) * 33 + nl;
        int row = n;
        if (MODE == 2) row = (n < FF) ? 256 * (n >> 7) + (n & 127) : 256 * ((n - FF) >> 7) + 128 + ((n - FF) & 127);
        v4u o; o.x = pk2(s[0 * 33], s[1 * 33]); o.y = pk2(s[2 * 33], s[3 * 33]); o.z = pk2(s[4 * 33], s[5 * 33]); o.w = pk2(s[6 * 33], s[7 * 33]);
        *(GAS v4u*)(WT + (size_t)row * K + k0 + 8 * c) = o; }
    asm volatile("s_waitcnt lgkmcnt(0)" ::: "memory");
}
__device__ __forceinline__ void p0_prologue(const Ctx& C, const void* const* in) {
    LAS float* scr = (LAS float*)(C.lds + C.wave * 16384);
    const int gw = C.vcu * NWAVES + C.wave, NGW = C.G * NWAVES;
    constexpr int I_IN = 16 * 120, I_OUT = 16 * 32, I_UP = 16 * 176, I_DN = 44 * 32, NITEMS = I_IN + I_OUT + I_UP + I_DN;
    bf16* win = (bf16*)(C.ws + WS_WIN); bf16* wout = (bf16*)(C.ws + WS_WOUT); bf16* wup = (bf16*)(C.ws + WS_WUP); bf16* wdn = (bf16*)(C.ws + WS_WDN);
    for (int it = gw; it < NITEMS; it += NGW) {
        int r = it;
        if (r < I_IN) { p0_tr_item<0>(INF(10), DM, 3652, 120, win, scr, r, C.lane); continue; } r -= I_IN;
        if (r < I_OUT) { p0_tr_item<0>(INF(22), DM, DM, 32, wout, scr, r, C.lane); continue; } r -= I_OUT;
        if (r < I_UP) { p0_tr_item<2>(INF(25), DM, NUP, 176, wup, scr, r, C.lane); continue; } r -= I_UP;
        p0_tr_item<0>(INF(28), FF, DM, 32, wdn, scr, r, C.lane);
    }
    bf16* xb = (bf16*)(C.ws + WS_XB);
    for (int m = gw; m < MT; m += NGW) {
        const float* xr = (m < MP) ? INF(0) + (size_t)m * DM : INF(1) + (size_t)(m - MP) * DM;
        const GAS f32x4* x4 = (const GAS f32x4*)xr + C.lane;
        GAS unsigned long long* o8 = (GAS unsigned long long*)(xb + (size_t)m * DM) + C.lane;
#pragma unroll
        for (int j = 0; j < 4; ++j) { const f32x4 v = x4[64 * j]; o8[64 * j] = (unsigned long long)pk2(v.x, v.y) | ((unsigned long long)pk2(v.z, v.w) << 32); }
    }
}

__device__ __forceinline__ float sigmoidf_(float x) { return 1.f / (1.f + __expf(-x)); }
__device__ __forceinline__ void p2_prep(const Ctx& C, const void* const* in) {
    LAS float* act = (LAS float*)C.lds;
    const float* PRW = (const float*)(C.ws + WS_PRW);
    float* SCAN = (float*)(C.ws + WS_SCAN); float* Gb = (float*)(C.ws + WS_G); float* RKR = (float*)(C.ws + WS_RKR);
    const float* smu = INF(11); const float* sst = INF(7);
    const float* wup = INF(13); const float* aup = INF(15); const float* gup = INF(16);
    const int c = C.tid, h = C.wave, j = C.lane;
    const float mu_r = smu[c], mu_k = smu[RW + c], mu_v = smu[2 * RW + c];
    const float w0 = INF(12)[c], a0 = INF(14)[c], kkc = INF(17)[c], kac = INF(18)[c], rkc = INF(19)[c];
    for (int tile = C.vcu; tile < MT / 32; tile += C.G) {
        const int m0 = tile * 32;
        __syncthreads();
        {
            const int tok = C.tid >> 4, cg = C.tid & 15, m = m0 + tok, col0 = 1536 + cg * 16;
            const float* prow = PRW + (size_t)m * SC + col0; const float* pprev = prow - SC; bool zero = false;
            if (m < MP) { zero = (m & (TP - 1)) == 0; } else { const int ms = m - MP; if ((ms & 3) == 0) pprev = sst + (size_t)(ms >> 2) * SC + col0; }
#pragma unroll
            for (int i = 0; i < 4; ++i) {
                const f32x4 p = *(const f32x4*)(prow + 4 * i); f32x4 q = (f32x4){0.f, 0.f, 0.f, 0.f}; if (!zero) q = *(const f32x4*)(pprev + 4 * i);
                const f32x4 mu = *(const f32x4*)(smu + col0 + 4 * i); f32x4 s = p + (q - p) * mu;
                if (cg < 4) { for (int e = 0; e < 4; ++e) { const float ex = __expf(2.f * s[e]); s[e] = 1.f - 2.f / (ex + 1.f); } }
                else if (cg >= 8) { for (int e = 0; e < 4; ++e) s[e] = sigmoidf_(s[e]); }
                *(LAS f32x4*)(act + tok * 256 + cg * 16 + 4 * i) = s;
            }
        }
        __syncthreads();
        float aw[32], aa[32], ag[32];
#pragma unroll
        for (int t = 0; t < 32; ++t) { aw[t] = 0.f; aa[t] = 0.f; ag[t] = 0.f; }
        for (int k = 0; k < 64; k += 4) {
            const float w_0 = wup[(k + 0) * RW + c], w_1 = wup[(k + 1) * RW + c], w_2 = wup[(k + 2) * RW + c], w_3 = wup[(k + 3) * RW + c];
            const float a_0 = aup[(k + 0) * RW + c], a_1 = aup[(k + 1) * RW + c], a_2 = aup[(k + 2) * RW + c], a_3 = aup[(k + 3) * RW + c];
#pragma unroll
            for (int t = 0; t < 32; ++t) {
                const f32x4 x = *(const LAS f32x4*)(act + t * 256 + k); const f32x4 y = *(const LAS f32x4*)(act + t * 256 + 64 + k);
                aw[t] += x[0] * w_0 + x[1] * w_1 + x[2] * w_2 + x[3] * w_3; aa[t] += y[0] * a_0 + y[1] * a_1 + y[2] * a_2 + y[3] * a_3;
            }
        }
        for (int k = 0; k < 128; k += 4) {
            const float g_0 = gup[(k + 0) * RW + c], g_1 = gup[(k + 1) * RW + c], g_2 = gup[(k + 2) * RW + c], g_3 = gup[(k + 3) * RW + c];
#pragma unroll
            for (int t = 0; t < 32; ++t) { const f32x4 x = *(const LAS f32x4*)(act + t * 256 + 128 + k); ag[t] += x[0] * g_0 + x[1] * g_1 + x[2] * g_2 + x[3] * g_3; }
        }
        float pr_p = 0.f, pk_p = 0.f, pv_p = 0.f;
        if (m0 < MP) { if ((m0 & (TP - 1)) != 0) { const float* pp = PRW + (size_t)(m0 - 1) * SC; pr_p = pp[c]; pk_p = pp[RW + c]; pv_p = pp[2 * RW + c]; } }
#pragma unroll
        for (int t = 0; t < 32; ++t) {
            const int m = m0 + t; const float* pc = PRW + (size_t)m * SC;
            const float pr = pc[c], pk = pc[RW + c], pv = pc[2 * RW + c];
            if (m0 >= MP && (t & 3) == 0) { const float* ss = sst + (size_t)((m - MP) >> 2) * SC; pr_p = ss[c]; pk_p = ss[RW + c]; pv_p = ss[2 * RW + c]; }
            const float r = pr + (pr_p - pr) * mu_r, k = pk + (pk_p - pk) * mu_k, v = pv + (pv_p - pv) * mu_v;
            pr_p = pr; pk_p = pk; pv_p = pv;
            const float u = w0 + aw[t];
            const float wlog = -__logf(1.f + __expf(-u)) - 0.5f;
            const float decay = __expf(-__expf(wlog));
            const float a = sigmoidf_(a0 + aa[t]);
            float kk = k * kkc; const float ss2 = wave_sum(kk * kk); kk *= rsqrtf(fmaxf(ss2, 1e-24f));
            const float kp = k * (1.f + (a - 1.f) * kac);
            const float bb = kk * a, wr = decay * r;
            const float br = wave_sum(bb * r), kr = wave_sum(kp * r), rkr = wave_sum(r * kp * rkc);
            float* rec = SCAN + ((size_t)m * 8 + h) * SREC;
            rec[j] = decay; rec[64 + j] = kk; rec[128 + j] = bb; rec[192 + j] = kp; rec[256 + j] = wr; rec[320 + j] = v;
            if (j == 0) { rec[384] = br; rec[385] = kr; RKR[(size_t)m * 8 + h] = rkr; }
            Gb[(size_t)m * RW + c] = ag[t];
        }
    }
}

__device__ __forceinline__ unsigned long long topk_select(const LAS float* vals, int nvis, int lane) {
    const int nreg = (nvis + 63) >> 6;
    unsigned key[64];
#pragma unroll
    for (int g = 0; g < 8; ++g) {
        if (g * 8 < nreg) {
#pragma unroll
            for (int e = 0; e < 8; ++e) { const int i = g * 8 + e; const int kidx = 64 * i + lane;
                unsigned u = 0u;
                if (kidx < nvis) { const float v = vals[kidx]; u = __builtin_bit_cast(unsigned, v); if ((u << 1) == 0u) u = 0u; u = (u & 0x80000000u) ? ~u : (u | 0x80000000u); }
                key[i] = u; }
        } else {
#pragma unroll
            for (int e = 0; e < 8; ++e) key[g * 8 + e] = 0u;
        }
    }
    unsigned long long myword = 0ull;
    const unsigned long long lt = (lane == 0) ? 0ull : (~0ull >> (64 - lane));
    if (nvis <= 256) {
#pragma unroll
        for (int i = 0; i < 4; ++i) { const unsigned long long m = __ballot(64 * i + lane < nvis); if (lane == i) myword = m; }
        return myword;
    }
    unsigned T = 0u;
    for (int bit = 31; bit >= 0; --bit) {
        const unsigned cand = T | (1u << bit); int cnt = 0;
#pragma unroll
        for (int g = 0; g < 8; ++g) if (g * 8 < nreg) {
#pragma unroll
            for (int e = 0; e < 8; ++e) cnt += __popcll(__ballot(key[g * 8 + e] >= cand));
        }
        if (cnt >= 256) T = cand;
    }
    int cgt = 0;
#pragma unroll
    for (int g = 0; g < 8; ++g) if (g * 8 < nreg) {
#pragma unroll
        for (int e = 0; e < 8; ++e) cgt += __popcll(__ballot(key[g * 8 + e] > T));
    }
    const int need = 256 - cgt; int run = 0;
#pragma unroll
    for (int g = 0; g < 8; ++g) if (g * 8 < nreg) {
#pragma unroll
        for (int e = 0; e < 8; ++e) { const int i = g * 8 + e;
            const bool eq = key[i] == T; const unsigned long long em = __ballot(eq);
            const int before = run + __popcll(em & lt);
            const bool s = (key[i] > T) || (eq && before < need); run += __popcll(em);
            const unsigned long long m = __ballot(s); if (lane == i) myword = m; }
    }
    return myword;
}
__device__ __forceinline__ void p3_topk(const Ctx& C, const void* const* in) {
    const float* QI = (const float*)(C.ws + WS_QI); const float* WI = (const float*)(C.ws + WS_WI);
    unsigned long long* MASK = (unsigned long long*)(C.ws + WS_MASK); int* SEL = (int*)(C.ws + WS_SEL);
    const int lane = C.lane, wave = C.wave, hi = lane >> 5;
    constexpr int NU_P = MP / 8, NU = NU_P + BS;
    for (int unit = C.vcu; unit < NU; unit += C.G) {
        __syncthreads();
        if (unit < NU_P) {
            LAS float* idx = (LAS float*)C.lds;
            const int b = unit >> 9, t0 = (unit & 511) * 8, nkeys = t0 + 8;
            const int rho = lane & 31, q = rho >> 2, hh = rho & 3;
            const float* qrow = QI + ((size_t)(b * TP + t0 + q)) * 256 + hh * 64 + 8 * hi;
            bf16x8 af[4];
#pragma unroll
            for (int s = 0; s < 4; ++s) af[s] = pack_bf8(*(const f32x4*)(qrow + 16 * s), *(const f32x4*)(qrow + 16 * s + 4));
            f32x4 wiv[4];
#pragma unroll
            for (int g = 0; g < 4; ++g) wiv[g] = *(const f32x4*)(WI + ((size_t)(b * TP + t0 + 2 * g + hi)) * 4) * 0.125f;
            const float* KI = C.out + O_KIP + (size_t)b * TP * 64;
            const int ntile = (nkeys + 31) >> 5;
            for (int tile = wave; tile < ntile; tile += 8) {
                const int key = tile * 32 + rho;
                const float* krow = KI + (size_t)key * 64 + 8 * hi;
                f32x16 acc;
#pragma unroll
                for (int r = 0; r < 16; ++r) acc[r] = 0.f;
#pragma unroll
                for (int s = 0; s < 4; ++s) { const bf16x8 bf = pack_bf8(*(const f32x4*)(krow + 16 * s), *(const f32x4*)(krow + 16 * s + 4));
                    acc = __builtin_amdgcn_mfma_f32_32x32x16_bf16(af[s], bf, acc, 0, 0, 0); }
#pragma unroll
                for (int g = 0; g < 4; ++g) {
                    float v = 0.f;
#pragma unroll
                    for (int e = 0; e < 4; ++e) v += wiv[g][e] * fmaxf(acc[4 * g + e], 0.f);
                    idx[(2 * g + hi) * 4096 + key] = v;
                }
            }
            __syncthreads();
            const int t = t0 + wave;
            const unsigned long long w = topk_select(idx + wave * 4096, t + 1, lane);
            MASK[((size_t)(b * TP + t)) * 64 + lane] = w;
        } else {
            const int b = unit - NU_P;
            LAS float* qis = (LAS float*)C.lds;
            LAS float* wis = qis + 1024;
            LAS float* idx = qis + 1280;
            if (C.tid < 256) { const int row = C.tid >> 4, c4 = (C.tid & 15) * 4;
                *(LAS f32x4*)(qis + row * 64 + c4) = *(const f32x4*)(QI + ((size_t)(MP + b * 4 + (row >> 2))) * 256 + (row & 3) * 64 + c4); }
            if (C.tid < 16) wis[C.tid] = WI[((size_t)(MP + b * 4 + (C.tid >> 2))) * 4 + (C.tid & 3)] * 0.125f;
            __syncthreads();
            const int* pt = (const int*)in[5] + b * NPAGES;
            for (int s = C.tid; s < LS; s += NTHR) {
                const float* krow = (s < PAST) ? INF(4) + ((size_t)pt[s >> 7] * 128 + (s & 127)) * 64 : C.out + O_KIS + (size_t)(b * 4 + (s - PAST)) * 64;
                f32x4 kx[16];
#pragma unroll
                for (int i = 0; i < 16; ++i) kx[i] = *(const f32x4*)(krow + 4 * i);
#pragma unroll
                for (int t = 0; t < 4; ++t) {
                    float v = 0.f;
#pragma unroll
                    for (int hh = 0; hh < 4; ++hh) {
                        float d0 = 0.f, d1 = 0.f;
#pragma unroll
                        for (int i = 0; i < 16; i += 2) { const f32x4 qa = *(const LAS f32x4*)(qis + (t * 4 + hh) * 64 + 4 * i), qb = *(const LAS f32x4*)(qis + (t * 4 + hh) * 64 + 4 * i + 4);
                            d0 += kx[i][0] * qa[0] + kx[i][1] * qa[1] + kx[i][2] * qa[2] + kx[i][3] * qa[3];
                            d1 += kx[i + 1][0] * qb[0] + kx[i + 1][1] * qb[1] + kx[i + 1][2] * qb[2] + kx[i + 1][3] * qb[3]; }
                        v += wis[t * 4 + hh] * fmaxf(d0 + d1, 0.f);
                    }
                    idx[t * 2112 + s] = v;
                }
            }
            __syncthreads();
            if (wave < 4) {
                const int t = wave;
                unsigned long long w = topk_select(idx + t * 2112, PAST + t + 1, lane);
                int cnt = __popcll(w), pre = cnt;
#pragma unroll
                for (int o = 1; o < 64; o <<= 1) { const int x = __shfl_up(pre, o); if (lane >= o) pre += x; }
                int pos = pre - cnt; int* sel = SEL + (size_t)(b * 4 + t) * 256;
                while (w) { const int bit = __builtin_ctzll(w); if (pos < 256) sel[pos] = 64 * lane + bit; ++pos; w &= w - 1; }
            }
        }
    }
}

struct ScanVec { f32x4 w, kk, b, k, wr; float v; float br, kr; };
__device__ __forceinline__ float scan_step(float (&S)[4], const ScanVec& x) {
    float p1 = S[0] * x.kk[0] + S[1] * x.kk[1] + S[2] * x.kk[2] + S[3] * x.kk[3];
    float p2 = S[0] * x.wr[0] + S[1] * x.wr[1] + S[2] * x.wr[2] + S[3] * x.wr[3];
    float t0 = S[0] * x.w[0] + x.v * x.k[0], t1 = S[1] * x.w[1] + x.v * x.k[1], t2 = S[2] * x.w[2] + x.v * x.k[2], t3 = S[3] * x.w[3] + x.v * x.k[3];
    p1 = sum16(p1); p2 = sum16(p2);
    const float sa = -p1;
    S[0] = t0 + sa * x.b[0]; S[1] = t1 + sa * x.b[1]; S[2] = t2 + sa * x.b[2]; S[3] = t3 + sa * x.b[3];
    return p2 + sa * x.br + x.v * x.kr;
}
__device__ __forceinline__ void p4_scan(const Ctx& C, const void* const* in) {
    const float* SCAN = (const float*)(C.ws + WS_SCAN); float* YS = (float*)(C.ws + WS_YS);
    const int lane = C.lane, wave = C.wave, rg = lane >> 4, jl = lane & 15;
    {
        const float* st = INF(6);
        for (int u = C.vcu * NWAVES + wave; u < BS * 8 * 16; u += C.G * NWAVES) {
            const int bh = u >> 4, b = bh >> 3, h = bh & 7, i = (u & 15) * 4 + rg;
            const f32x4 s4 = *(const f32x4*)(st + ((size_t)bh * 64 + i) * 64 + 4 * jl);
            float S[4] = {s4[0], s4[1], s4[2], s4[3]};
#pragma unroll
            for (int t = 0; t < 4; ++t) {
                const int m = MP + b * 4 + t; const float* rec = SCAN + ((size_t)m * 8 + h) * SREC;
                ScanVec x; x.w = *(const f32x4*)(rec + 4 * jl); x.kk = *(const f32x4*)(rec + 64 + 4 * jl); x.b = *(const f32x4*)(rec + 128 + 4 * jl);
                x.k = *(const f32x4*)(rec + 192 + 4 * jl); x.wr = *(const f32x4*)(rec + 256 + 4 * jl); x.v = rec[320 + i]; x.br = rec[384]; x.kr = rec[385];
                const float y = scan_step(S, x);
                if (jl == 0) YS[(size_t)m * RW + h * 64 + i] = y;
            }
            *(f32x4*)(C.out + O_WKVS + ((size_t)bh * 64 + i) * 64 + 4 * jl) = (f32x4){S[0], S[1], S[2], S[3]};
        }
    }
    __syncthreads();
    for (int unit = C.vcu; unit < 256; unit += C.G) {
        const int bh = unit >> 3, b = bh >> 3, h = bh & 7, i = (unit & 7) * 8 + wave * 4 + rg;
        LAS float* buf = (LAS float*)C.lds;
        constexpr int CH = 16, CHF4 = CH * SREC / 4;
        const float* base = SCAN + ((size_t)(b * TP) * 8 + h) * SREC;
        f32x4 stg[4];
#define SC_GLOAD(t0_) do { _Pragma("unroll") for (int k_ = 0; k_ < 4; ++k_) { const int q_ = C.tid + k_ * NTHR; if (q_ < CHF4) { const int s_ = q_ / 98, off_ = q_ - s_ * 98; stg[k_] = *(const f32x4*)(base + (size_t)((t0_) + s_) * 8 * SREC + off_ * 4); } } } while (0)
#define SC_LSTORE(bi_) do { _Pragma("unroll") for (int k_ = 0; k_ < 4; ++k_) { const int q_ = C.tid + k_ * NTHR; if (q_ < CHF4) *(LAS f32x4*)(buf + (bi_) * (CH * SREC) + q_ * 4) = stg[k_]; } } while (0)
        SC_GLOAD(0); SC_LSTORE(0); __syncthreads();
        float S[4] = {0.f, 0.f, 0.f, 0.f};
        for (int ch = 0; ch < TP / CH; ++ch) {
            if (ch + 1 < TP / CH) SC_GLOAD((ch + 1) * CH);
            if (wave < 2) {
                const LAS float* cb = buf + (ch & 1) * (CH * SREC);
#pragma unroll 4
                for (int s = 0; s < CH; ++s) {
                    const LAS float* rec = cb + s * SREC;
                    ScanVec x; x.w = *(const LAS f32x4*)(rec + 4 * jl); x.kk = *(const LAS f32x4*)(rec + 64 + 4 * jl); x.b = *(const LAS f32x4*)(rec + 128 + 4 * jl);
                    x.k = *(const LAS f32x4*)(rec + 192 + 4 * jl); x.wr = *(const LAS f32x4*)(rec + 256 + 4 * jl); x.v = rec[320 + i];
                    const f32x2 bk = *(const LAS f32x2*)(rec + 384); x.br = bk[0]; x.kr = bk[1];
                    const float y = scan_step(S, x);
                    if (jl == 0) YS[((size_t)(b * TP + ch * CH + s)) * RW + h * 64 + i] = y;
                }
            }
            if (ch + 1 < TP / CH) SC_LSTORE((ch + 1) & 1);
            __syncthreads();
        }
        if (wave < 2) *(f32x4*)(C.out + O_WKVP + ((size_t)bh * 64 + i) * 64 + 4 * jl) = (f32x4){S[0], S[1], S[2], S[3]};
    }
}
__device__ __forceinline__ void p5_post(const Ctx& C, const void* const* in) {
    const float* YS = (const float*)(C.ws + WS_YS); const float* Gb = (const float*)(C.ws + WS_G); const float* RKR = (const float*)(C.ws + WS_RKR);
    const float* SCAN = (const float*)(C.ws + WS_SCAN); bf16* MIX = (bf16*)(C.ws + WS_MIX);
    const int c = C.tid, h = C.wave, j = C.lane;
    const float gg = INF(20)[c], gb = INF(21)[c];
    for (int m = C.vcu; m < MT; m += C.G) {
        const float y = YS[(size_t)m * RW + c];
        const float mu = wave_sum(y) * (1.f / 64.f); const float d = y - mu; const float var = wave_sum(d * d) * (1.f / 64.f);
        const float yn = d * rsqrtf(var + GN_EPS) * gg + gb;
        const float v = SCAN[((size_t)m * 8 + h) * SREC + 320 + j];
        const float o = (yn + RKR[(size_t)m * 8 + h] * v) * Gb[(size_t)m * RW + c];
        MIX[(size_t)m * DM + c] = (bf16)f2bf(o);
    }
}
__device__ __forceinline__ int t5_bucket(int d) {
    if (d < 16) return d;
    int b = 16;
    b += (d >= 19); b += (d >= 21); b += (d >= 24); b += (d >= 27); b += (d >= 31); b += (d >= 35); b += (d >= 40); b += (d >= 46);
    b += (d >= 52); b += (d >= 59); b += (d >= 67); b += (d >= 77); b += (d >= 87); b += (d >= 99); b += (d >= 113);
    return b;
}
constexpr int KROW = 72, VROW = 68;
constexpr int ATT_KB = 64 * KROW * 2, ATT_VB = 64 * VROW * 2;
__device__ __forceinline__ void attn_prompt_unit(const Ctx& C, int b, int h, int qb, const LAS float* btab) {
    const bf16* QB = (const bf16*)(C.ws + WS_QB); const bf16* KB = (const bf16*)(C.ws + WS_KB); const bf16* VB = (const bf16*)(C.ws + WS_VB);
    const unsigned long long* MASK = (const unsigned long long*)(C.ws + WS_MASK); bf16* MIX = (bf16*)(C.ws + WS_MIX);
    LAS unsigned char* kbuf = C.lds; LAS unsigned char* vbuf = C.lds + 2 * ATT_KB;
    const int lane = C.lane, wave = C.wave, r32 = lane & 31, hi = lane >> 5;
    const int q0 = qb * 256, qw0 = q0 + wave * 32, q = qw0 + r32;
    const size_t rowb = (size_t)b * TP;
    const int NT = (q0 + 256) / 64;
    bf16x8 qf[4];
#pragma unroll
    for (int s = 0; s < 4; ++s) qf[s] = *(const bf16x8*)(QB + (rowb + q) * RW + h * 64 + 16 * s + 8 * hi);
    const unsigned long long* mrow = MASK + (rowb + q) * 64;
    const int srow = C.tid >> 3, sch = C.tid & 7;
    const bf16* kg = KB + (rowb + srow) * RW + h * 64 + sch * 8; const bf16* vg = VB + (rowb + srow) * RW + h * 64 + sch * 8;
    v4u kst, vst;
#define ATT_GLOAD(t) do { kst = *(const v4u*)(kg + (size_t)(t) * 64 * RW); vst = *(const v4u*)(vg + (size_t)(t) * 64 * RW); } while (0)
#define ATT_LSTORE(bi) do { *(LAS v4u*)(kbuf + (bi) * ATT_KB + srow * (KROW * 2) + sch * 16) = kst; \
        LAS unsigned short* vt_ = (LAS unsigned short*)(vbuf + (bi) * ATT_VB) + (sch * 8) * VROW + srow; \
        vt_[0 * VROW] = (unsigned short)(vst.x & 0xffffu); vt_[1 * VROW] = (unsigned short)(vst.x >> 16); vt_[2 * VROW] = (unsigned short)(vst.y & 0xffffu); vt_[3 * VROW] = (unsigned short)(vst.y >> 16); \
        vt_[4 * VROW] = (unsigned short)(vst.z & 0xffffu); vt_[5 * VROW] = (unsigned short)(vst.z >> 16); vt_[6 * VROW] = (unsigned short)(vst.w & 0xffffu); vt_[7 * VROW] = (unsigned short)(vst.w >> 16); } while (0)
    __syncthreads();
    ATT_GLOAD(0); ATT_LSTORE(0);
    __syncthreads();
    f32x16 o0, o1;
#pragma unroll
    for (int r = 0; r < 16; ++r) { o0[r] = 0.f; o1[r] = 0.f; }
    float mrun = -1e30f, lrun = 0.f;
    unsigned long long mw = mrow[0];
    for (int t = 0; t < NT; ++t) {
        const int bi = t & 1;
        if (t + 1 < NT) ATT_GLOAD(t + 1);
        const unsigned long long mcur = mw; if (t + 1 < NT) mw = mrow[t + 1];
        const int kv0 = t * 64;
        if (kv0 <= qw0 + 31) {
            f32x16 p0, p1;
#pragma unroll
            for (int r = 0; r < 16; ++r) { p0[r] = 0.f; p1[r] = 0.f; }
            const LAS unsigned char* kb0 = kbuf + bi * ATT_KB + r32 * (KROW * 2) + hi * 16;
#pragma unroll
            for (int s = 0; s < 4; ++s) {
                const bf16x8 ka = *(const LAS bf16x8*)(kb0 + s * 32), kb2 = *(const LAS bf16x8*)(kb0 + 32 * (KROW * 2) + s * 32);
                p0 = __builtin_amdgcn_mfma_f32_32x32x16_bf16(ka, qf[s], p0, 0, 0, 0);
                p1 = __builtin_amdgcn_mfma_f32_32x32x16_bf16(kb2, qf[s], p1, 0, 0, 0);
            }
            if (kv0 + 63 + 113 > qw0) {
#pragma unroll
                for (int r = 0; r < 16; ++r) { const int kv = kv0 + (r & 3) + 8 * (r >> 2) + 4 * hi;
                    int d0 = q - kv; d0 = d0 < 0 ? 0 : (d0 > 127 ? 127 : d0); int d1 = q - kv - 32; d1 = d1 < 0 ? 0 : (d1 > 127 ? 127 : d1);
                    p0[r] += btab[h * 128 + d0]; p1[r] += btab[h * 128 + d1]; }
            }
            float mx = p0[0];
#pragma unroll
            for (int r = 1; r < 16; ++r) mx = fmaxf(mx, p0[r]);
#pragma unroll
            for (int r = 0; r < 16; ++r) mx = fmaxf(mx, p1[r]);
            mx = fmaxf(mx, __shfl_xor(mx, 32));
            const float mnew = fmaxf(mrun, mx);
            const float alpha = __builtin_amdgcn_exp2f(mrun - mnew);
            mrun = mnew;
            const unsigned wlo = (unsigned)mcur >> (4 * hi), whi = (unsigned)(mcur >> 32) >> (4 * hi);
            float ls = 0.f;
#pragma unroll
            for (int r = 0; r < 16; ++r) { const int pos = (r & 3) + 8 * (r >> 2);
                const int m0 = __builtin_amdgcn_sbfe(wlo, pos, 1), m1 = __builtin_amdgcn_sbfe(whi, pos, 1);
                const float e0 = __builtin_amdgcn_exp2f(p0[r] - mnew), e1 = __builtin_amdgcn_exp2f(p1[r] - mnew);
                p0[r] = __builtin_bit_cast(float, __builtin_bit_cast(int, e0) & m0); p1[r] = __builtin_bit_cast(float, __builtin_bit_cast(int, e1) & m1);
                ls += p0[r] + p1[r]; }
            lrun = lrun * alpha + ls;
            if (__any(alpha != 1.f)) {
#pragma unroll
                for (int r = 0; r < 16; ++r) { o0[r] *= alpha; o1[r] *= alpha; }
            }
            const LAS unsigned char* vb0 = vbuf + bi * ATT_VB + r32 * (VROW * 2) + hi * 8;
#pragma unroll
            for (int jj = 0; jj < 4; ++jj) {
                f32x4 pa, pb;
                if (jj == 0) { pa = (f32x4){p0[0], p0[1], p0[2], p0[3]}; pb = (f32x4){p0[4], p0[5], p0[6], p0[7]}; }
                else if (jj == 1) { pa = (f32x4){p0[8], p0[9], p0[10], p0[11]}; pb = (f32x4){p0[12], p0[13], p0[14], p0[15]}; }
                else if (jj == 2) { pa = (f32x4){p1[0], p1[1], p1[2], p1[3]}; pb = (f32x4){p1[4], p1[5], p1[6], p1[7]}; }
                else { pa = (f32x4){p1[8], p1[9], p1[10], p1[11]}; pb = (f32x4){p1[12], p1[13], p1[14], p1[15]}; }
                const bf16x8 pf = pack_bf8(pa, pb);
                typedef unsigned u32x2 __attribute__((ext_vector_type(2)));
                const u32x2 a0 = *(const LAS u32x2*)(vb0 + jj * 32), a1 = *(const LAS u32x2*)(vb0 + jj * 32 + 16);
                const u32x2 c0 = *(const LAS u32x2*)(vb0 + 32 * (VROW * 2) + jj * 32), c1 = *(const LAS u32x2*)(vb0 + 32 * (VROW * 2) + jj * 32 + 16);
                const bf16x8 va = __builtin_bit_cast(bf16x8, (v4u){a0.x, a0.y, a1.x, a1.y}), vc = __builtin_bit_cast(bf16x8, (v4u){c0.x, c0.y, c1.x, c1.y});
                o0 = __builtin_amdgcn_mfma_f32_32x32x16_bf16(va, pf, o0, 0, 0, 0);
                o1 = __builtin_amdgcn_mfma_f32_32x32x16_bf16(vc, pf, o1, 0, 0, 0);
            }
        }
        if (t + 1 < NT) ATT_LSTORE(bi ^ 1);
        __syncthreads();
    }
#undef ATT_GLOAD
#undef ATT_LSTORE
    const float ltot = lrun + __shfl_xor(lrun, 32);
    const float inv = 1.f / ltot;
    bf16* orow = MIX + (rowb + q) * DM + RW + h * 64;
#pragma unroll
    for (int g = 0; g < 4; ++g) {
        const int d = 8 * g + 4 * hi;
        typedef unsigned u32x2 __attribute__((ext_vector_type(2)));
        u32x2 w0, w1;
        w0.x = pk2(o0[4 * g] * inv, o0[4 * g + 1] * inv); w0.y = pk2(o0[4 * g + 2] * inv, o0[4 * g + 3] * inv);
        w1.x = pk2(o1[4 * g] * inv, o1[4 * g + 1] * inv); w1.y = pk2(o1[4 * g + 2] * inv, o1[4 * g + 3] * inv);
        *(u32x2*)(orow + d) = w0; *(u32x2*)(orow + 32 + d) = w1;
    }
}
__device__ __forceinline__ void attn_sample_query(const Ctx& C, const void* const* in, int qi_, const LAS float* btab) {
    const bf16* QB = (const bf16*)(C.ws + WS_QB); const int* SEL = (const int*)(C.ws + WS_SEL); bf16* MIX = (bf16*)(C.ws + WS_MIX);
    const int lane = C.lane, hh = lane >> 3, ch = lane & 7;
    const int b = qi_ >> 2, t = qi_ & 3, m = MP + qi_, qpos = PAST + t;
    float qv[8];
    { const v4u qq = *(const v4u*)(QB + (size_t)m * RW + hh * 64 + ch * 8);
      qv[0] = bf2f(qq.x & 0xffffu); qv[1] = bf2f(qq.x >> 16); qv[2] = bf2f(qq.y & 0xffffu); qv[3] = bf2f(qq.y >> 16);
      qv[4] = bf2f(qq.z & 0xffffu); qv[5] = bf2f(qq.z >> 16); qv[6] = bf2f(qq.w & 0xffffu); qv[7] = bf2f(qq.w >> 16); }
    const int* pt = (const int*)in[5] + b * NPAGES;
    const int* sel = SEL + (size_t)qi_ * 256;
    const float* ck = INF(2); const float* cv = INF(3);
    float acc[8] = {0.f, 0.f, 0.f, 0.f, 0.f, 0.f, 0.f, 0.f}; float mrun = -1e30f, lrun = 0.f;
    for (int j0 = 0; j0 < 256; j0 += 4) {
        f32x4 k0[4], k1[4], v0[4], v1[4]; float bias[4];
#pragma unroll
        for (int u = 0; u < 4; ++u) {
            const int s = sel[j0 + u];
            const float *kr, *vr;
            if (s < PAST) { const size_t row = (size_t)pt[s >> 7] * 128 + (s & 127); kr = ck + row * RW; vr = cv + row * RW; }
            else { const size_t row = (size_t)(b * 4 + (s - PAST)); kr = C.out + O_KS + row * RW; vr = C.out + O_VS + row * RW; }
            kr += hh * 64 + ch * 8; vr += hh * 64 + ch * 8;
            k0[u] = *(const f32x4*)kr; k1[u] = *(const f32x4*)(kr + 4); v0[u] = *(const f32x4*)vr; v1[u] = *(const f32x4*)(vr + 4);
            int d = qpos - s; d = d < 0 ? 0 : (d > 127 ? 127 : d); bias[u] = btab[1024 + hh * 128 + d];
        }
#pragma unroll
        for (int u = 0; u < 4; ++u) {
            float p = qv[0] * k0[u][0] + qv[1] * k0[u][1] + qv[2] * k0[u][2] + qv[3] * k0[u][3] + qv[4] * k1[u][0] + qv[5] * k1[u][1] + qv[6] * k1[u][2] + qv[7] * k1[u][3];
            p = sum8(p) + bias[u];
            const float mnew = fmaxf(mrun, p); const float alpha = __builtin_amdgcn_exp2f(mrun - mnew), e = __builtin_amdgcn_exp2f(p - mnew);
            mrun = mnew; lrun = lrun * alpha + e;
            acc[0] = acc[0] * alpha + e * v0[u][0]; acc[1] = acc[1] * alpha + e * v0[u][1]; acc[2] = acc[2] * alpha + e * v0[u][2]; acc[3] = acc[3] * alpha + e * v0[u][3];
            acc[4] = acc[4] * alpha + e * v1[u][0]; acc[5] = acc[5] * alpha + e * v1[u][1]; acc[6] = acc[6] * alpha + e * v1[u][2]; acc[7] = acc[7] * alpha + e * v1[u][3];
        }
    }
    const float inv = 1.f / lrun;
    v4u w; w.x = pk2(acc[0] * inv, acc[1] * inv); w.y = pk2(acc[2] * inv, acc[3] * inv); w.z = pk2(acc[4] * inv, acc[5] * inv); w.w = pk2(acc[6] * inv, acc[7] * inv);
    *(v4u*)(MIX + (size_t)m * DM + RW + hh * 64 + ch * 8) = w;
}
__device__ __forceinline__ void p5_attn(const Ctx& C, const void* const* in) {
    LAS float* btab = (LAS float*)(C.lds + 2 * ATT_KB + 2 * ATT_VB);
    const float* rb = INF(9);
    for (int i = C.tid; i < 1024; i += NTHR) { const int hh = i >> 7, d = i & 127; const float bv = rb[t5_bucket(d) * 8 + hh];
        btab[i] = (bv - rb[31 * 8 + hh]) * LOG2E; btab[1024 + i] = bv * LOG2E; }
    __syncthreads();
    for (int qi_ = C.vcu * NWAVES + C.wave; qi_ < MS; qi_ += C.G * NWAVES) attn_sample_query(C, in, qi_, btab);
    for (int u = C.vcu; u < 512; u += C.G) {
        const int bh = (u & 255) >> 3, s = u & 7, qb = (u < 256) ? s : 15 - s;
        attn_prompt_unit(C, bh >> 3, bh & 7, qb, btab);
    }
}

__device__ __forceinline__ void ln_rows(const Ctx& C, const float* Z, const float* g, const float* bt, float* outP, float* outS, bf16* ob) {
    const int gw = C.vcu * NWAVES + C.wave, NGW = C.G * NWAVES;
    f32x4 gv[4], bv[4];
#pragma unroll
    for (int j = 0; j < 4; ++j) { gv[j] = *((const f32x4*)g + C.lane + 64 * j); bv[j] = *((const f32x4*)bt + C.lane + 64 * j); }
    for (int m = gw; m < MT; m += NGW) {
        const f32x4* zr = (const f32x4*)(Z + (size_t)m * DM) + C.lane;
        f32x4 v[4]; float s = 0.f;
#pragma unroll
        for (int j = 0; j < 4; ++j) { v[j] = zr[64 * j]; s += (v[j].x + v[j].y) + (v[j].z + v[j].w); }
        const float mean = wave_sum(s) * (1.f / DM); float s2 = 0.f;
#pragma unroll
        for (int j = 0; j < 4; ++j) { v[j] = v[j] - mean; s2 += (v[j].x * v[j].x + v[j].y * v[j].y) + (v[j].z * v[j].z + v[j].w * v[j].w); }
        const float rstd = rsqrtf(wave_sum(s2) * (1.f / DM) + LN_EPS);
        float* orow = (m < MP) ? outP + (size_t)m * DM : outS + (size_t)(m - MP) * DM;
#pragma unroll
        for (int j = 0; j < 4; ++j) { const f32x4 o = v[j] * rstd * gv[j] + bv[j]; *((f32x4*)orow + C.lane + 64 * j) = o;
            if (ob) *((unsigned long long*)(ob + (size_t)m * DM) + C.lane + 64 * j) = (unsigned long long)pk2(o.x, o.y) | ((unsigned long long)pk2(o.z, o.w) << 32); }
    }
}

__device__ __forceinline__ void p9_conv(const Ctx& C, const void* const* in) {
    const bf16* UC = (const bf16*)(C.ws + WS_UC); const bf16* UL = (const bf16*)(C.ws + WS_UL); bf16* H = (bf16*)(C.ws + WS_H);
    const float* cw = INF(26); const float* cb = INF(27); const float* cst = INF(8);
    constexpr int CPR = FF / 8;
    const long total = (long)MT * CPR;
    for (long it = (long)C.vcu * NTHR + C.tid; it < total; it += (long)C.G * NTHR) {
        const int m = (int)(it / CPR), c = (int)(it - (long)m * CPR) * 8;
        int t; const float* prev = nullptr;
        if (m < MP) t = m & (TP - 1); else { const int ms = m - MP; t = ms & 3; prev = cst + (size_t)(ms >> 2) * 2 * FF; }
        float u0[8], u1[8], u2[8], ul[8];
        { const v4u a = *(const v4u*)(UC + (size_t)m * FF + c); const v4u l = *(const v4u*)(UL + (size_t)m * FF + c);
          u2[0] = bf2f(a.x & 0xffffu); u2[1] = bf2f(a.x >> 16); u2[2] = bf2f(a.y & 0xffffu); u2[3] = bf2f(a.y >> 16); u2[4] = bf2f(a.z & 0xffffu); u2[5] = bf2f(a.z >> 16); u2[6] = bf2f(a.w & 0xffffu); u2[7] = bf2f(a.w >> 16);
          ul[0] = bf2f(l.x & 0xffffu); ul[1] = bf2f(l.x >> 16); ul[2] = bf2f(l.y & 0xffffu); ul[3] = bf2f(l.y >> 16); ul[4] = bf2f(l.z & 0xffffu); ul[5] = bf2f(l.z >> 16); ul[6] = bf2f(l.w & 0xffffu); ul[7] = bf2f(l.w >> 16); }
        if (t >= 1) { const v4u a = *(const v4u*)(UC + (size_t)(m - 1) * FF + c);
          u1[0] = bf2f(a.x & 0xffffu); u1[1] = bf2f(a.x >> 16); u1[2] = bf2f(a.y & 0xffffu); u1[3] = bf2f(a.y >> 16); u1[4] = bf2f(a.z & 0xffffu); u1[5] = bf2f(a.z >> 16); u1[6] = bf2f(a.w & 0xffffu); u1[7] = bf2f(a.w >> 16); }
        else { for (int e = 0; e < 8; ++e) u1[e] = prev ? prev[FF + c + e] : 0.f; }
        if (t >= 2) { const v4u a = *(const v4u*)(UC + (size_t)(m - 2) * FF + c);
          u0[0] = bf2f(a.x & 0xffffu); u0[1] = bf2f(a.x >> 16); u0[2] = bf2f(a.y & 0xffffu); u0[3] = bf2f(a.y >> 16); u0[4] = bf2f(a.z & 0xffffu); u0[5] = bf2f(a.z >> 16); u0[6] = bf2f(a.w & 0xffffu); u0[7] = bf2f(a.w >> 16); }
        else { for (int e = 0; e < 8; ++e) u0[e] = prev ? prev[t * FF + c + e] : 0.f; }
        float hv[8];
#pragma unroll
        for (int e = 0; e < 8; ++e) { const float cv = u0[e] * cw[c + e] + u1[e] * cw[FF + c + e] + u2[e] * cw[2 * FF + c + e] + cb[c + e];
            hv[e] = cv / (1.f + __expf(-cv)) * ul[e]; }
        v4u w; w.x = pk2(hv[0], hv[1]); w.y = pk2(hv[2], hv[3]); w.z = pk2(hv[4], hv[5]); w.w = pk2(hv[6], hv[7]);
        *(v4u*)(H + (size_t)m * FF + c) = w;
    }
}

struct Args { const void* in[31]; float* out; unsigned char* ws; int ph_lo, ph_hi; };
__global__ void __launch_bounds__(NTHR, 2) fwd_kernel(Args args) {
    extern __shared__ __attribute__((aligned(16))) unsigned char lds_raw[];
    Ctx C;
    C.lds = (LAS unsigned char*)lds_raw; C.tid = threadIdx.x; C.lane = C.tid & 63; C.wave = __builtin_amdgcn_readfirstlane(C.tid >> 6);
    C.G = gridDim.x; { const int bx = blockIdx.x; C.vcu = (C.G % 8 == 0) ? (bx % 8) * (C.G / 8) + bx / 8 : bx; }
    C.out = args.out; C.ws = args.ws;
    const void* const* in = args.in;
    volatile LAS unsigned* MISC = (volatile LAS unsigned*)(C.lds + MISC_OFF);
    for (int u = C.tid; u < (LDS_BYTES - LDSCTL_OFF) / 4; u += NTHR) ((LAS unsigned*)(C.lds + LDSCTL_OFF))[u] = 0u;
    __syncthreads();
    const int lo = args.ph_lo, hi = args.ph_hi;
    const bool multi = (hi - lo) > 1;
    XcdBarrier bar; bar.bar = (unsigned*)(C.ws + WS_CTL) + CW_BAR; bar.x = 0; bar.st = nullptr;
    if (multi) bar = xcd_barrier_post((unsigned*)(C.ws + WS_CTL) + CW_BAR, MISC + 8);
#define IN(k) (lo <= (k) && (k) < hi)
#define SEAM(k) do { if (IN(k) && IN((k) + 1)) xcd_barrier(bar); } while (0)
    bf16* XB = (bf16*)(C.ws + WS_XB); bf16* MIX = (bf16*)(C.ws + WS_MIX); bf16* X1B = (bf16*)(C.ws + WS_X1B); bf16* HB = (bf16*)(C.ws + WS_H);
    float* Z = (float*)(C.ws + WS_Z); float* X1 = (float*)(C.ws + WS_X1);

    if (IN(0)) { p0_prologue(C, in); } SEAM(0);
    if (IN(1)) {
        pg8::Gemm g{XB, (const bf16*)(C.ws + WS_WIN), MT, NINP, DM}; pg8::StaticOrder S; S.init(MT, NINP, C.G, (int)blockIdx.x);
        pg8::EpiIn E{(float*)(C.ws + WS_PRW), (bf16*)(C.ws + WS_QB), (bf16*)(C.ws + WS_KB), (bf16*)(C.ws + WS_VB), (float*)(C.ws + WS_QI), (float*)(C.ws + WS_WI), C.out};
        pg8::gemm_phase<pg8::EpiIn, pg8::StaticOrder, true, true>(C.lds, g, S, E);
    } SEAM(1);
    if (IN(2)) { p2_prep(C, in); } SEAM(2);
    if (IN(3)) { p3_topk(C, in); } SEAM(3);
    if (IN(4)) { p4_scan(C, in); } SEAM(4);
    if (IN(5)) { p5_post(C, in); p5_attn(C, in); } SEAM(5);
    if (IN(6)) {
        pg8::Gemm g{MIX, (const bf16*)(C.ws + WS_WOUT), MT, DM, DM}; pg8::StaticOrder S; S.init(MT, DM, C.G, (int)blockIdx.x);
        pg8::EpiRes E{INF(0), INF(1), Z};
        pg8::gemm_phase<pg8::EpiRes, pg8::StaticOrder, true, true>(C.lds, g, S, E);
    } SEAM(6);
    if (IN(7)) { ln_rows(C, Z, INF(23), INF(24), X1, X1 + (size_t)MP * DM, X1B); } SEAM(7);
    if (IN(8)) {
        pg8::Gemm g{X1B, (const bf16*)(C.ws + WS_WUP), MT, NUP, DM}; pg8::StaticOrder S; S.init(MT, NUP, C.G, (int)blockIdx.x);
        pg8::EpiUp E{(bf16*)(C.ws + WS_UC), (bf16*)(C.ws + WS_UL), C.out};
        pg8::gemm_phase<pg8::EpiUp, pg8::StaticOrder, true, true>(C.lds, g, S, E);
    } SEAM(8);
    if (IN(9)) { p9_conv(C, in); } SEAM(9);
    if (IN(10)) {
        pg8::Gemm g{HB, (const bf16*)(C.ws + WS_WDN), MT, DM, FF}; pg8::StaticOrder S; S.init(MT, DM, C.G, (int)blockIdx.x);
        pg8::EpiRes E{X1, X1 + (size_t)MP * DM, Z};
        pg8::gemm_phase<pg8::EpiRes, pg8::StaticOrder, true, true>(C.lds, g, S, E);
    } SEAM(10);
    if (IN(11)) { ln_rows(C, Z, INF(29), INF(30), C.out + O_YP, C.out + O_YS, nullptr); }
#undef IN
#undef SEAM
}

#ifndef N_LAUNCH_MODE
#define N_LAUNCH_MODE 0
#endif
extern "C" void kernel_launch(void* const* d_in, const int* in_sizes, int n_in, void* d_out, int out_size, void* d_ws, size_t ws_size, hipStream_t stream) {
    static int grid = 0;
    if (grid == 0) {
        if (n_in != 31 || out_size != (int)O_END || ws_size < WS_END) { fprintf(stderr, "kernel_launch: unexpected shapes (n_in %d, out %d, ws %zu)\n", n_in, out_size, ws_size); grid = -1; return; }
        int dev = 0, cus = 0, per_cu = 0;
        if (hipGetDevice(&dev) != hipSuccess || hipDeviceGetAttribute(&cus, hipDeviceAttributeMultiprocessorCount, dev) != hipSuccess) { grid = -1; return; }
        if (hipFuncSetAttribute((const void*)fwd_kernel, hipFuncAttributeMaxDynamicSharedMemorySize, LDS_BYTES) != hipSuccess) { fprintf(stderr, "kernel_launch: hipFuncSetAttribute failed\n"); grid = -1; return; }
        if (hipOccupancyMaxActiveBlocksPerMultiprocessor(&per_cu, (const void*)fwd_kernel, NTHR, LDS_BYTES) != hipSuccess || per_cu < 1) fprintf(stderr, "kernel_launch: occupancy query says %d\n", per_cu);
        (void)hipGetLastError();
        grid = cus;
    }
    if (grid < 0) return;
    (void)hipMemsetAsync((char*)d_ws + WS_CTL, 0, CTL_ZERO_BYTES, stream);
    Args a{};
    for (int i = 0; i < 31; ++i) a.in[i] = d_in[i];
    a.out = (float*)d_out; a.ws = (unsigned char*)d_ws;
#if N_LAUNCH_MODE == 1
    a.ph_lo = 0; a.ph_hi = NPHASE;
    hipLaunchKernelGGL(fwd_kernel, dim3(grid), dim3(NTHR), LDS_BYTES, stream, a);
#else
    for (int p = 0; p < NPHASE; ++p) { a.ph_lo = p; a.ph_hi = p + 1; hipLaunchKernelGGL(fwd_kernel, dim3(grid), dim3(NTHR), LDS_BYTES, stream, a); }
#endif
    const hipError_t le = hipPeekAtLastError();
    if (le != hipSuccess) fprintf(stderr, "kernel_launch: launch failed: %s\n", hipGetErrorName(le));
}
```

```cpp
#include <hip/hip_runtime.h>
#include <cstdio>
#include <cstdint>
namespace pg8 {
#define PG8_LAS __attribute__((address_space(3)))
typedef unsigned short bf16_t;
typedef short bf16x8 __attribute__((ext_vector_type(8)));
typedef float f32x4 __attribute__((ext_vector_type(4)));
typedef unsigned u32x4 __attribute__((ext_vector_type(4)));
constexpr int BM = 256, BK = 64, HALF = 128, HTB = HALF * BK * 2  , STAGE_BYTES = 8 * HTB, NXCD = 8, WGM = 8;

__host__ __device__ __forceinline__ int lds_byte(int r, int c) { const int st = (r >> 4) * 2 + (c >> 5), rr = r & 15, cc = c & 31, ob = rr * 64 + cc * 2; return st * 1024 + (ob ^ (((ob >> 9) & 1) << 5)); }
__host__ __device__ __forceinline__ void stage_rc(int b, int& R, int& C) { const int st = b / 1024, sb = b % 1024, swz = sb ^ (((sb >> 9) & 1) << 5); R = (st >> 1) * 16 + swz / 64; C = (st & 1) * 32 + (swz % 64) / 2; }
__host__ __device__ __forceinline__ int perm32(int rho) { const int n = rho >> 4, i = rho & 15; return 8 * (i >> 2) + 4 * n + (i & 3); }

struct Unit { int pm, pn; };
struct Gemm { const bf16_t* A; const bf16_t* Bt; int M, N, K; };

struct StaticOrder {
    int nM, nN, nwg, G, c;
    __host__ __device__ void init(int M, int N, int G_, int c_) { nM = M / BM; nN = N / BM; nwg = nM * nN; G = G_; c = c_; }
    __host__ __device__ bool next(int i, Unit& u) const {
        const long L = (long)i * G + c; if (L >= nwg) return false;
        int wgid = (int)L; { const int q = nwg / NXCD, r = nwg % NXCD, xcd = wgid % NXCD, off = wgid / NXCD; wgid = (xcd < r ? xcd * (q + 1) : r * (q + 1) + (xcd - r) * q) + off; }
        const int nig = WGM * nN, gid = wgid / nig, fm = gid * WGM, gsz = (nM - fm) < WGM ? (nM - fm) : WGM;
        u.pm = fm + ((wgid % nig) % gsz); u.pn = (wgid % nig) / gsz; return true;
    }
    __device__ __forceinline__ void a_ready(const Unit&) const {}
    __device__ __forceinline__ void done(const Unit&) const {}
};

__device__ __forceinline__ unsigned cvt_pk_bf16(float lo, float hi) { unsigned r; asm volatile("v_cvt_pk_bf16_f32 %0, %1, %2" : "=v"(r) : "v"(lo), "v"(hi)); return r; }
typedef float f32x2 __attribute__((ext_vector_type(2)));
template <class Epi, class Sched, bool ALIGN_EPI = false, bool SP2 = false>
__device__ __forceinline__ void gemm_phase(PG8_LAS unsigned char* lds, const Gemm g, const Sched& S, const Epi& E) {
    const int tid = threadIdx.x, wid = __builtin_amdgcn_readfirstlane(tid >> 6), lane = tid & 63, wr = wid >> 2, wc = wid & 3, fr = lane & 15, fq = lane >> 4;
    const int K = g.K, nt = K / BK;
    unsigned voffA[2], voffB[2];
#pragma unroll
    for (int i = 0; i < 2; ++i) { int R, C; stage_rc(tid * 16 + i * 8192, R, C); const int Rb = Epi::PERM ? ((R & ~31) + perm32(R & 31)) : R;
        voffA[i] = (unsigned)(R * K + C) * 2u; voffB[i] = (unsigned)(Rb * K + C) * 2u; }
    const size_t kstep = (size_t)(BK * 2);
    const size_t hstep = (size_t)HALF * K * 2;
    const size_t tstep = 2 * hstep;
    const unsigned ldsw = (unsigned)wid * 1024u;
    const int aoff = lds_byte(wr * 64 + fr, fq * 8), boff = lds_byte(wc * 32 + fr, fq * 8);
#define PG8_SA(b, h) (((b) * 2 + (h)) * HTB)
#define PG8_SB(b, h) ((4 + (b) * 2 + (h)) * HTB)
#define PG8_STAGE(bufoff, gbase, voff) do { _Pragma("unroll") for (int _i = 0; _i < 2; ++_i) \
        __builtin_amdgcn_global_load_lds((const unsigned*)((const char*)(gbase) + (voff)[_i]), (PG8_LAS unsigned*)(lds + (bufoff) + ldsw + _i * 8192), 16, 0, 0); } while (0)
#define PG8_LDA(dst, b, h) do { _Pragma("unroll") for (int m = 0; m < 4; ++m) _Pragma("unroll") for (int k = 0; k < 2; ++k) dst[m][k] = *(const PG8_LAS bf16x8*)(lds + PG8_SA(b, h) + aoff + m * 2048 + k * 1024); } while (0)
#define PG8_LDB(dst, b, h) do { _Pragma("unroll") for (int n = 0; n < 2; ++n) _Pragma("unroll") for (int k = 0; k < 2; ++k) dst[n][k] = *(const PG8_LAS bf16x8*)(lds + PG8_SB(b, h) + boff + n * 2048 + k * 1024); } while (0)
#define PG8_MMA(ai, bj, At, Bt) do { __builtin_amdgcn_s_setprio(1); _Pragma("unroll") for (int m = 0; m < 4; ++m) _Pragma("unroll") for (int n = 0; n < 2; ++n) _Pragma("unroll") for (int k = 0; k < 2; ++k) \
        acc[ai][bj][m][n] = __builtin_amdgcn_mfma_f32_16x16x32_bf16(Bt[n][k], At[m][k], acc[ai][bj][m][n], 0, 0, 0); __builtin_amdgcn_s_setprio(0); } while (0)
#define PG8_WAIT_V(n) asm volatile("s_waitcnt vmcnt(" #n ")" ::: "memory")
#define PG8_WAIT_L(n) asm volatile("s_waitcnt lgkmcnt(" #n ")" ::: "memory")
#define PG8_BAR __builtin_amdgcn_s_barrier()
#define PG8_SCHED __builtin_amdgcn_sched_barrier(0)
    Unit cur, nxt; int ui = 0;
    if (!S.next(0, cur)) return;
    f32x4 acc[2][2][4][2];
#pragma unroll
    for (int a = 0; a < 2; ++a)
#pragma unroll
        for (int b = 0; b < 2; ++b)
#pragma unroll
            for (int m = 0; m < 4; ++m)
#pragma unroll
                for (int n = 0; n < 2; ++n) acc[a][b][m][n] = (f32x4){0.f, 0.f, 0.f, 0.f};
    bf16x8 At[4][2], B0[2][2], B1[2][2];
    const char* cA = (const char*)g.A + (size_t)cur.pm * tstep; const char* cB = (const char*)g.Bt + (size_t)cur.pn * tstep;
    S.a_ready(cur);
    if constexpr (SP2) {
        PG8_STAGE(PG8_SB(0, 0), cB, voffB); PG8_STAGE(PG8_SB(0, 1), cB + hstep, voffB); PG8_STAGE(PG8_SA(0, 0), cA, voffA); PG8_STAGE(PG8_SA(0, 1), cA + hstep, voffA);
        if (wr == 1) PG8_BAR;
        PG8_WAIT_V(2); PG8_BAR;
        PG8_STAGE(PG8_SB(1, 0), cB + kstep, voffB); PG8_STAGE(PG8_SA(1, 0), cA + kstep, voffA); PG8_STAGE(PG8_SB(1, 1), cB + hstep + kstep, voffB);
        PG8_WAIT_V(6); PG8_BAR;
    } else {
        PG8_STAGE(PG8_SB(0, 0), cB, voffB); PG8_STAGE(PG8_SA(0, 0), cA, voffA); PG8_STAGE(PG8_SB(0, 1), cB + hstep, voffB); PG8_STAGE(PG8_SA(0, 1), cA + hstep, voffA);
        if (wr == 1) PG8_BAR;
        PG8_WAIT_V(4); PG8_BAR;
        PG8_STAGE(PG8_SB(1, 0), cB + kstep, voffB); PG8_STAGE(PG8_SA(1, 0), cA + kstep, voffA); PG8_STAGE(PG8_SB(1, 1), cB + hstep + kstep, voffB);
        PG8_WAIT_V(6); PG8_BAR;
    }
    for (;;) {
        const bool has_next = S.next(ui + 1, nxt);
        const char* nA = has_next ? (const char*)g.A + (size_t)nxt.pm * tstep : cA; const char* nB = has_next ? (const char*)g.Bt + (size_t)nxt.pn * tstep : cB;
        for (int t = 0; t < nt; t += 2) {
            const bool last = (t == nt - 2);
            const char* a1 = cA + (size_t)(t + 1) * kstep;
            const char* a2 = last ? nA : cA + (size_t)(t + 2) * kstep; const char* b2 = last ? nB : cB + (size_t)(t + 2) * kstep;
            const char* a3 = a2 + kstep; const char* b3 = b2 + kstep;
            if (last && has_next) S.a_ready(nxt);
            if constexpr (SP2) {
            PG8_LDB(B0, 0, 0); PG8_LDB(B1, 0, 1); PG8_SCHED; PG8_LDA(At, 0, 0); PG8_STAGE(PG8_SA(1, 1), a1 + hstep, voffA);
            PG8_WAIT_V(8); PG8_WAIT_L(0); PG8_BAR; PG8_MMA(0, 0, At, B0); PG8_MMA(0, 1, At, B1); PG8_BAR; PG8_SCHED;
            PG8_LDA(At, 0, 1); PG8_STAGE(PG8_SB(0, 0), b2, voffB); PG8_STAGE(PG8_SB(0, 1), b2 + hstep, voffB); PG8_STAGE(PG8_SA(0, 0), a2, voffA);
            PG8_WAIT_V(8); PG8_WAIT_L(0); PG8_BAR; PG8_MMA(1, 0, At, B0); PG8_MMA(1, 1, At, B1); PG8_BAR; PG8_SCHED;
            PG8_LDB(B0, 1, 0); PG8_LDB(B1, 1, 1); PG8_SCHED; PG8_LDA(At, 1, 0); PG8_STAGE(PG8_SA(0, 1), a2 + hstep, voffA);
            PG8_WAIT_V(8); PG8_WAIT_L(0); PG8_BAR; PG8_MMA(0, 0, At, B0); PG8_MMA(0, 1, At, B1); PG8_BAR; PG8_SCHED;
            PG8_LDA(At, 1, 1); PG8_STAGE(PG8_SB(1, 0), b3, voffB); PG8_STAGE(PG8_SB(1, 1), b3 + hstep, voffB); PG8_STAGE(PG8_SA(1, 0), a3, voffA);
            PG8_WAIT_V(8); PG8_WAIT_L(0); PG8_BAR; PG8_MMA(1, 0, At, B0); PG8_MMA(1, 1, At, B1); PG8_BAR; PG8_SCHED;
            } else {
            PG8_LDB(B0, 0, 0); PG8_SCHED; PG8_LDA(At, 0, 0); PG8_STAGE(PG8_SA(1, 1), a1 + hstep, voffA);
            PG8_WAIT_L(8); PG8_BAR; PG8_WAIT_L(0); PG8_MMA(0, 0, At, B0); PG8_BAR; PG8_SCHED;
            PG8_LDB(B1, 0, 1); PG8_STAGE(PG8_SB(0, 0), b2, voffB);
            PG8_BAR; PG8_WAIT_L(0); PG8_MMA(0, 1, At, B1); PG8_BAR;
            PG8_LDA(At, 0, 1); PG8_STAGE(PG8_SA(0, 0), a2, voffA);
            PG8_BAR; PG8_WAIT_L(0); PG8_MMA(1, 0, At, B0); PG8_BAR; PG8_SCHED;
            PG8_STAGE(PG8_SB(0, 1), b2 + hstep, voffB);
            PG8_WAIT_V(6); PG8_BAR; PG8_MMA(1, 1, At, B1); PG8_BAR;
            PG8_LDB(B0, 1, 0); PG8_SCHED; PG8_LDA(At, 1, 0); PG8_STAGE(PG8_SA(0, 1), a2 + hstep, voffA);
            PG8_WAIT_L(8); PG8_BAR; PG8_WAIT_L(0); PG8_MMA(0, 0, At, B0); PG8_BAR; PG8_SCHED;
            PG8_LDB(B1, 1, 1); PG8_STAGE(PG8_SB(1, 0), b3, voffB);
            PG8_BAR; PG8_WAIT_L(0); PG8_MMA(0, 1, At, B1); PG8_BAR;
            PG8_LDA(At, 1, 1); PG8_STAGE(PG8_SA(1, 0), a3, voffA);
            PG8_BAR; PG8_WAIT_L(0); PG8_MMA(1, 0, At, B0); PG8_BAR; PG8_SCHED;
            PG8_STAGE(PG8_SB(1, 1), b3 + hstep, voffB);
            PG8_WAIT_V(6); PG8_BAR; PG8_MMA(1, 1, At, B1); PG8_BAR;
            }
        }
        if constexpr (ALIGN_EPI) { if (wr == 0) PG8_BAR; }
        if constexpr (!Epi::AFTER_DRAIN) { E(acc, cur, wr, wc, fr, fq); S.done(cur); }
        if (!has_next) break;
#pragma unroll
        for (int a = 0; a < 2; ++a)
#pragma unroll
            for (int b = 0; b < 2; ++b)
#pragma unroll
                for (int m = 0; m < 4; ++m)
#pragma unroll
                    for (int n = 0; n < 2; ++n) acc[a][b][m][n] = (f32x4){0.f, 0.f, 0.f, 0.f};
        cur = nxt; cA = nA; cB = nB; ++ui;
        if constexpr (ALIGN_EPI) { if (wr == 1) PG8_BAR; }
    }
    PG8_WAIT_V(0);
    if constexpr (!ALIGN_EPI) { if (wr == 0) PG8_BAR; }
    PG8_BAR;
    if constexpr (Epi::AFTER_DRAIN) { E.fused(acc, cur, wr, wc, fr, fq, lds, wid, lane); S.done(cur); }
#undef PG8_SA
#undef PG8_SB
#undef PG8_STAGE
#undef PG8_LDA
#undef PG8_LDB
#undef PG8_MMA
#undef PG8_WAIT_V
#undef PG8_WAIT_L
#undef PG8_BAR
#undef PG8_SCHED
}
}
#define GAS __attribute__((address_space(1)))
#define LAS __attribute__((address_space(3)))
typedef unsigned short bf16;
typedef unsigned v4u __attribute__((ext_vector_type(4)));
typedef float f32x4 __attribute__((ext_vector_type(4)));
typedef short bf16x8 __attribute__((ext_vector_type(8)));
typedef GAS unsigned gu32;
typedef GAS unsigned long long gu64;
#define RLX_AGENT __ATOMIC_RELAXED, __HIP_MEMORY_SCOPE_AGENT
#define LDS_WAIT() asm volatile("s_waitcnt lgkmcnt(0)" ::: "memory")
#define VM_WAIT() asm volatile("s_waitcnt vmcnt(0)" ::: "memory")
__device__ __forceinline__ unsigned long long rt() { return __builtin_amdgcn_s_memrealtime(); }
__device__ __forceinline__ unsigned f2bf(float f) { unsigned u = __builtin_bit_cast(unsigned, f); return (u + 0x7fffu + ((u >> 16) & 1u)) >> 16; }
__device__ __forceinline__ unsigned pk2(float lo, float hi) { return f2bf(lo) | (f2bf(hi) << 16); }

#define XB_TMO      128
#define XB_XCNT(j)  (256  + 64 * (j))
#define XB_XSUB(j)  (1280 + 64 * (j))
#define XB_XGEN(j)  (2304 + 64 * (j))
#define XB_TOP      3328
#define XB_TOPGEN   3392
#define XCD_BAR_WORDS 3456
#define XB_SPIN_CAP (1u << 18)

__device__ __forceinline__ unsigned xb_ld(unsigned* p)              { return __hip_atomic_load(p, __ATOMIC_RELAXED, __HIP_MEMORY_SCOPE_AGENT); }
__device__ __forceinline__ unsigned xb_add(unsigned* p, unsigned v) { return __hip_atomic_fetch_add(p, v, __ATOMIC_RELAXED, __HIP_MEMORY_SCOPE_AGENT); }
__device__ __forceinline__ unsigned xb_xcc_id() { return (unsigned)__builtin_amdgcn_s_getreg((3 << 11) | 20) & 0xFu; }
#define XB_SPIN(cond, bar) do { unsigned _sp = 0; while (cond) { __builtin_amdgcn_s_sleep(1); \
    if ((++_sp & 255u) == 0u) { if (xb_ld(&(bar)[XB_TMO])) break; if (_sp > XB_SPIN_CAP) { atomicAdd(&(bar)[XB_TMO], 1u); break; } } } } while (0)

struct XcdBarrier {
    unsigned* bar; unsigned x;
    volatile LAS unsigned* st;
};

__device__ __forceinline__ XcdBarrier xcd_barrier_post(unsigned* bar, volatile LAS unsigned* st) {
    XcdBarrier b; b.bar = bar; b.x = xb_xcc_id(); b.st = st;
    if (threadIdx.x == 0) (void)xb_add(&bar[XB_XCNT(b.x)], 1u);
    return b;
}
__device__ __forceinline__ void xcd_barrier_complete(unsigned* bar, unsigned x, unsigned& nloc, unsigned& nx) {
    const unsigned G = gridDim.x * gridDim.y * gridDim.z;
    unsigned sum, cnt, mine, sp = 0u;
    for (;;) {
        sum = 0u; cnt = 0u; mine = 0u;
#pragma unroll
        for (unsigned j = 0; j < 16; ++j) { const unsigned c = xb_ld(&bar[XB_XCNT(j)]); sum += c; cnt += (c > 0u) ? 1u : 0u; mine = (j == x) ? c : mine; }
        if (sum == G) break;
        __builtin_amdgcn_s_sleep(1);
        if ((++sp & 255u) == 0u) { if (xb_ld(&bar[XB_TMO])) break; if (sp > XB_SPIN_CAP) { atomicAdd(&bar[XB_TMO], 1u); break; } }
    }
    nloc = mine > 0u ? mine : 1u; nx = cnt > 0u ? cnt : 1u;
}

__device__ __forceinline__ void xcd_barrier(const XcdBarrier& b) {
    asm volatile("s_waitcnt vmcnt(0)" ::: "memory");
    __syncthreads();
    if (threadIdx.x == 0) {
        unsigned* bar = b.bar;
        __builtin_amdgcn_s_waitcnt(0);
        unsigned nloc = b.st[0], nx = b.st[1];
        if (nloc == 0u) { xcd_barrier_complete(bar, b.x, nloc, nx); b.st[0] = nloc; b.st[1] = nx; }
        const unsigned old = xb_add(&bar[XB_XSUB(b.x)], 1u);
        const unsigned gen = old / nloc;
        if (old + 1u == (gen + 1u) * nloc) {
            __builtin_amdgcn_fence(__ATOMIC_RELEASE, "agent");
            asm volatile("s_waitcnt vmcnt(0)" ::: "memory");
            const unsigned og = xb_add(&bar[XB_TOP], 1u);
            const unsigned tg = og / nx;
            if (og + 1u == (tg + 1u) * nx) xb_add(&bar[XB_TOPGEN], 1u);
            else XB_SPIN(xb_ld(&bar[XB_TOPGEN]) == tg, bar);
            __builtin_amdgcn_fence(__ATOMIC_ACQUIRE, "agent");
            xb_add(&bar[XB_XGEN(b.x)], 1u);
            asm volatile("s_waitcnt vmcnt(0)" ::: "memory");
        } else {
            XB_SPIN(xb_ld(&bar[XB_XGEN(b.x)]) == gen, bar);
            __builtin_amdgcn_fence(__ATOMIC_ACQUIRE, "agent");
            asm volatile("s_waitcnt vmcnt(0)" ::: "memory");
        }
    }
    __syncthreads();
}
constexpr int TP = 4096, BP = 4, MP = BP * TP;
constexpr int BS = 128, TS = 4, MS = BS * TS;
constexpr int MT = MP + MS;
constexpr int DM = 1024, RW = 512, SC = 1792, NINP = 3840, FF = 2816, NUP = 5632;
constexpr int PAST = 2048, NPAGES = 16, LS = PAST + TS;
constexpr float ALPHA = 1.189207115002721f;
constexpr float LN_EPS = 1e-5f, GN_EPS = 64e-5f;
constexpr float QSCALE = 0.125f * 1.4426950408889634f;
constexpr float LOG2E = 1.4426950408889634f;
constexpr size_t O_YP = 0, O_YS = 16777216, O_KP = 17301504, O_VP = 25690112, O_KIP = 34078720, O_WKVP = 35127296, O_SHP = 35258368, O_CVP = 35265536,
                 O_KS = 35288064, O_VS = 35550208, O_KIS = 35812352, O_WKVS = 35845120, O_SHS = 40039424, O_CVS = 40268800, O_END = 40989696;

namespace pg8 {
__device__ __forceinline__ u32x4 pack8(const f32x4 a, const f32x4 b) { u32x4 w; w.x = cvt_pk_bf16(a[0], a[1]); w.y = cvt_pk_bf16(a[2], a[3]); w.z = cvt_pk_bf16(b[0], b[1]); w.w = cvt_pk_bf16(b[2], b[3]); return w; }
struct EpiIn {
    static constexpr bool PERM = true, AFTER_DRAIN = false;
    float* prw; bf16_t* qb; bf16_t* kb; bf16_t* vb; float* qi; float* wi; float* out;
    __device__ __forceinline__ void operator()(const f32x4 (&acc)[2][2][4][2], const Unit& u, int wr, int wc, int fr, int fq) const {
        const int pn = u.pn; const bool samp = u.pm >= 64;
#pragma unroll
        for (int ai = 0; ai < 2; ++ai)
#pragma unroll
            for (int m = 0; m < 4; ++m) {
                const int row = u.pm * BM + ai * HALF + wr * 64 + m * 16 + fr;
                const int rs = row - MP;
#pragma unroll
                for (int bj = 0; bj < 2; ++bj) {
                    const int col = pn * BM + bj * HALF + wc * 32 + 8 * fq;
                    const f32x4 v0 = acc[ai][bj][m][0], v1 = acc[ai][bj][m][1];
                    if (pn < 7) {
                        float* p = prw + (size_t)row * SC + col; *(f32x4*)p = v0; *(f32x4*)(p + 4) = v1;
                        const bool last = samp ? ((rs & 3) == 3) : ((row & (TP - 1)) == TP - 1);
                        if (last) { float* o = samp ? out + O_SHS + (size_t)(rs >> 2) * SC + col : out + O_SHP + (size_t)(row >> 12) * SC + col; *(f32x4*)o = v0; *(f32x4*)(o + 4) = v1; }
                    } else if (pn < 9) {
                        const int c = col - 1792; *(u32x4*)(qb + (size_t)row * RW + c) = pack8(v0 * QSCALE, v1 * QSCALE);
                    } else if (pn < 11) {
                        const int c = col - 2304; float* o = samp ? out + O_KS + (size_t)rs * RW + c : out + O_KP + (size_t)row * RW + c; *(f32x4*)o = v0; *(f32x4*)(o + 4) = v1;
                        *(u32x4*)(kb + (size_t)row * RW + c) = pack8(v0, v1);
                    } else if (pn < 13) {
                        const int c = col - 2816; float* o = samp ? out + O_VS + (size_t)rs * RW + c : out + O_VP + (size_t)row * RW + c; *(f32x4*)o = v0; *(f32x4*)(o + 4) = v1;
                        *(u32x4*)(vb + (size_t)row * RW + c) = pack8(v0, v1);
                    } else if (pn == 13) {
                        const int c = col - 3328; float* o = qi + (size_t)row * 256 + c; *(f32x4*)o = v0; *(f32x4*)(o + 4) = v1;
                    } else {
                        const int c = col - 3584;
                        if (c < 64) { float* o = samp ? out + O_KIS + (size_t)rs * 64 + c : out + O_KIP + (size_t)row * 64 + c; *(f32x4*)o = v0; *(f32x4*)(o + 4) = v1; }
                        else if (c == 64) { *(f32x4*)(wi + (size_t)row * 4) = v0 * 0.5f; }
                    }
                }
            }
    }
};
struct EpiRes {
    static constexpr bool PERM = true, AFTER_DRAIN = false;
    const float* resP; const float* resS; float* out;
    __device__ __forceinline__ void operator()(const f32x4 (&acc)[2][2][4][2], const Unit& u, int wr, int wc, int fr, int fq) const {
        const bool samp = u.pm >= 64;
#pragma unroll
        for (int ai = 0; ai < 2; ++ai)
#pragma unroll
            for (int m = 0; m < 4; ++m) {
                const int row = u.pm * BM + ai * HALF + wr * 64 + m * 16 + fr;
                const float* rr = samp ? resS + (size_t)(row - MP) * DM : resP + (size_t)row * DM;
#pragma unroll
                for (int bj = 0; bj < 2; ++bj) {
                    const int col = u.pn * BM + bj * HALF + wc * 32 + 8 * fq;
                    const f32x4 r0 = *(const f32x4*)(rr + col), r1 = *(const f32x4*)(rr + col + 4);
                    float* o = out + (size_t)row * DM + col;
                    *(f32x4*)o = r0 * ALPHA + acc[ai][bj][m][0]; *(f32x4*)(o + 4) = r1 * ALPHA + acc[ai][bj][m][1];
                }
            }
    }
};
struct EpiUp {
    static constexpr bool PERM = true, AFTER_DRAIN = false;
    bf16_t* uc; bf16_t* ul; float* out;
    __device__ __forceinline__ void operator()(const f32x4 (&acc)[2][2][4][2], const Unit& u, int wr, int wc, int fr, int fq) const {
        const bool samp = u.pm >= 64;
#pragma unroll
        for (int ai = 0; ai < 2; ++ai)
#pragma unroll
            for (int m = 0; m < 4; ++m) {
                const int row = u.pm * BM + ai * HALF + wr * 64 + m * 16 + fr;
                const int c = u.pn * HALF + wc * 32 + 8 * fq;
                *(u32x4*)(uc + (size_t)row * FF + c) = pack8(acc[ai][0][m][0], acc[ai][0][m][1]);
                *(u32x4*)(ul + (size_t)row * FF + c) = pack8(acc[ai][1][m][0], acc[ai][1][m][1]);
                if (samp) { const int rs = row - MP, t = rs & 3; if (t >= 2) { float* o = out + O_CVS + ((size_t)(rs >> 2) * 2 + (t - 2)) * FF + c; *(f32x4*)o = acc[ai][0][m][0]; *(f32x4*)(o + 4) = acc[ai][0][m][1]; } }
                else { const int t = row & (TP - 1); if (t >= TP - 2) { float* o = out + O_CVP + ((size_t)(row >> 12) * 2 + (t - (TP - 2))) * FF + c; *(f32x4*)o = acc[ai][0][m][0]; *(f32x4*)(o + 4) = acc[ai][0][m][1]; } }
            }
    }
};
}
constexpr size_t MiB = 1u << 20;
constexpr size_t WS_CTL = 0, CTL_ZERO_BYTES = 1 * MiB;
constexpr size_t WS_WIN = 2 * MiB;
constexpr size_t WS_WOUT = 10 * MiB;
constexpr size_t WS_WUP = 12 * MiB;
constexpr size_t WS_WDN = 24 * MiB;
constexpr size_t WS_XB = 32 * MiB;
constexpr size_t WS_PRW = 66 * MiB;
constexpr size_t WS_QB = 182 * MiB;
constexpr size_t WS_KB = 199 * MiB;
constexpr size_t WS_VB = 216 * MiB;
constexpr size_t WS_QI = 233 * MiB;
constexpr size_t WS_WI = 250 * MiB;
constexpr size_t WS_SCAN = 251 * MiB;
constexpr size_t WS_G = 454 * MiB;
constexpr size_t WS_RKR = 488 * MiB;
constexpr size_t WS_YS = 489 * MiB;
constexpr size_t WS_MASK = 523 * MiB;
constexpr size_t WS_SEL = 532 * MiB;
constexpr size_t WS_MIX = 533 * MiB;
constexpr size_t WS_Z = 567 * MiB;
constexpr size_t WS_X1 = 634 * MiB;
constexpr size_t WS_X1B = 701 * MiB;
constexpr size_t WS_UC = 735 * MiB;
constexpr size_t WS_UL = 826 * MiB;
constexpr size_t WS_H = 917 * MiB;
constexpr size_t WS_END = 1008 * MiB;
constexpr int CW_BAR = 4096;
constexpr int SREC = 392;

constexpr int RING_BYTES = 131072, LDSCTL_OFF = RING_BYTES, MISC_OFF = LDSCTL_OFF + 320, LDS_BYTES = 147456;
constexpr int NWAVES = 8, NTHR = 512;
constexpr int NPHASE = 12;

__device__ __forceinline__ float bf2f(unsigned short h) { return __builtin_bit_cast(float, (unsigned)h << 16); }
__device__ __forceinline__ float wave_sum(float v) {
#pragma unroll
    for (int o = 1; o < 64; o <<= 1) v += __shfl_xor(v, o);
    return v;
}
template <int CTRL> __device__ __forceinline__ float dppf(float x) { return __builtin_bit_cast(float, __builtin_amdgcn_update_dpp(0, __builtin_bit_cast(int, x), CTRL, 0xf, 0xf, true)); }
__device__ __forceinline__ float sum16(float x) {
    x += dppf<0xB1>(x); x += dppf<0x4E>(x); x += dppf<0x141>(x); x += dppf<0x140>(x); return x;
}
__device__ __forceinline__ float sum8(float x) {
    x += dppf<0xB1>(x); x += dppf<0x4E>(x); x += dppf<0x141>(x); return x;
}
__device__ __forceinline__ bf16x8 pack_bf8(const f32x4 a, const f32x4 b) {
    v4u w; w.x = pk2(a[0], a[1]); w.y = pk2(a[2], a[3]); w.z = pk2(b[0], b[1]); w.w = pk2(b[2], b[3]); return __builtin_bit_cast(bf16x8, w);
}
typedef float f32x16 __attribute__((ext_vector_type(16)));
typedef float f32x2 __attribute__((ext_vector_type(2)));

struct Ctx {
    LAS unsigned char* lds; int tid, lane, wave, vcu, G;
    const void* const* in_; float* out; unsigned char* ws;
};
#define INF(k) ((const float*)in[k])

template <int MODE> __device__ __forceinline__ void p0_tr_item(const float* W, int K, int N, int nblk, bf16* WT, LAS float* scr, int item, int lane) {
    const int kb = item / nblk, nb = item % nblk, k0 = 64 * kb, n0 = 32 * nb;
    const int nl0 = lane & 31; const bool okn = (n0 + nl0) < N;
#pragma unroll 8
    for (int i = 0; i < 32; ++i) { const int kk = 2 * i + (lane >> 5); scr[kk * 33 + nl0] = okn ? W[(size_t)(k0 + kk) * N + n0 + nl0] : 0.f; }
    asm volatile("s_waitcnt lgkmcnt(0)" ::: "memory");
    const int c = lane & 7;
#pragma unroll
    for (int j = 0; j < 4; ++j) { const int nl = (lane >> 3) + 8 * j; const int n = n0 + nl; const LAS float* s = scr + (8 * c) * 33 + nl;
        int row = n;
        if (MODE == 2) row = (n < FF) ? 256 * (n >> 7) + (n & 127) : 256 * ((n - FF) >> 7) + 128 + ((n - FF) & 127);
        v4u o; o.x = pk2(s[0 * 33], s[1 * 33]); o.y = pk2(s[2 * 33], s[3 * 33]); o.z = pk2(s[4 * 33], s[5 * 33]); o.w = pk2(s[6 * 33], s[7 * 33]);
        *(GAS v4u*)(WT + (size_t)row * K + k0 + 8 * c) = o; }
    asm volatile("s_waitcnt lgkmcnt(0)" ::: "memory");
}
__device__ __forceinline__ void p0_prologue(const Ctx& C, const void* const* in) {
    LAS float* scr = (LAS float*)(C.lds + C.wave * 16384);
    const int gw = C.vcu * NWAVES + C.wave, NGW = C.G * NWAVES;
    constexpr int I_IN = 16 * 120, I_OUT = 16 * 32, I_UP = 16 * 176, I_DN = 44 * 32, NITEMS = I_IN + I_OUT + I_UP + I_DN;
    bf16* win = (bf16*)(C.ws + WS_WIN); bf16* wout = (bf16*)(C.ws + WS_WOUT); bf16* wup = (bf16*)(C.ws + WS_WUP); bf16* wdn = (bf16*)(C.ws + WS_WDN);
    for (int it = gw; it < NITEMS; it += NGW) {
        int r = it;
        if (r < I_IN) { p0_tr_item<0>(INF(10), DM, 3652, 120, win, scr, r, C.lane); continue; } r -= I_IN;
        if (r < I_OUT) { p0_tr_item<0>(INF(22), DM, DM, 32, wout, scr, r, C.lane); continue; } r -= I_OUT;
        if (r < I_UP) { p0_tr_item<2>(INF(25), DM, NUP, 176, wup, scr, r, C.lane); continue; } r -= I_UP;
        p0_tr_item<0>(INF(28), FF, DM, 32, wdn, scr, r, C.lane);
    }
    bf16* xb = (bf16*)(C.ws + WS_XB);
    for (int m = gw; m < MT; m += NGW) {
        const float* xr = (m < MP) ? INF(0) + (size_t)m * DM : INF(1) + (size_t)(m - MP) * DM;
        const GAS f32x4* x4 = (const GAS f32x4*)xr + C.lane;
        GAS unsigned long long* o8 = (GAS unsigned long long*)(xb + (size_t)m * DM) + C.lane;
#pragma unroll
        for (int j = 0; j < 4; ++j) { const f32x4 v = x4[64 * j]; o8[64 * j] = (unsigned long long)pk2(v.x, v.y) | ((unsigned long long)pk2(v.z, v.w) << 32); }
    }
}

__device__ __forceinline__ float sigmoidf_(float x) { return 1.f / (1.f + __expf(-x)); }
__device__ __forceinline__ void p2_prep(const Ctx& C, const void* const* in) {
    LAS float* act = (LAS float*)C.lds;
    const float* PRW = (const float*)(C.ws + WS_PRW);
    float* SCAN = (float*)(C.ws + WS_SCAN); float* Gb = (float*)(C.ws + WS_G); float* RKR = (float*)(C.ws + WS_RKR);
    const float* smu = INF(11); const float* sst = INF(7);
    const float* wup = INF(13); const float* aup = INF(15); const float* gup = INF(16);
    const int c = C.tid, h = C.wave, j = C.lane;
    const float mu_r = smu[c], mu_k = smu[RW + c], mu_v = smu[2 * RW + c];
    const float w0 = INF(12)[c], a0 = INF(14)[c], kkc = INF(17)[c], kac = INF(18)[c], rkc = INF(19)[c];
    for (int tile = C.vcu; tile < MT / 32; tile += C.G) {
        const int m0 = tile * 32;
        __syncthreads();
        {
            const int tok = C.tid >> 4, cg = C.tid & 15, m = m0 + tok, col0 = 1536 + cg * 16;
            const float* prow = PRW + (size_t)m * SC + col0; const float* pprev = prow - SC; bool zero = false;
            if (m < MP) { zero = (m & (TP - 1)) == 0; } else { const int ms = m - MP; if ((ms & 3) == 0) pprev = sst + (size_t)(ms >> 2) * SC + col0; }
#pragma unroll
            for (int i = 0; i < 4; ++i) {
                const f32x4 p = *(const f32x4*)(prow + 4 * i); f32x4 q = (f32x4){0.f, 0.f, 0.f, 0.f}; if (!zero) q = *(const f32x4*)(pprev + 4 * i);
                const f32x4 mu = *(const f32x4*)(smu + col0 + 4 * i); f32x4 s = p + (q - p) * mu;
                if (cg < 4) { for (int e = 0; e < 4; ++e) { const float ex = __expf(2.f * s[e]); s[e] = 1.f - 2.f / (ex + 1.f); } }
                else if (cg >= 8) { for (int e = 0; e < 4; ++e) s[e] = sigmoidf_(s[e]); }
                *(LAS f32x4*)(act + tok * 256 + cg * 16 + 4 * i) = s;
            }
        }
        __syncthreads();
        float aw[32], aa[32], ag[32];
#pragma unroll
        for (int t = 0; t < 32; ++t) { aw[t] = 0.f; aa[t] = 0.f; ag[t] = 0.f; }
        for (int k = 0; k < 64; k += 4) {
            const float w_0 = wup[(k + 0) * RW + c], w_1 = wup[(k + 1) * RW + c], w_2 = wup[(k + 2) * RW + c], w_3 = wup[(k + 3) * RW + c];
            const float a_0 = aup[(k + 0) * RW + c], a_1 = aup[(k + 1) * RW + c], a_2 = aup[(k + 2) * RW + c], a_3 = aup[(k + 3) * RW + c];
#pragma unroll
            for (int t = 0; t < 32; ++t) {
                const f32x4 x = *(const LAS f32x4*)(act + t * 256 + k); const f32x4 y = *(const LAS f32x4*)(act + t * 256 + 64 + k);
                aw[t] += x[0] * w_0 + x[1] * w_1 + x[2] * w_2 + x[3] * w_3; aa[t] += y[0] * a_0 + y[1] * a_1 + y[2] * a_2 + y[3] * a_3;
            }
        }
        for (int k = 0; k < 128; k += 4) {
            const float g_0 = gup[(k + 0) * RW + c], g_1 = gup[(k + 1) * RW + c], g_2 = gup[(k + 2) * RW + c], g_3 = gup[(k + 3) * RW + c];
#pragma unroll
            for (int t = 0; t < 32; ++t) { const f32x4 x = *(const LAS f32x4*)(act + t * 256 + 128 + k); ag[t] += x[0] * g_0 + x[1] * g_1 + x[2] * g_2 + x[3] * g_3; }
        }
        float pr_p = 0.f, pk_p = 0.f, pv_p = 0.f;
        if (m0 < MP) { if ((m0 & (TP - 1)) != 0) { const float* pp = PRW + (size_t)(m0 - 1) * SC; pr_p = pp[c]; pk_p = pp[RW + c]; pv_p = pp[2 * RW + c]; } }
#pragma unroll
        for (int t = 0; t < 32; ++t) {
            const int m = m0 + t; const float* pc = PRW + (size_t)m * SC;
            const float pr = pc[c], pk = pc[RW + c], pv = pc[2 * RW + c];
            if (m0 >= MP && (t & 3) == 0) { const float* ss = sst + (size_t)((m - MP) >> 2) * SC; pr_p = ss[c]; pk_p = ss[RW + c]; pv_p = ss[2 * RW + c]; }
            const float r = pr + (pr_p - pr) * mu_r, k = pk + (pk_p - pk) * mu_k, v = pv + (pv_p - pv) * mu_v;
            pr_p = pr; pk_p = pk; pv_p = pv;
            const float u = w0 + aw[t];
            const float wlog = -__logf(1.f + __expf(-u)) - 0.5f;
            const float decay = __expf(-__expf(wlog));
            const float a = sigmoidf_(a0 + aa[t]);
            float kk = k * kkc; const float ss2 = wave_sum(kk * kk); kk *= rsqrtf(fmaxf(ss2, 1e-24f));
            const float kp = k * (1.f + (a - 1.f) * kac);
            const float bb = kk * a, wr = decay * r;
            const float br = wave_sum(bb * r), kr = wave_sum(kp * r), rkr = wave_sum(r * kp * rkc);
            float* rec = SCAN + ((size_t)m * 8 + h) * SREC;
            rec[j] = decay; rec[64 + j] = kk; rec[128 + j] = bb; rec[192 + j] = kp; rec[256 + j] = wr; rec[320 + j] = v;
            if (j == 0) { rec[384] = br; rec[385] = kr; RKR[(size_t)m * 8 + h] = rkr; }
            Gb[(size_t)m * RW + c] = ag[t];
        }
    }
}

__device__ __forceinline__ unsigned long long topk_select(const LAS float* vals, int nvis, int lane) {
    const int nreg = (nvis + 63) >> 6;
    unsigned key[64];
#pragma unroll
    for (int g = 0; g < 8; ++g) {
        if (g * 8 < nreg) {
#pragma unroll
            for (int e = 0; e < 8; ++e) { const int i = g * 8 + e; const int kidx = 64 * i + lane;
                unsigned u = 0u;
                if (kidx < nvis) { const float v = vals[kidx]; u = __builtin_bit_cast(unsigned, v); if ((u << 1) == 0u) u = 0u; u = (u & 0x80000000u) ? ~u : (u | 0x80000000u); }
                key[i] = u; }
        } else {
#pragma unroll
            for (int e = 0; e < 8; ++e) key[g * 8 + e] = 0u;
        }
    }
    unsigned long long myword = 0ull;
    const unsigned long long lt = (lane == 0) ? 0ull : (~0ull >> (64 - lane));
    if (nvis <= 256) {
#pragma unroll
        for (int i = 0; i < 4; ++i) { const unsigned long long m = __ballot(64 * i + lane < nvis); if (lane == i) myword = m; }
        return myword;
    }
    unsigned T = 0u;
    for (int bit = 31; bit >= 0; --bit) {
        const unsigned cand = T | (1u << bit); int cnt = 0;
#pragma unroll
        for (int g = 0; g < 8; ++g) if (g * 8 < nreg) {
#pragma unroll
            for (int e = 0; e < 8; ++e) cnt += __popcll(__ballot(key[g * 8 + e] >= cand));
        }
        if (cnt >= 256) T = cand;
    }
    int cgt = 0;
#pragma unroll
    for (int g = 0; g < 8; ++g) if (g * 8 < nreg) {
#pragma unroll
        for (int e = 0; e < 8; ++e) cgt += __popcll(__ballot(key[g * 8 + e] > T));
    }
    const int need = 256 - cgt; int run = 0;
#pragma unroll
    for (int g = 0; g < 8; ++g) if (g * 8 < nreg) {
#pragma unroll
        for (int e = 0; e < 8; ++e) { const int i = g * 8 + e;
            const bool eq = key[i] == T; const unsigned long long em = __ballot(eq);
            const int before = run + __popcll(em & lt);
            const bool s = (key[i] > T) || (eq && before < need); run += __popcll(em);
            const unsigned long long m = __ballot(s); if (lane == i) myword = m; }
    }
    return myword;
}
__device__ __forceinline__ void p3_topk(const Ctx& C, const void* const* in) {
    const float* QI = (const float*)(C.ws + WS_QI); const float* WI = (const float*)(C.ws + WS_WI);
    unsigned long long* MASK = (unsigned long long*)(C.ws + WS_MASK); int* SEL = (int*)(C.ws + WS_SEL);
    const int lane = C.lane, wave = C.wave, hi = lane >> 5;
    constexpr int NU_P = MP / 8, NU = NU_P + BS;
    for (int unit = C.vcu; unit < NU; unit += C.G) {
        __syncthreads();
        if (unit < NU_P) {
            LAS float* idx = (LAS float*)C.lds;
            const int b = unit >> 9, t0 = (unit & 511) * 8, nkeys = t0 + 8;
            const int rho = lane & 31, q = rho >> 2, hh = rho & 3;
            const float* qrow = QI + ((size_t)(b * TP + t0 + q)) * 256 + hh * 64 + 8 * hi;
            bf16x8 af[4];
#pragma unroll
            for (int s = 0; s < 4; ++s) af[s] = pack_bf8(*(const f32x4*)(qrow + 16 * s), *(const f32x4*)(qrow + 16 * s + 4));
            f32x4 wiv[4];
#pragma unroll
            for (int g = 0; g < 4; ++g) wiv[g] = *(const f32x4*)(WI + ((size_t)(b * TP + t0 + 2 * g + hi)) * 4) * 0.125f;
            const float* KI = C.out + O_KIP + (size_t)b * TP * 64;
            const int ntile = (nkeys + 31) >> 5;
            for (int tile = wave; tile < ntile; tile += 8) {
                const int key = tile * 32 + rho;
                const float* krow = KI + (size_t)key * 64 + 8 * hi;
                f32x16 acc;
#pragma unroll
                for (int r = 0; r < 16; ++r) acc[r] = 0.f;
#pragma unroll
                for (int s = 0; s < 4; ++s) { const bf16x8 bf = pack_bf8(*(const f32x4*)(krow + 16 * s), *(const f32x4*)(krow + 16 * s + 4));
                    acc = __builtin_amdgcn_mfma_f32_32x32x16_bf16(af[s], bf, acc, 0, 0, 0); }
#pragma unroll
                for (int g = 0; g < 4; ++g) {
                    float v = 0.f;
#pragma unroll
                    for (int e = 0; e < 4; ++e) v += wiv[g][e] * fmaxf(acc[4 * g + e], 0.f);
                    idx[(2 * g + hi) * 4096 + key] = v;
                }
            }
            __syncthreads();
            const int t = t0 + wave;
            const unsigned long long w = topk_select(idx + wave * 4096, t + 1, lane);
            MASK[((size_t)(b * TP + t)) * 64 + lane] = w;
        } else {
            const int b = unit - NU_P;
            LAS float* qis = (LAS float*)C.lds;
            LAS float* wis = qis + 1024;
            LAS float* idx = qis + 1280;
            if (C.tid < 256) { const int row = C.tid >> 4, c4 = (C.tid & 15) * 4;
                *(LAS f32x4*)(qis + row * 64 + c4) = *(const f32x4*)(QI + ((size_t)(MP + b * 4 + (row >> 2))) * 256 + (row & 3) * 64 + c4); }
            if (C.tid < 16) wis[C.tid] = WI[((size_t)(MP + b * 4 + (C.tid >> 2))) * 4 + (C.tid & 3)] * 0.125f;
            __syncthreads();
            const int* pt = (const int*)in[5] + b * NPAGES;
            for (int s = C.tid; s < LS; s += NTHR) {
                const float* krow = (s < PAST) ? INF(4) + ((size_t)pt[s >> 7] * 128 + (s & 127)) * 64 : C.out + O_KIS + (size_t)(b * 4 + (s - PAST)) * 64;
                f32x4 kx[16];
#pragma unroll
                for (int i = 0; i < 16; ++i) kx[i] = *(const f32x4*)(krow + 4 * i);
#pragma unroll
                for (int t = 0; t < 4; ++t) {
                    float v = 0.f;
#pragma unroll
                    for (int hh = 0; hh < 4; ++hh) {
                        float d0 = 0.f, d1 = 0.f;
#pragma unroll
                        for (int i = 0; i < 16; i += 2) { const f32x4 qa = *(const LAS f32x4*)(qis + (t * 4 + hh) * 64 + 4 * i), qb = *(const LAS f32x4*)(qis + (t * 4 + hh) * 64 + 4 * i + 4);
                            d0 += kx[i][0] * qa[0] + kx[i][1] * qa[1] + kx[i][2] * qa[2] + kx[i][3] * qa[3];
                            d1 += kx[i + 1][0] * qb[0] + kx[i + 1][1] * qb[1] + kx[i + 1][2] * qb[2] + kx[i + 1][3] * qb[3]; }
                        v += wis[t * 4 + hh] * fmaxf(d0 + d1, 0.f);
                    }
                    idx[t * 2112 + s] = v;
                }
            }
            __syncthreads();
            if (wave < 4) {
                const int t = wave;
                unsigned long long w = topk_select(idx + t * 2112, PAST + t + 1, lane);
                int cnt = __popcll(w), pre = cnt;
#pragma unroll
                for (int o = 1; o < 64; o <<= 1) { const int x = __shfl_up(pre, o); if (lane >= o) pre += x; }
                int pos = pre - cnt; int* sel = SEL + (size_t)(b * 4 + t) * 256;
                while (w) { const int bit = __builtin_ctzll(w); if (pos < 256) sel[pos] = 64 * lane + bit; ++pos; w &= w - 1; }
            }
        }
    }
}

struct ScanVec { f32x4 w, kk, b, k, wr; float v; float br, kr; };
__device__ __forceinline__ float scan_step(float (&S)[4], const ScanVec& x) {
    float p1 = S[0] * x.kk[0] + S[1] * x.kk[1] + S[2] * x.kk[2] + S[3] * x.kk[3];
    float p2 = S[0] * x.wr[0] + S[1] * x.wr[1] + S[2] * x.wr[2] + S[3] * x.wr[3];
    float t0 = S[0] * x.w[0] + x.v * x.k[0], t1 = S[1] * x.w[1] + x.v * x.k[1], t2 = S[2] * x.w[2] + x.v * x.k[2], t3 = S[3] * x.w[3] + x.v * x.k[3];
    p1 = sum16(p1); p2 = sum16(p2);
    const float sa = -p1;
    S[0] = t0 + sa * x.b[0]; S[1] = t1 + sa * x.b[1]; S[2] = t2 + sa * x.b[2]; S[3] = t3 + sa * x.b[3];
    return p2 + sa * x.br + x.v * x.kr;
}
__device__ __forceinline__ void p4_scan(const Ctx& C, const void* const* in) {
    const float* SCAN = (const float*)(C.ws + WS_SCAN); float* YS = (float*)(C.ws + WS_YS);
    const int lane = C.lane, wave = C.wave, rg = lane >> 4, jl = lane & 15;
    {
        const float* st = INF(6);
        for (int u = C.vcu * NWAVES + wave; u < BS * 8 * 16; u += C.G * NWAVES) {
            const int bh = u >> 4, b = bh >> 3, h = bh & 7, i = (u & 15) * 4 + rg;
            const f32x4 s4 = *(const f32x4*)(st + ((size_t)bh * 64 + i) * 64 + 4 * jl);
            float S[4] = {s4[0], s4[1], s4[2], s4[3]};
#pragma unroll
            for (int t = 0; t < 4; ++t) {
                const int m = MP + b * 4 + t; const float* rec = SCAN + ((size_t)m * 8 + h) * SREC;
                ScanVec x; x.w = *(const f32x4*)(rec + 4 * jl); x.kk = *(const f32x4*)(rec + 64 + 4 * jl); x.b = *(const f32x4*)(rec + 128 + 4 * jl);
                x.k = *(const f32x4*)(rec + 192 + 4 * jl); x.wr = *(const f32x4*)(rec + 256 + 4 * jl); x.v = rec[320 + i]; x.br = rec[384]; x.kr = rec[385];
                const float y = scan_step(S, x);
                if (jl == 0) YS[(size_t)m * RW + h * 64 + i] = y;
            }
            *(f32x4*)(C.out + O_WKVS + ((size_t)bh * 64 + i) * 64 + 4 * jl) = (f32x4){S[0], S[1], S[2], S[3]};
        }
    }
    __syncthreads();
    for (int unit = C.vcu; unit < 256; unit += C.G) {
        const int bh = unit >> 3, b = bh >> 3, h = bh & 7, i = (unit & 7) * 8 + wave * 4 + rg;
        LAS float* buf = (LAS float*)C.lds;
        constexpr int CH = 16, CHF4 = CH * SREC / 4;
        const float* base = SCAN + ((size_t)(b * TP) * 8 + h) * SREC;
        f32x4 stg[4];
#define SC_GLOAD(t0_) do { _Pragma("unroll") for (int k_ = 0; k_ < 4; ++k_) { const int q_ = C.tid + k_ * NTHR; if (q_ < CHF4) { const int s_ = q_ / 98, off_ = q_ - s_ * 98; stg[k_] = *(const f32x4*)(base + (size_t)((t0_) + s_) * 8 * SREC + off_ * 4); } } } while (0)
#define SC_LSTORE(bi_) do { _Pragma("unroll") for (int k_ = 0; k_ < 4; ++k_) { const int q_ = C.tid + k_ * NTHR; if (q_ < CHF4) *(LAS f32x4*)(buf + (bi_) * (CH * SREC) + q_ * 4) = stg[k_]; } } while (0)
        SC_GLOAD(0); SC_LSTORE(0); __syncthreads();
        float S[4] = {0.f, 0.f, 0.f, 0.f};
        for (int ch = 0; ch < TP / CH; ++ch) {
            if (ch + 1 < TP / CH) SC_GLOAD((ch + 1) * CH);
            if (wave < 2) {
                const LAS float* cb = buf + (ch & 1) * (CH * SREC);
#pragma unroll 4
                for (int s = 0; s < CH; ++s) {
                    const LAS float* rec = cb + s * SREC;
                    ScanVec x; x.w = *(const LAS f32x4*)(rec + 4 * jl); x.kk = *(const LAS f32x4*)(rec + 64 + 4 * jl); x.b = *(const LAS f32x4*)(rec + 128 + 4 * jl);
                    x.k = *(const LAS f32x4*)(rec + 192 + 4 * jl); x.wr = *(const LAS f32x4*)(rec + 256 + 4 * jl); x.v = rec[320 + i];
                    const f32x2 bk = *(const LAS f32x2*)(rec + 384); x.br = bk[0]; x.kr = bk[1];
                    const float y = scan_step(S, x);
                    if (jl == 0) YS[((size_t)(b * TP + ch * CH + s)) * RW + h * 64 + i] = y;
                }
            }
            if (ch + 1 < TP / CH) SC_LSTORE((ch + 1) & 1);
            __syncthreads();
        }
        if (wave < 2) *(f32x4*)(C.out + O_WKVP + ((size_t)bh * 64 + i) * 64 + 4 * jl) = (f32x4){S[0], S[1], S[2], S[3]};
    }
}
__device__ __forceinline__ void p5_post(const Ctx& C, const void* const* in) {
    const float* YS = (const float*)(C.ws + WS_YS); const float* Gb = (const float*)(C.ws + WS_G); const float* RKR = (const float*)(C.ws + WS_RKR);
    const float* SCAN = (const float*)(C.ws + WS_SCAN); bf16* MIX = (bf16*)(C.ws + WS_MIX);
    const int c = C.tid, h = C.wave, j = C.lane;
    const float gg = INF(20)[c], gb = INF(21)[c];
    for (int m = C.vcu; m < MT; m += C.G) {
        const float y = YS[(size_t)m * RW + c];
        const float mu = wave_sum(y) * (1.f / 64.f); const float d = y - mu; const float var = wave_sum(d * d) * (1.f / 64.f);
        const float yn = d * rsqrtf(var + GN_EPS) * gg + gb;
        const float v = SCAN[((size_t)m * 8 + h) * SREC + 320 + j];
        const float o = (yn + RKR[(size_t)m * 8 + h] * v) * Gb[(size_t)m * RW + c];
        MIX[(size_t)m * DM + c] = (bf16)f2bf(o);
    }
}
__device__ __forceinline__ int t5_bucket(int d) {
    if (d < 16) return d;
    int b = 16;
    b += (d >= 19); b += (d >= 21); b += (d >= 24); b += (d >= 27); b += (d >= 31); b += (d >= 35); b += (d >= 40); b += (d >= 46);
    b += (d >= 52); b += (d >= 59); b += (d >= 67); b += (d >= 77); b += (d >= 87); b += (d >= 99); b += (d >= 113);
    return b;
}
constexpr int KROW = 72, VROW = 68;
constexpr int ATT_KB = 64 * KROW * 2, ATT_VB = 64 * VROW * 2;
__device__ __forceinline__ void attn_prompt_unit(const Ctx& C, int b, int h, int qb, const LAS float* btab) {
    const bf16* QB = (const bf16*)(C.ws + WS_QB); const bf16* KB = (const bf16*)(C.ws + WS_KB); const bf16* VB = (const bf16*)(C.ws + WS_VB);
    const unsigned long long* MASK = (const unsigned long long*)(C.ws + WS_MASK); bf16* MIX = (bf16*)(C.ws + WS_MIX);
    LAS unsigned char* kbuf = C.lds; LAS unsigned char* vbuf = C.lds + 2 * ATT_KB;
    const int lane = C.lane, wave = C.wave, r32 = lane & 31, hi = lane >> 5;
    const int q0 = qb * 256, qw0 = q0 + wave * 32, q = qw0 + r32;
    const size_t rowb = (size_t)b * TP;
    const int NT = (q0 + 256) / 64;
    bf16x8 qf[4];
#pragma unroll
    for (int s = 0; s < 4; ++s) qf[s] = *(const bf16x8*)(QB + (rowb + q) * RW + h * 64 + 16 * s + 8 * hi);
    const unsigned long long* mrow = MASK + (rowb + q) * 64;
    const int srow = C.tid >> 3, sch = C.tid & 7;
    const bf16* kg = KB + (rowb + srow) * RW + h * 64 + sch * 8; const bf16* vg = VB + (rowb + srow) * RW + h * 64 + sch * 8;
    v4u kst, vst;
#define ATT_GLOAD(t) do { kst = *(const v4u*)(kg + (size_t)(t) * 64 * RW); vst = *(const v4u*)(vg + (size_t)(t) * 64 * RW); } while (0)
#define ATT_LSTORE(bi) do { *(LAS v4u*)(kbuf + (bi) * ATT_KB + srow * (KROW * 2) + sch * 16) = kst; \
        LAS unsigned short* vt_ = (LAS unsigned short*)(vbuf + (bi) * ATT_VB) + (sch * 8) * VROW + srow; \
        vt_[0 * VROW] = (unsigned short)(vst.x & 0xffffu); vt_[1 * VROW] = (unsigned short)(vst.x >> 16); vt_[2 * VROW] = (unsigned short)(vst.y & 0xffffu); vt_[3 * VROW] = (unsigned short)(vst.y >> 16); \
        vt_[4 * VROW] = (unsigned short)(vst.z & 0xffffu); vt_[5 * VROW] = (unsigned short)(vst.z >> 16); vt_[6 * VROW] = (unsigned short)(vst.w & 0xffffu); vt_[7 * VROW] = (unsigned short)(vst.w >> 16); } while (0)
    __syncthreads();
    ATT_GLOAD(0); ATT_LSTORE(0);
    __syncthreads();
    f32x16 o0, o1;
#pragma unroll
    for (int r = 0; r < 16; ++r) { o0[r] = 0.f; o1[r] = 0.f; }
    float mrun = -1e30f, lrun = 0.f;
    unsigned long long mw = mrow[0];
    for (int t = 0; t < NT; ++t) {
        const int bi = t & 1;
        if (t + 1 < NT) ATT_GLOAD(t + 1);
        const unsigned long long mcur = mw; if (t + 1 < NT) mw = mrow[t + 1];
        const int kv0 = t * 64;
        if (kv0 <= qw0 + 31) {
            f32x16 p0, p1;
#pragma unroll
            for (int r = 0; r < 16; ++r) { p0[r] = 0.f; p1[r] = 0.f; }
            const LAS unsigned char* kb0 = kbuf + bi * ATT_KB + r32 * (KROW * 2) + hi * 16;
#pragma unroll
            for (int s = 0; s < 4; ++s) {
                const bf16x8 ka = *(const LAS bf16x8*)(kb0 + s * 32), kb2 = *(const LAS bf16x8*)(kb0 + 32 * (KROW * 2) + s * 32);
                p0 = __builtin_amdgcn_mfma_f32_32x32x16_bf16(ka, qf[s], p0, 0, 0, 0);
                p1 = __builtin_amdgcn_mfma_f32_32x32x16_bf16(kb2, qf[s], p1, 0, 0, 0);
            }
            if (kv0 + 63 + 113 > qw0) {
#pragma unroll
                for (int r = 0; r < 16; ++r) { const int kv = kv0 + (r & 3) + 8 * (r >> 2) + 4 * hi;
                    int d0 = q - kv; d0 = d0 < 0 ? 0 : (d0 > 127 ? 127 : d0); int d1 = q - kv - 32; d1 = d1 < 0 ? 0 : (d1 > 127 ? 127 : d1);
                    p0[r] += btab[h * 128 + d0]; p1[r] += btab[h * 128 + d1]; }
            }
            float mx = p0[0];
#pragma unroll
            for (int r = 1; r < 16; ++r) mx = fmaxf(mx, p0[r]);
#pragma unroll
            for (int r = 0; r < 16; ++r) mx = fmaxf(mx, p1[r]);
            mx = fmaxf(mx, __shfl_xor(mx, 32));
            const float mnew = fmaxf(mrun, mx);
            const float alpha = __builtin_amdgcn_exp2f(mrun - mnew);
            mrun = mnew;
            const unsigned wlo = (unsigned)mcur >> (4 * hi), whi = (unsigned)(mcur >> 32) >> (4 * hi);
            float ls = 0.f;
#pragma unroll
            for (int r = 0; r < 16; ++r) { const int pos = (r & 3) + 8 * (r >> 2);
                const int m0 = __builtin_amdgcn_sbfe(wlo, pos, 1), m1 = __builtin_amdgcn_sbfe(whi, pos, 1);
                const float e0 = __builtin_amdgcn_exp2f(p0[r] - mnew), e1 = __builtin_amdgcn_exp2f(p1[r] - mnew);
                p0[r] = __builtin_bit_cast(float, __builtin_bit_cast(int, e0) & m0); p1[r] = __builtin_bit_cast(float, __builtin_bit_cast(int, e1) & m1);
                ls += p0[r] + p1[r]; }
            lrun = lrun * alpha + ls;
            if (__any(alpha != 1.f)) {
#pragma unroll
                for (int r = 0; r < 16; ++r) { o0[r] *= alpha; o1[r] *= alpha; }
            }
            const LAS unsigned char* vb0 = vbuf + bi * ATT_VB + r32 * (VROW * 2) + hi * 8;
#pragma unroll
            for (int jj = 0; jj < 4; ++jj) {
                f32x4 pa, pb;
                if (jj == 0) { pa = (f32x4){p0[0], p0[1], p0[2], p0[3]}; pb = (f32x4){p0[4], p0[5], p0[6], p0[7]}; }
                else if (jj == 1) { pa = (f32x4){p0[8], p0[9], p0[10], p0[11]}; pb = (f32x4){p0[12], p0[13], p0[14], p0[15]}; }
                else if (jj == 2) { pa = (f32x4){p1[0], p1[1], p1[2], p1[3]}; pb = (f32x4){p1[4], p1[5], p1[6], p1[7]}; }
                else { pa = (f32x4){p1[8], p1[9], p1[10], p1[11]}; pb = (f32x4){p1[12], p1[13], p1[14], p1[15]}; }
                const bf16x8 pf = pack_bf8(pa, pb);
                typedef unsigned u32x2 __attribute__((ext_vector_type(2)));
                const u32x2 a0 = *(const LAS u32x2*)(vb0 + jj * 32), a1 = *(const LAS u32x2*)(vb0 + jj * 32 + 16);
                const u32x2 c0 = *(const LAS u32x2*)(vb0 + 32 * (VROW * 2) + jj * 32), c1 = *(const LAS u32x2*)(vb0 + 32 * (VROW * 2) + jj * 32 + 16);
                const bf16x8 va = __builtin_bit_cast(bf16x8, (v4u){a0.x, a0.y, a1.x, a1.y}), vc = __builtin_bit_cast(bf16x8, (v4u){c0.x, c0.y, c1.x, c1.y});
                o0 = __builtin_amdgcn_mfma_f32_32x32x16_bf16(va, pf, o0, 0, 0, 0);
                o1 = __builtin_amdgcn_mfma_f32_32x32x16_bf16(vc, pf, o1, 0, 0, 0);
            }
        }
        if (t + 1 < NT) ATT_LSTORE(bi ^ 1);
        __syncthreads();
    }
#undef ATT_GLOAD
#undef ATT_LSTORE
    const float ltot = lrun + __shfl_xor(lrun, 32);
    const float inv = 1.f / ltot;
    bf16* orow = MIX + (rowb + q) * DM + RW + h * 64;
#pragma unroll
    for (int g = 0; g < 4; ++g) {
        const int d = 8 * g + 4 * hi;
        typedef unsigned u32x2 __attribute__((ext_vector_type(2)));
        u32x2 w0, w1;
        w0.x = pk2(o0[4 * g] * inv, o0[4 * g + 1] * inv); w0.y = pk2(o0[4 * g + 2] * inv, o0[4 * g + 3] * inv);
        w1.x = pk2(o1[4 * g] * inv, o1[4 * g + 1] * inv); w1.y = pk2(o1[4 * g + 2] * inv, o1[4 * g + 3] * inv);
        *(u32x2*)(orow + d) = w0; *(u32x2*)(orow + 32 + d) = w1;
    }
}
__device__ __forceinline__ void attn_sample_query(const Ctx& C, const void* const* in, int qi_, const LAS float* btab) {
    const bf16* QB = (const bf16*)(C.ws + WS_QB); const int* SEL = (const int*)(C.ws + WS_SEL); bf16* MIX = (bf16*)(C.ws + WS_MIX);
    const int lane = C.lane, hh = lane >> 3, ch = lane & 7;
    const int b = qi_ >> 2, t = qi_ & 3, m = MP + qi_, qpos = PAST + t;
    float qv[8];
    { const v4u qq = *(const v4u*)(QB + (size_t)m * RW + hh * 64 + ch * 8);
      qv[0] = bf2f(qq.x & 0xffffu); qv[1] = bf2f(qq.x >> 16); qv[2] = bf2f(qq.y & 0xffffu); qv[3] = bf2f(qq.y >> 16);
      qv[4] = bf2f(qq.z & 0xffffu); qv[5] = bf2f(qq.z >> 16); qv[6] = bf2f(qq.w & 0xffffu); qv[7] = bf2f(qq.w >> 16); }
    const int* pt = (const int*)in[5] + b * NPAGES;
    const int* sel = SEL + (size_t)qi_ * 256;
    const float* ck = INF(2); const float* cv = INF(3);
    float acc[8] = {0.f, 0.f, 0.f, 0.f, 0.f, 0.f, 0.f, 0.f}; float mrun = -1e30f, lrun = 0.f;
    for (int j0 = 0; j0 < 256; j0 += 4) {
        f32x4 k0[4], k1[4], v0[4], v1[4]; float bias[4];
#pragma unroll
        for (int u = 0; u < 4; ++u) {
            const int s = sel[j0 + u];
            const float *kr, *vr;
            if (s < PAST) { const size_t row = (size_t)pt[s >> 7] * 128 + (s & 127); kr = ck + row * RW; vr = cv + row * RW; }
            else { const size_t row = (size_t)(b * 4 + (s - PAST)); kr = C.out + O_KS + row * RW; vr = C.out + O_VS + row * RW; }
            kr += hh * 64 + ch * 8; vr += hh * 64 + ch * 8;
            k0[u] = *(const f32x4*)kr; k1[u] = *(const f32x4*)(kr + 4); v0[u] = *(const f32x4*)vr; v1[u] = *(const f32x4*)(vr + 4);
            int d = qpos - s; d = d < 0 ? 0 : (d > 127 ? 127 : d); bias[u] = btab[1024 + hh * 128 + d];
        }
#pragma unroll
        for (int u = 0; u < 4; ++u) {
            float p = qv[0] * k0[u][0] + qv[1] * k0[u][1] + qv[2] * k0[u][2] + qv[3] * k0[u][3] + qv[4] * k1[u][0] + qv[5] * k1[u][1] + qv[6] * k1[u][2] + qv[7] * k1[u][3];
            p = sum8(p) + bias[u];
            const float mnew = fmaxf(mrun, p); const float alpha = __builtin_amdgcn_exp2f(mrun - mnew), e = __builtin_amdgcn_exp2f(p - mnew);
            mrun = mnew; lrun = lrun * alpha + e;
            acc[0] = acc[0] * alpha + e * v0[u][0]; acc[1] = acc[1] * alpha + e * v0[u][1]; acc[2] = acc[2] * alpha + e * v0[u][2]; acc[3] = acc[3] * alpha + e * v0[u][3];
            acc[4] = acc[4] * alpha + e * v1[u][0]; acc[5] = acc[5] * alpha + e * v1[u][1]; acc[6] = acc[6] * alpha + e * v1[u][2]; acc[7] = acc[7] * alpha + e * v1[u][3];
        }
    }
    const float inv = 1.f / lrun;
    v4u w; w.x = pk2(acc[0] * inv, acc[1] * inv); w.y = pk2(acc[2] * inv, acc[3] * inv); w.z = pk2(acc[4] * inv, acc[5] * inv); w.w = pk2(acc[6] * inv, acc[7] * inv);
    *(v4u*)(MIX + (size_t)m * DM + RW + hh * 64 + ch * 8) = w;
}
__device__ __forceinline__ void p5_attn(const Ctx& C, const void* const* in) {
    LAS float* btab = (LAS float*)(C.lds + 2 * ATT_KB + 2 * ATT_VB);
    const float* rb = INF(9);
    for (int i = C.tid; i < 1024; i += NTHR) { const int hh = i >> 7, d = i & 127; const float bv = rb[t5_bucket(d) * 8 + hh];
        btab[i] = (bv - rb[31 * 8 + hh]) * LOG2E; btab[1024 + i] = bv * LOG2E; }
    __syncthreads();
    for (int qi_ = C.vcu * NWAVES + C.wave; qi_ < MS; qi_ += C.G * NWAVES) attn_sample_query(C, in, qi_, btab);
    for (int u = C.vcu; u < 512; u += C.G) {
        const int bh = (u & 255) >> 3, s = u & 7, qb = (u < 256) ? s : 15 - s;
        attn_prompt_unit(C, bh >> 3, bh & 7, qb, btab);
    }
}

__device__ __forceinline__ void ln_rows(const Ctx& C, const float* Z, const float* g, const float* bt, float* outP, float* outS, bf16* ob) {
    const int gw = C.vcu * NWAVES + C.wave, NGW = C.G * NWAVES;
    f32x4 gv[4], bv[4];
#pragma unroll
    for (int j = 0; j < 4; ++j) { gv[j] = *((const f32x4*)g + C.lane + 64 * j); bv[j] = *((const f32x4*)bt + C.lane + 64 * j); }
    for (int m = gw; m < MT; m += NGW) {
        const f32x4* zr = (const f32x4*)(Z + (size_t)m * DM) + C.lane;
        f32x4 v[4]; float s = 0.f;
#pragma unroll
        for (int j = 0; j < 4; ++j) { v[j] = zr[64 * j]; s += (v[j].x + v[j].y) + (v[j].z + v[j].w); }
        const float mean = wave_sum(s) * (1.f / DM); float s2 = 0.f;
#pragma unroll
        for (int j = 0; j < 4; ++j) { v[j] = v[j] - mean; s2 += (v[j].x * v[j].x + v[j].y * v[j].y) + (v[j].z * v[j].z + v[j].w * v[j].w); }
        const float rstd = rsqrtf(wave_sum(s2) * (1.f / DM) + LN_EPS);
        float* orow = (m < MP) ? outP + (size_t)m * DM : outS + (size_t)(m - MP) * DM;
#pragma unroll
        for (int j = 0; j < 4; ++j) { const f32x4 o = v[j] * rstd * gv[j] + bv[j]; *((f32x4*)orow + C.lane + 64 * j) = o;
            if (ob) *((unsigned long long*)(ob + (size_t)m * DM) + C.lane + 64 * j) = (unsigned long long)pk2(o.x, o.y) | ((unsigned long long)pk2(o.z, o.w) << 32); }
    }
}

__device__ __forceinline__ void p9_conv(const Ctx& C, const void* const* in) {
    const bf16* UC = (const bf16*)(C.ws + WS_UC); const bf16* UL = (const bf16*)(C.ws + WS_UL); bf16* H = (bf16*)(C.ws + WS_H);
    const float* cw = INF(26); const float* cb = INF(27); const float* cst = INF(8);
    constexpr int CPR = FF / 8;
    const long total = (long)MT * CPR;
    for (long it = (long)C.vcu * NTHR + C.tid; it < total; it += (long)C.G * NTHR) {
        const int m = (int)(it / CPR), c = (int)(it - (long)m * CPR) * 8;
        int t; const float* prev = nullptr;
        if (m < MP) t = m & (TP - 1); else { const int ms = m - MP; t = ms & 3; prev = cst + (size_t)(ms >> 2) * 2 * FF; }
        float u0[8], u1[8], u2[8], ul[8];
        { const v4u a = *(const v4u*)(UC + (size_t)m * FF + c); const v4u l = *(const v4u*)(UL + (size_t)m * FF + c);
          u2[0] = bf2f(a.x & 0xffffu); u2[1] = bf2f(a.x >> 16); u2[2] = bf2f(a.y & 0xffffu); u2[3] = bf2f(a.y >> 16); u2[4] = bf2f(a.z & 0xffffu); u2[5] = bf2f(a.z >> 16); u2[6] = bf2f(a.w & 0xffffu); u2[7] = bf2f(a.w >> 16);
          ul[0] = bf2f(l.x & 0xffffu); ul[1] = bf2f(l.x >> 16); ul[2] = bf2f(l.y & 0xffffu); ul[3] = bf2f(l.y >> 16); ul[4] = bf2f(l.z & 0xffffu); ul[5] = bf2f(l.z >> 16); ul[6] = bf2f(l.w & 0xffffu); ul[7] = bf2f(l.w >> 16); }
        if (t >= 1) { const v4u a = *(const v4u*)(UC + (size_t)(m - 1) * FF + c);
          u1[0] = bf2f(a.x & 0xffffu); u1[1] = bf2f(a.x >> 16); u1[2] = bf2f(a.y & 0xffffu); u1[3] = bf2f(a.y >> 16); u1[4] = bf2f(a.z & 0xffffu); u1[5] = bf2f(a.z >> 16); u1[6] = bf2f(a.w & 0xffffu); u1[7] = bf2f(a.w >> 16); }
        else { for (int e = 0; e < 8; ++e) u1[e] = prev ? prev[FF + c + e] : 0.f; }
        if (t >= 2) { const v4u a = *(const v4u*)(UC + (size_t)(m - 2) * FF + c);
          u0[0] = bf2f(a.x & 0xffffu); u0[1] = bf2f(a.x >> 16); u0[2] = bf2f(a.y & 0xffffu); u0[3] = bf2f(a.y >> 16); u0[4] = bf2f(a.z & 0xffffu); u0[5] = bf2f(a.z >> 16); u0[6] = bf2f(a.w & 0xffffu); u0[7] = bf2f(a.w >> 16); }
        else { for (int e = 0; e < 8; ++e) u0[e] = prev ? prev[t * FF + c + e] : 0.f; }
        float hv[8];
#pragma unroll
        for (int e = 0; e < 8; ++e) { const float cv = u0[e] * cw[c + e] + u1[e] * cw[FF + c + e] + u2[e] * cw[2 * FF + c + e] + cb[c + e];
            hv[e] = cv / (1.f + __expf(-cv)) * ul[e]; }
        v4u w; w.x = pk2(hv[0], hv[1]); w.y = pk2(hv[2], hv[3]); w.z = pk2(hv[4], hv[5]); w.w = pk2(hv[6], hv[7]);
        *(v4u*)(H + (size_t)m * FF + c) = w;
    }
}

struct Args { const void* in[31]; float* out; unsigned char* ws; int ph_lo, ph_hi; };
__global__ void __launch_bounds__(NTHR, 2) fwd_kernel(Args args) {
    extern __shared__ __attribute__((aligned(16))) unsigned char lds_raw[];
    Ctx C;
    C.lds = (LAS unsigned char*)lds_raw; C.tid = threadIdx.x; C.lane = C.tid & 63; C.wave = __builtin_amdgcn_readfirstlane(C.tid >> 6);
    C.G = gridDim.x; { const int bx = blockIdx.x; C.vcu = (C.G % 8 == 0) ? (bx % 8) * (C.G / 8) + bx / 8 : bx; }
    C.out = args.out; C.ws = args.ws;
    const void* const* in = args.in;
    volatile LAS unsigned* MISC = (volatile LAS unsigned*)(C.lds + MISC_OFF);
    for (int u = C.tid; u < (LDS_BYTES - LDSCTL_OFF) / 4; u += NTHR) ((LAS unsigned*)(C.lds + LDSCTL_OFF))[u] = 0u;
    __syncthreads();
    const int lo = args.ph_lo, hi = args.ph_hi;
    const bool multi = (hi - lo) > 1;
    XcdBarrier bar; bar.bar = (unsigned*)(C.ws + WS_CTL) + CW_BAR; bar.x = 0; bar.st = nullptr;
    if (multi) bar = xcd_barrier_post((unsigned*)(C.ws + WS_CTL) + CW_BAR, MISC + 8);
#define IN(k) (lo <= (k) && (k) < hi)
#define SEAM(k) do { if (IN(k) && IN((k) + 1)) xcd_barrier(bar); } while (0)
    bf16* XB = (bf16*)(C.ws + WS_XB); bf16* MIX = (bf16*)(C.ws + WS_MIX); bf16* X1B = (bf16*)(C.ws + WS_X1B); bf16* HB = (bf16*)(C.ws + WS_H);
    float* Z = (float*)(C.ws + WS_Z); float* X1 = (float*)(C.ws + WS_X1);

    if (IN(0)) { p0_prologue(C, in); } SEAM(0);
    if (IN(1)) {
        pg8::Gemm g{XB, (const bf16*)(C.ws + WS_WIN), MT, NINP, DM}; pg8::StaticOrder S; S.init(MT, NINP, C.G, (int)blockIdx.x);
        pg8::EpiIn E{(float*)(C.ws + WS_PRW), (bf16*)(C.ws + WS_QB), (bf16*)(C.ws + WS_KB), (bf16*)(C.ws + WS_VB), (float*)(C.ws + WS_QI), (float*)(C.ws + WS_WI), C.out};
        pg8::gemm_phase<pg8::EpiIn, pg8::StaticOrder, true, true>(C.lds, g, S, E);
    } SEAM(1);
    if (IN(2)) { p2_prep(C, in); } SEAM(2);
    if (IN(3)) { p3_topk(C, in); } SEAM(3);
    if (IN(4)) { p4_scan(C, in); } SEAM(4);
    if (IN(5)) { p5_post(C, in); p5_attn(C, in); } SEAM(5);
    if (IN(6)) {
        pg8::Gemm g{MIX, (const bf16*)(C.ws + WS_WOUT), MT, DM, DM}; pg8::StaticOrder S; S.init(MT, DM, C.G, (int)blockIdx.x);
        pg8::EpiRes E{INF(0), INF(1), Z};
        pg8::gemm_phase<pg8::EpiRes, pg8::StaticOrder, true, true>(C.lds, g, S, E);
    } SEAM(6);
    if (IN(7)) { ln_rows(C, Z, INF(23), INF(24), X1, X1 + (size_t)MP * DM, X1B); } SEAM(7);
    if (IN(8)) {
        pg8::Gemm g{X1B, (const bf16*)(C.ws + WS_WUP), MT, NUP, DM}; pg8::StaticOrder S; S.init(MT, NUP, C.G, (int)blockIdx.x);
        pg8::EpiUp E{(bf16*)(C.ws + WS_UC), (bf16*)(C.ws + WS_UL), C.out};
        pg8::gemm_phase<pg8::EpiUp, pg8::StaticOrder, true, true>(C.lds, g, S, E);
    } SEAM(8);
    if (IN(9)) { p9_conv(C, in); } SEAM(9);
    if (IN(10)) {
        pg8::Gemm g{HB, (const bf16*)(C.ws + WS_WDN), MT, DM, FF}; pg8::StaticOrder S; S.init(MT, DM, C.G, (int)blockIdx.x);
        pg8::EpiRes E{X1, X1 + (size_t)MP * DM, Z};
        pg8::gemm_phase<pg8::EpiRes, pg8::StaticOrder, true, true>(C.lds, g, S, E);
    } SEAM(10);
    if (IN(11)) { ln_rows(C, Z, INF(29), INF(30), C.out + O_YP, C.out + O_YS, nullptr); }
#undef IN
#undef SEAM
}

#ifndef N_LAUNCH_MODE
#define N_LAUNCH_MODE 1
#endif
extern "C" void kernel_launch(void* const* d_in, const int* in_sizes, int n_in, void* d_out, int out_size, void* d_ws, size_t ws_size, hipStream_t stream) {
    static int grid = 0;
    if (grid == 0) {
        if (n_in != 31 || out_size != (int)O_END || ws_size < WS_END) { fprintf(stderr, "kernel_launch: unexpected shapes (n_in %d, out %d, ws %zu)\n", n_in, out_size, ws_size); grid = -1; return; }
        int dev = 0, cus = 0, per_cu = 0;
        if (hipGetDevice(&dev) != hipSuccess || hipDeviceGetAttribute(&cus, hipDeviceAttributeMultiprocessorCount, dev) != hipSuccess) { grid = -1; return; }
        if (hipFuncSetAttribute((const void*)fwd_kernel, hipFuncAttributeMaxDynamicSharedMemorySize, LDS_BYTES) != hipSuccess) { fprintf(stderr, "kernel_launch: hipFuncSetAttribute failed\n"); grid = -1; return; }
        if (hipOccupancyMaxActiveBlocksPerMultiprocessor(&per_cu, (const void*)fwd_kernel, NTHR, LDS_BYTES) != hipSuccess || per_cu < 1) fprintf(stderr, "kernel_launch: occupancy query says %d\n", per_cu);
        (void)hipGetLastError();
        grid = cus;
    }
    if (grid < 0) return;
    (void)hipMemsetAsync((char*)d_ws + WS_CTL, 0, CTL_ZERO_BYTES, stream);
    Args a{};
    for (int i = 0; i < 31; ++i) a.in[i] = d_in[i];
    a.out = (float*)d_out; a.ws = (unsigned char*)d_ws;
#if N_LAUNCH_MODE == 1
    a.ph_lo = 0; a.ph_hi = NPHASE;
    hipLaunchKernelGGL(fwd_kernel, dim3(grid), dim3(NTHR), LDS_BYTES, stream, a);
#else
    for (int p = 0; p < NPHASE; ++p) { a.ph_lo = p; a.ph_hi = p + 1; hipLaunchKernelGGL(fwd_kernel, dim3(grid), dim3(NTHR), LDS_BYTES, stream, a); }
#endif
    const hipError_t le = hipPeekAtLastError();
    if (le != hipSuccess) fprintf(stderr, "kernel_launch: launch failed: %s\n", hipGetErrorName(le));
}
```

```cpp
#include <hip/hip_runtime.h>
#include <cstdio>
#include <cstdint>
namespace pg8 {
#define PG8_LAS __attribute__((address_space(3)))
typedef unsigned short bf16_t;
typedef short bf16x8 __attribute__((ext_vector_type(8)));
typedef float f32x4 __attribute__((ext_vector_type(4)));
typedef unsigned u32x4 __attribute__((ext_vector_type(4)));
constexpr int BM = 256, BK = 64, HALF = 128, HTB = HALF * BK * 2  , STAGE_BYTES = 8 * HTB, NXCD = 8, WGM = 8;

__host__ __device__ __forceinline__ int lds_byte(int r, int c) { const int st = (r >> 4) * 2 + (c >> 5), rr = r & 15, cc = c & 31, ob = rr * 64 + cc * 2; return st * 1024 + (ob ^ (((ob >> 9) & 1) << 5)); }
__host__ __device__ __forceinline__ void stage_rc(int b, int& R, int& C) { const int st = b / 1024, sb = b % 1024, swz = sb ^ (((sb >> 9) & 1) << 5); R = (st >> 1) * 16 + swz / 64; C = (st & 1) * 32 + (swz % 64) / 2; }
__host__ __device__ __forceinline__ int perm32(int rho) { const int n = rho >> 4, i = rho & 15; return 8 * (i >> 2) + 4 * n + (i & 3); }

struct Unit { int pm, pn; };
struct Gemm { const bf16_t* A; const bf16_t* Bt; int M, N, K; };

struct StaticOrder {
    int nM, nN, nwg, G, c;
    __host__ __device__ void init(int M, int N, int G_, int c_) { nM = M / BM; nN = N / BM; nwg = nM * nN; G = G_; c = c_; }
    __host__ __device__ bool next(int i, Unit& u) const {
        const long L = (long)i * G + c; if (L >= nwg) return false;
        int wgid = (int)L; { const int q = nwg / NXCD, r = nwg % NXCD, xcd = wgid % NXCD, off = wgid / NXCD; wgid = (xcd < r ? xcd * (q + 1) : r * (q + 1) + (xcd - r) * q) + off; }
        const int nig = WGM * nN, gid = wgid / nig, fm = gid * WGM, gsz = (nM - fm) < WGM ? (nM - fm) : WGM;
        u.pm = fm + ((wgid % nig) % gsz); u.pn = (wgid % nig) / gsz; return true;
    }
    __device__ __forceinline__ void a_ready(const Unit&) const {}
    __device__ __forceinline__ void done(const Unit&) const {}
};

__device__ __forceinline__ unsigned cvt_pk_bf16(float lo, float hi) { unsigned r; asm volatile("v_cvt_pk_bf16_f32 %0, %1, %2" : "=v"(r) : "v"(lo), "v"(hi)); return r; }
typedef float f32x2 __attribute__((ext_vector_type(2)));
template <class Epi, class Sched, bool ALIGN_EPI = false, bool SP2 = false>
__device__ __forceinline__ void gemm_phase(PG8_LAS unsigned char* lds, const Gemm g, const Sched& S, const Epi& E) {
    const int tid = threadIdx.x, wid = __builtin_amdgcn_readfirstlane(tid >> 6), lane = tid & 63, wr = wid >> 2, wc = wid & 3, fr = lane & 15, fq = lane >> 4;
    const int K = g.K, nt = K / BK;
    unsigned voffA[2], voffB[2];
#pragma unroll
    for (int i = 0; i < 2; ++i) { int R, C; stage_rc(tid * 16 + i * 8192, R, C); const int Rb = Epi::PERM ? ((R & ~31) + perm32(R & 31)) : R;
        voffA[i] = (unsigned)(R * K + C) * 2u; voffB[i] = (unsigned)(Rb * K + C) * 2u; }
    const size_t kstep = (size_t)(BK * 2);
    const size_t hstep = (size_t)HALF * K * 2;
    const size_t tstep = 2 * hstep;
    const unsigned ldsw = (unsigned)wid * 1024u;
    const int aoff = lds_byte(wr * 64 + fr, fq * 8), boff = lds_byte(wc * 32 + fr, fq * 8);
#define PG8_SA(b, h) (((b) * 2 + (h)) * HTB)
#define PG8_SB(b, h) ((4 + (b) * 2 + (h)) * HTB)
#define PG8_STAGE(bufoff, gbase, voff) do { _Pragma("unroll") for (int _i = 0; _i < 2; ++_i) \
        __builtin_amdgcn_global_load_lds((const unsigned*)((const char*)(gbase) + (voff)[_i]), (PG8_LAS unsigned*)(lds + (bufoff) + ldsw + _i * 8192), 16, 0, 0); } while (0)
#define PG8_LDA(dst, b, h) do { _Pragma("unroll") for (int m = 0; m < 4; ++m) _Pragma("unroll") for (int k = 0; k < 2; ++k) dst[m][k] = *(const PG8_LAS bf16x8*)(lds + PG8_SA(b, h) + aoff + m * 2048 + k * 1024); } while (0)
#define PG8_LDB(dst, b, h) do { _Pragma("unroll") for (int n = 0; n < 2; ++n) _Pragma("unroll") for (int k = 0; k < 2; ++k) dst[n][k] = *(const PG8_LAS bf16x8*)(lds + PG8_SB(b, h) + boff + n * 2048 + k * 1024); } while (0)
#define PG8_MMA(ai, bj, At, Bt) do { __builtin_amdgcn_s_setprio(1); _Pragma("unroll") for (int m = 0; m < 4; ++m) _Pragma("unroll") for (int n = 0; n < 2; ++n) _Pragma("unroll") for (int k = 0; k < 2; ++k) \
        acc[ai][bj][m][n] = __builtin_amdgcn_mfma_f32_16x16x32_bf16(Bt[n][k], At[m][k], acc[ai][bj][m][n], 0, 0, 0); __builtin_amdgcn_s_setprio(0); } while (0)
#define PG8_WAIT_V(n) asm volatile("s_waitcnt vmcnt(" #n ")" ::: "memory")
#define PG8_WAIT_L(n) asm volatile("s_waitcnt lgkmcnt(" #n ")" ::: "memory")
#define PG8_BAR __builtin_amdgcn_s_barrier()
#define PG8_SCHED __builtin_amdgcn_sched_barrier(0)
    Unit cur, nxt; int ui = 0;
    if (!S.next(0, cur)) return;
    f32x4 acc[2][2][4][2];
#pragma unroll
    for (int a = 0; a < 2; ++a)
#pragma unroll
        for (int b = 0; b < 2; ++b)
#pragma unroll
            for (int m = 0; m < 4; ++m)
#pragma unroll
                for (int n = 0; n < 2; ++n) acc[a][b][m][n] = (f32x4){0.f, 0.f, 0.f, 0.f};
    bf16x8 At[4][2], B0[2][2], B1[2][2];
    const char* cA = (const char*)g.A + (size_t)cur.pm * tstep; const char* cB = (const char*)g.Bt + (size_t)cur.pn * tstep;
    S.a_ready(cur);
    if constexpr (SP2) {
        PG8_STAGE(PG8_SB(0, 0), cB, voffB); PG8_STAGE(PG8_SB(0, 1), cB + hstep, voffB); PG8_STAGE(PG8_SA(0, 0), cA, voffA); PG8_STAGE(PG8_SA(0, 1), cA + hstep, voffA);
        if (wr == 1) PG8_BAR;
        PG8_WAIT_V(2); PG8_BAR;
        PG8_STAGE(PG8_SB(1, 0), cB + kstep, voffB); PG8_STAGE(PG8_SA(1, 0), cA + kstep, voffA); PG8_STAGE(PG8_SB(1, 1), cB + hstep + kstep, voffB);
        PG8_WAIT_V(6); PG8_BAR;
    } else {
        PG8_STAGE(PG8_SB(0, 0), cB, voffB); PG8_STAGE(PG8_SA(0, 0), cA, voffA); PG8_STAGE(PG8_SB(0, 1), cB + hstep, voffB); PG8_STAGE(PG8_SA(0, 1), cA + hstep, voffA);
        if (wr == 1) PG8_BAR;
        PG8_WAIT_V(4); PG8_BAR;
        PG8_STAGE(PG8_SB(1, 0), cB + kstep, voffB); PG8_STAGE(PG8_SA(1, 0), cA + kstep, voffA); PG8_STAGE(PG8_SB(1, 1), cB + hstep + kstep, voffB);
        PG8_WAIT_V(6); PG8_BAR;
    }
    for (;;) {
        const bool has_next = S.next(ui + 1, nxt);
        const char* nA = has_next ? (const char*)g.A + (size_t)nxt.pm * tstep : cA; const char* nB = has_next ? (const char*)g.Bt + (size_t)nxt.pn * tstep : cB;
        for (int t = 0; t < nt; t += 2) {
            const bool last = (t == nt - 2);
            const char* a1 = cA + (size_t)(t + 1) * kstep;
            const char* a2 = last ? nA : cA + (size_t)(t + 2) * kstep; const char* b2 = last ? nB : cB + (size_t)(t + 2) * kstep;
            const char* a3 = a2 + kstep; const char* b3 = b2 + kstep;
            if (last && has_next) S.a_ready(nxt);
            if constexpr (SP2) {
            PG8_LDB(B0, 0, 0); PG8_LDB(B1, 0, 1); PG8_SCHED; PG8_LDA(At, 0, 0); PG8_STAGE(PG8_SA(1, 1), a1 + hstep, voffA);
            PG8_WAIT_V(8); PG8_WAIT_L(0); PG8_BAR; PG8_MMA(0, 0, At, B0); PG8_MMA(0, 1, At, B1); PG8_BAR; PG8_SCHED;
            PG8_LDA(At, 0, 1); PG8_STAGE(PG8_SB(0, 0), b2, voffB); PG8_STAGE(PG8_SB(0, 1), b2 + hstep, voffB); PG8_STAGE(PG8_SA(0, 0), a2, voffA);
            PG8_WAIT_V(8); PG8_WAIT_L(0); PG8_BAR; PG8_MMA(1, 0, At, B0); PG8_MMA(1, 1, At, B1); PG8_BAR; PG8_SCHED;
            PG8_LDB(B0, 1, 0); PG8_LDB(B1, 1, 1); PG8_SCHED; PG8_LDA(At, 1, 0); PG8_STAGE(PG8_SA(0, 1), a2 + hstep, voffA);
            PG8_WAIT_V(8); PG8_WAIT_L(0); PG8_BAR; PG8_MMA(0, 0, At, B0); PG8_MMA(0, 1, At, B1); PG8_BAR; PG8_SCHED;
            PG8_LDA(At, 1, 1); PG8_STAGE(PG8_SB(1, 0), b3, voffB); PG8_STAGE(PG8_SB(1, 1), b3 + hstep, voffB); PG8_STAGE(PG8_SA(1, 0), a3, voffA);
            PG8_WAIT_V(8); PG8_WAIT_L(0); PG8_BAR; PG8_MMA(1, 0, At, B0); PG8_MMA(1, 1, At, B1); PG8_BAR; PG8_SCHED;
            } else {
            PG8_LDB(B0, 0, 0); PG8_SCHED; PG8_LDA(At, 0, 0); PG8_STAGE(PG8_SA(1, 1), a1 + hstep, voffA);
            PG8_WAIT_L(8); PG8_BAR; PG8_WAIT_L(0); PG8_MMA(0, 0, At, B0); PG8_BAR; PG8_SCHED;
            PG8_LDB(B1, 0, 1); PG8_STAGE(PG8_SB(0, 0), b2, voffB);
            PG8_BAR; PG8_WAIT_L(0); PG8_MMA(0, 1, At, B1); PG8_BAR;
            PG8_LDA(At, 0, 1); PG8_STAGE(PG8_SA(0, 0), a2, voffA);
            PG8_BAR; PG8_WAIT_L(0); PG8_MMA(1, 0, At, B0); PG8_BAR; PG8_SCHED;
            PG8_STAGE(PG8_SB(0, 1), b2 + hstep, voffB);
            PG8_WAIT_V(6); PG8_BAR; PG8_MMA(1, 1, At, B1); PG8_BAR;
            PG8_LDB(B0, 1, 0); PG8_SCHED; PG8_LDA(At, 1, 0); PG8_STAGE(PG8_SA(0, 1), a2 + hstep, voffA);
            PG8_WAIT_L(8); PG8_BAR; PG8_WAIT_L(0); PG8_MMA(0, 0, At, B0); PG8_BAR; PG8_SCHED;
            PG8_LDB(B1, 1, 1); PG8_STAGE(PG8_SB(1, 0), b3, voffB);
            PG8_BAR; PG8_WAIT_L(0); PG8_MMA(0, 1, At, B1); PG8_BAR;
            PG8_LDA(At, 1, 1); PG8_STAGE(PG8_SA(1, 0), a3, voffA);
            PG8_BAR; PG8_WAIT_L(0); PG8_MMA(1, 0, At, B0); PG8_BAR; PG8_SCHED;
            PG8_STAGE(PG8_SB(1, 1), b3 + hstep, voffB);
            PG8_WAIT_V(6); PG8_BAR; PG8_MMA(1, 1, At, B1); PG8_BAR;
            }
        }
        if constexpr (ALIGN_EPI) { if (wr == 0) PG8_BAR; }
        if constexpr (!Epi::AFTER_DRAIN) { E(acc, cur, wr, wc, fr, fq); S.done(cur); }
        if (!has_next) break;
#pragma unroll
        for (int a = 0; a < 2; ++a)
#pragma unroll
            for (int b = 0; b < 2; ++b)
#pragma unroll
                for (int m = 0; m < 4; ++m)
#pragma unroll
                    for (int n = 0; n < 2; ++n) acc[a][b][m][n] = (f32x4){0.f, 0.f, 0.f, 0.f};
        cur = nxt; cA = nA; cB = nB; ++ui;
        if constexpr (ALIGN_EPI) { if (wr == 1) PG8_BAR; }
    }
    PG8_WAIT_V(0);
    if constexpr (!ALIGN_EPI) { if (wr == 0) PG8_BAR; }
    PG8_BAR;
    if constexpr (Epi::AFTER_DRAIN) { E.fused(acc, cur, wr, wc, fr, fq, lds, wid, lane); S.done(cur); }
#undef PG8_SA
#undef PG8_SB
#undef PG8_STAGE
#undef PG8_LDA
#undef PG8_LDB
#undef PG8_MMA
#undef PG8_WAIT_V
#undef PG8_WAIT_L
#undef PG8_BAR
#undef PG8_SCHED
}
}
#define GAS __attribute__((address_space(1)))
#define LAS __attribute__((address_space(3)))
typedef unsigned short bf16;
typedef unsigned v4u __attribute__((ext_vector_type(4)));
typedef float f32x4 __attribute__((ext_vector_type(4)));
typedef short bf16x8 __attribute__((ext_vector_type(8)));
typedef GAS unsigned gu32;
typedef GAS unsigned long long gu64;
#define RLX_AGENT __ATOMIC_RELAXED, __HIP_MEMORY_SCOPE_AGENT
#define LDS_WAIT() asm volatile("s_waitcnt lgkmcnt(0)" ::: "memory")
#define VM_WAIT() asm volatile("s_waitcnt vmcnt(0)" ::: "memory")
__device__ __forceinline__ unsigned long long rt() { return __builtin_amdgcn_s_memrealtime(); }
__device__ __forceinline__ unsigned f2bf(float f) { unsigned u = __builtin_bit_cast(unsigned, f); return (u + 0x7fffu + ((u >> 16) & 1u)) >> 16; }
__device__ __forceinline__ unsigned pk2(float lo, float hi) { return f2bf(lo) | (f2bf(hi) << 16); }

#define XB_TMO      128
#define XB_XCNT(j)  (256  + 64 * (j))
#define XB_XSUB(j)  (1280 + 64 * (j))
#define XB_XGEN(j)  (2304 + 64 * (j))
#define XB_TOP      3328
#define XB_TOPGEN   3392
#define XCD_BAR_WORDS 3456
#define XB_SPIN_CAP (1u << 18)

__device__ __forceinline__ unsigned xb_ld(unsigned* p)              { return __hip_atomic_load(p, __ATOMIC_RELAXED, __HIP_MEMORY_SCOPE_AGENT); }
__device__ __forceinline__ unsigned xb_add(unsigned* p, unsigned v) { return __hip_atomic_fetch_add(p, v, __ATOMIC_RELAXED, __HIP_MEMORY_SCOPE_AGENT); }
__device__ __forceinline__ unsigned xb_xcc_id() { return (unsigned)__builtin_amdgcn_s_getreg((3 << 11) | 20) & 0xFu; }
#define XB_SPIN(cond, bar) do { unsigned _sp = 0; while (cond) { __builtin_amdgcn_s_sleep(1); \
    if ((++_sp & 255u) == 0u) { if (xb_ld(&(bar)[XB_TMO])) break; if (_sp > XB_SPIN_CAP) { atomicAdd(&(bar)[XB_TMO], 1u); break; } } } } while (0)

struct XcdBarrier {
    unsigned* bar; unsigned x;
    volatile LAS unsigned* st;
};

__device__ __forceinline__ XcdBarrier xcd_barrier_post(unsigned* bar, volatile LAS unsigned* st) {
    XcdBarrier b; b.bar = bar; b.x = xb_xcc_id(); b.st = st;
    if (threadIdx.x == 0) (void)xb_add(&bar[XB_XCNT(b.x)], 1u);
    return b;
}
__device__ __forceinline__ void xcd_barrier_complete(unsigned* bar, unsigned x, unsigned& nloc, unsigned& nx) {
    const unsigned G = gridDim.x * gridDim.y * gridDim.z;
    unsigned sum, cnt, mine, sp = 0u;
    for (;;) {
        sum = 0u; cnt = 0u; mine = 0u;
#pragma unroll
        for (unsigned j = 0; j < 16; ++j) { const unsigned c = xb_ld(&bar[XB_XCNT(j)]); sum += c; cnt += (c > 0u) ? 1u : 0u; mine = (j == x) ? c : mine; }
        if (sum == G) break;
        __builtin_amdgcn_s_sleep(1);
        if ((++sp & 255u) == 0u) { if (xb_ld(&bar[XB_TMO])) break; if (sp > XB_SPIN_CAP) { atomicAdd(&bar[XB_TMO], 1u); break; } }
    }
    nloc = mine > 0u ? mine : 1u; nx = cnt > 0u ? cnt : 1u;
}

__device__ __forceinline__ void xcd_barrier(const XcdBarrier& b) {
    asm volatile("s_waitcnt vmcnt(0)" ::: "memory");
    __syncthreads();
    if (threadIdx.x == 0) {
        unsigned* bar = b.bar;
        __builtin_amdgcn_s_waitcnt(0);
        unsigned nloc = b.st[0], nx = b.st[1];
        if (nloc == 0u) { xcd_barrier_complete(bar, b.x, nloc, nx); b.st[0] = nloc; b.st[1] = nx; }
        const unsigned old = xb_add(&bar[XB_XSUB(b.x)], 1u);
        const unsigned gen = old / nloc;
        if (old + 1u == (gen + 1u) * nloc) {
            __builtin_amdgcn_fence(__ATOMIC_RELEASE, "agent");
            asm volatile("s_waitcnt vmcnt(0)" ::: "memory");
            const unsigned og = xb_add(&bar[XB_TOP], 1u);
            const unsigned tg = og / nx;
            if (og + 1u == (tg + 1u) * nx) xb_add(&bar[XB_TOPGEN], 1u);
            else XB_SPIN(xb_ld(&bar[XB_TOPGEN]) == tg, bar);
            __builtin_amdgcn_fence(__ATOMIC_ACQUIRE, "agent");
            xb_add(&bar[XB_XGEN(b.x)], 1u);
            asm volatile("s_waitcnt vmcnt(0)" ::: "memory");
        } else {
            XB_SPIN(xb_ld(&bar[XB_XGEN(b.x)]) == gen, bar);
            __builtin_amdgcn_fence(__ATOMIC_ACQUIRE, "agent");
            asm volatile("s_waitcnt vmcnt(0)" ::: "memory");
        }
    }
    __syncthreads();
}
constexpr int TP = 4096, BP = 4, MP = BP * TP;
constexpr int BS = 128, TS = 4, MS = BS * TS;
constexpr int MT = MP + MS;
constexpr int DM = 1024, RW = 512, SC = 1792, NINP = 3840, FF = 2816, NUP = 5632;
constexpr int PAST = 2048, NPAGES = 16, LS = PAST + TS;
constexpr float ALPHA = 1.189207115002721f;
constexpr float LN_EPS = 1e-5f, GN_EPS = 64e-5f;
constexpr float QSCALE = 0.125f * 1.4426950408889634f;
constexpr float LOG2E = 1.4426950408889634f;
constexpr size_t O_YP = 0, O_YS = 16777216, O_KP = 17301504, O_VP = 25690112, O_KIP = 34078720, O_WKVP = 35127296, O_SHP = 35258368, O_CVP = 35265536,
                 O_KS = 35288064, O_VS = 35550208, O_KIS = 35812352, O_WKVS = 35845120, O_SHS = 40039424, O_CVS = 40268800, O_END = 40989696;

namespace pg8 {
__device__ __forceinline__ u32x4 pack8(const f32x4 a, const f32x4 b) { u32x4 w; w.x = cvt_pk_bf16(a[0], a[1]); w.y = cvt_pk_bf16(a[2], a[3]); w.z = cvt_pk_bf16(b[0], b[1]); w.w = cvt_pk_bf16(b[2], b[3]); return w; }
struct EpiIn {
    static constexpr bool PERM = true, AFTER_DRAIN = false;
    float* prw; bf16_t* qb; bf16_t* kb; bf16_t* vb; float* qi; float* wi; float* out;
    __device__ __forceinline__ void operator()(const f32x4 (&acc)[2][2][4][2], const Unit& u, int wr, int wc, int fr, int fq) const {
        const int pn = u.pn; const bool samp = u.pm >= 64;
#pragma unroll
        for (int ai = 0; ai < 2; ++ai)
#pragma unroll
            for (int m = 0; m < 4; ++m) {
                const int row = u.pm * BM + ai * HALF + wr * 64 + m * 16 + fr;
                const int rs = row - MP;
#pragma unroll
                for (int bj = 0; bj < 2; ++bj) {
                    const int col = pn * BM + bj * HALF + wc * 32 + 8 * fq;
                    const f32x4 v0 = acc[ai][bj][m][0], v1 = acc[ai][bj][m][1];
                    if (pn < 7) {
                        float* p = prw + (size_t)row * SC + col; *(f32x4*)p = v0; *(f32x4*)(p + 4) = v1;
                        const bool last = samp ? ((rs & 3) == 3) : ((row & (TP - 1)) == TP - 1);
                        if (last) { float* o = samp ? out + O_SHS + (size_t)(rs >> 2) * SC + col : out + O_SHP + (size_t)(row >> 12) * SC + col; *(f32x4*)o = v0; *(f32x4*)(o + 4) = v1; }
                    } else if (pn < 9) {
                        const int c = col - 1792; *(u32x4*)(qb + (size_t)row * RW + c) = pack8(v0 * QSCALE, v1 * QSCALE);
                    } else if (pn < 11) {
                        const int c = col - 2304; float* o = samp ? out + O_KS + (size_t)rs * RW + c : out + O_KP + (size_t)row * RW + c; *(f32x4*)o = v0; *(f32x4*)(o + 4) = v1;
                        *(u32x4*)(kb + (size_t)row * RW + c) = pack8(v0, v1);
                    } else if (pn < 13) {
                        const int c = col - 2816; float* o = samp ? out + O_VS + (size_t)rs * RW + c : out + O_VP + (size_t)row * RW + c; *(f32x4*)o = v0; *(f32x4*)(o + 4) = v1;
                        *(u32x4*)(vb + (size_t)row * RW + c) = pack8(v0, v1);
                    } else if (pn == 13) {
                        const int c = col - 3328; float* o = qi + (size_t)row * 256 + c; *(f32x4*)o = v0; *(f32x4*)(o + 4) = v1;
                    } else {
                        const int c = col - 3584;
                        if (c < 64) { float* o = samp ? out + O_KIS + (size_t)rs * 64 + c : out + O_KIP + (size_t)row * 64 + c; *(f32x4*)o = v0; *(f32x4*)(o + 4) = v1; }
                        else if (c == 64) { *(f32x4*)(wi + (size_t)row * 4) = v0 * 0.5f; }
                    }
                }
            }
    }
};
struct EpiRes {
    static constexpr bool PERM = true, AFTER_DRAIN = false;
    const float* resP; const float* resS; float* out;
    __device__ __forceinline__ void operator()(const f32x4 (&acc)[2][2][4][2], const Unit& u, int wr, int wc, int fr, int fq) const {
        const bool samp = u.pm >= 64;
#pragma unroll
        for (int ai = 0; ai < 2; ++ai)
#pragma unroll
            for (int m = 0; m < 4; ++m) {
                const int row = u.pm * BM + ai * HALF + wr * 64 + m * 16 + fr;
                const float* rr = samp ? resS + (size_t)(row - MP) * DM : resP + (size_t)row * DM;
#pragma unroll
                for (int bj = 0; bj < 2; ++bj) {
                    const int col = u.pn * BM + bj * HALF + wc * 32 + 8 * fq;
                    const f32x4 r0 = *(const f32x4*)(rr + col), r1 = *(const f32x4*)(rr + col + 4);
                    float* o = out + (size_t)row * DM + col;
                    *(f32x4*)o = r0 * ALPHA + acc[ai][bj][m][0]; *(f32x4*)(o + 4) = r1 * ALPHA + acc[ai][bj][m][1];
                }
            }
    }
};
struct EpiUp {
    static constexpr bool PERM = true, AFTER_DRAIN = false;
    bf16_t* uc; bf16_t* ul; float* out;
    __device__ __forceinline__ void operator()(const f32x4 (&acc)[2][2][4][2], const Unit& u, int wr, int wc, int fr, int fq) const {
        const bool samp = u.pm >= 64;
#pragma unroll
        for (int ai = 0; ai < 2; ++ai)
#pragma unroll
            for (int m = 0; m < 4; ++m) {
                const int row = u.pm * BM + ai * HALF + wr * 64 + m * 16 + fr;
                const int c = u.pn * HALF + wc * 32 + 8 * fq;
                *(u32x4*)(uc + (size_t)row * FF + c) = pack8(acc[ai][0][m][0], acc[ai][0][m][1]);
                *(u32x4*)(ul + (size_t)row * FF + c) = pack8(acc[ai][1][m][0], acc[ai][1][m][1]);
                if (samp) { const int rs = row - MP, t = rs & 3; if (t >= 2) { float* o = out + O_CVS + ((size_t)(rs >> 2) * 2 + (t - 2)) * FF + c; *(f32x4*)o = acc[ai][0][m][0]; *(f32x4*)(o + 4) = acc[ai][0][m][1]; } }
                else { const int t = row & (TP - 1); if (t >= TP - 2) { float* o = out + O_CVP + ((size_t)(row >> 12) * 2 + (t - (TP - 2))) * FF + c; *(f32x4*)o = acc[ai][0][m][0]; *(f32x4*)(o + 4) = acc[ai][0][m][1]; } }
            }
    }
};
}
constexpr size_t MiB = 1u << 20;
constexpr size_t WS_CTL = 0, CTL_ZERO_BYTES = 1 * MiB;
constexpr size_t WS_WIN = 2 * MiB;
constexpr size_t WS_WOUT = 10 * MiB;
constexpr size_t WS_WUP = 12 * MiB;
constexpr size_t WS_WDN = 24 * MiB;
constexpr size_t WS_XB = 32 * MiB;
constexpr size_t WS_PRW = 66 * MiB;
constexpr size_t WS_QB = 182 * MiB;
constexpr size_t WS_KB = 199 * MiB;
constexpr size_t WS_VB = 216 * MiB;
constexpr size_t WS_QI = 233 * MiB;
constexpr size_t WS_WI = 250 * MiB;
constexpr size_t WS_SCAN = 1024 * MiB;
constexpr size_t WS_G = 454 * MiB;
constexpr size_t WS_BG = 251 * MiB;
constexpr size_t WS_YS = 489 * MiB;
constexpr size_t WS_MASK = 523 * MiB;
constexpr size_t WS_SEL = 532 * MiB;
constexpr size_t WS_MIX = 533 * MiB;
constexpr size_t WS_Z = 567 * MiB;
constexpr size_t WS_X1 = 634 * MiB;
constexpr size_t WS_X1B = 701 * MiB;
constexpr size_t WS_UC = 735 * MiB;
constexpr size_t WS_UL = 826 * MiB;
constexpr size_t WS_H = 917 * MiB;
constexpr size_t WS_END = 1330 * MiB;
constexpr int CW_BAR = 4096;
constexpr int SREC = 576;

constexpr int RING_BYTES = 131072, LDSCTL_OFF = RING_BYTES, MISC_OFF = LDSCTL_OFF + 320, LDS_BYTES = 147456;
constexpr int NWAVES = 8, NTHR = 512;
constexpr int NPHASE = 12;

__device__ __forceinline__ float bf2f(unsigned short h) { return __builtin_bit_cast(float, (unsigned)h << 16); }
__device__ __forceinline__ float wave_sum(float v) {
#pragma unroll
    for (int o = 1; o < 64; o <<= 1) v += __shfl_xor(v, o);
    return v;
}
template <int CTRL> __device__ __forceinline__ float dppf(float x) { return __builtin_bit_cast(float, __builtin_amdgcn_update_dpp(0, __builtin_bit_cast(int, x), CTRL, 0xf, 0xf, true)); }
__device__ __forceinline__ float sum16(float x) {
    x += dppf<0xB1>(x); x += dppf<0x4E>(x); x += dppf<0x141>(x); x += dppf<0x140>(x); return x;
}
__device__ __forceinline__ float sum8(float x) {
    x += dppf<0xB1>(x); x += dppf<0x4E>(x); x += dppf<0x141>(x); return x;
}
__device__ __forceinline__ bf16x8 pack_bf8(const f32x4 a, const f32x4 b) {
    v4u w; w.x = pk2(a[0], a[1]); w.y = pk2(a[2], a[3]); w.z = pk2(b[0], b[1]); w.w = pk2(b[2], b[3]); return __builtin_bit_cast(bf16x8, w);
}
typedef float f32x16 __attribute__((ext_vector_type(16)));
typedef float f32x2 __attribute__((ext_vector_type(2)));

struct Ctx {
    LAS unsigned char* lds; int tid, lane, wave, vcu, G;
    const void* const* in_; float* out; unsigned char* ws;
};
#define INF(k) ((const float*)in[k])

template <int MODE> __device__ __forceinline__ void p0_tr_item(const float* W, int K, int N, int nblk, bf16* WT, LAS float* scr, int item, int lane) {
    const int kb = item / nblk, nb = item % nblk, k0 = 64 * kb, n0 = 32 * nb;
    const int nl0 = lane & 31; const bool okn = (n0 + nl0) < N;
#pragma unroll 8
    for (int i = 0; i < 32; ++i) { const int kk = 2 * i + (lane >> 5); scr[kk * 33 + nl0] = okn ? W[(size_t)(k0 + kk) * N + n0 + nl0] : 0.f; }
    asm volatile("s_waitcnt lgkmcnt(0)" ::: "memory");
    const int c = lane & 7;
#pragma unroll
    for (int j = 0; j < 4; ++j) { const int nl = (lane >> 3) + 8 * j; const int n = n0 + nl; const LAS float* s = scr + (8 * c) * 33 + nl;
        int row = n;
        if (MODE == 2) row = (n < FF) ? 256 * (n >> 7) + (n & 127) : 256 * ((n - FF) >> 7) + 128 + ((n - FF) & 127);
        v4u o; o.x = pk2(s[0 * 33], s[1 * 33]); o.y = pk2(s[2 * 33], s[3 * 33]); o.z = pk2(s[4 * 33], s[5 * 33]); o.w = pk2(s[6 * 33], s[7 * 33]);
        *(GAS v4u*)(WT + (size_t)row * K + k0 + 8 * c) = o; }
    asm volatile("s_waitcnt lgkmcnt(0)" ::: "memory");
}
__device__ __forceinline__ void p0_prologue(const Ctx& C, const void* const* in) {
    LAS float* scr = (LAS float*)(C.lds + C.wave * 16384);
    const int gw = C.vcu * NWAVES + C.wave, NGW = C.G * NWAVES;
    constexpr int I_IN = 16 * 120, I_OUT = 16 * 32, I_UP = 16 * 176, I_DN = 44 * 32, NITEMS = I_IN + I_OUT + I_UP + I_DN;
    bf16* win = (bf16*)(C.ws + WS_WIN); bf16* wout = (bf16*)(C.ws + WS_WOUT); bf16* wup = (bf16*)(C.ws + WS_WUP); bf16* wdn = (bf16*)(C.ws + WS_WDN);
    for (int it = gw; it < NITEMS; it += NGW) {
        int r = it;
        if (r < I_IN) { p0_tr_item<0>(INF(10), DM, 3652, 120, win, scr, r, C.lane); continue; } r -= I_IN;
        if (r < I_OUT) { p0_tr_item<0>(INF(22), DM, DM, 32, wout, scr, r, C.lane); continue; } r -= I_OUT;
        if (r < I_UP) { p0_tr_item<2>(INF(25), DM, NUP, 176, wup, scr, r, C.lane); continue; } r -= I_UP;
        p0_tr_item<0>(INF(28), FF, DM, 32, wdn, scr, r, C.lane);
    }
    bf16* xb = (bf16*)(C.ws + WS_XB);
    for (int m = gw; m < MT; m += NGW) {
        const float* xr = (m < MP) ? INF(0) + (size_t)m * DM : INF(1) + (size_t)(m - MP) * DM;
        const GAS f32x4* x4 = (const GAS f32x4*)xr + C.lane;
        GAS unsigned long long* o8 = (GAS unsigned long long*)(xb + (size_t)m * DM) + C.lane;
#pragma unroll
        for (int j = 0; j < 4; ++j) { const f32x4 v = x4[64 * j]; o8[64 * j] = (unsigned long long)pk2(v.x, v.y) | ((unsigned long long)pk2(v.z, v.w) << 32); }
    }
}

__device__ __forceinline__ float sigmoidf_(float x) { return 1.f / (1.f + __expf(-x)); }
__device__ __forceinline__ void p2_prep(const Ctx& C, const void* const* in) {
    LAS float* act = (LAS float*)C.lds;
    const float* PRW = (const float*)(C.ws + WS_PRW);
    float* SCAN = (float*)(C.ws + WS_SCAN); float* Gb = (float*)(C.ws + WS_G); float* BG = (float*)(C.ws + WS_BG);
    const float* smu = INF(11); const float* sst = INF(7);
    const float* wup = INF(13); const float* aup = INF(15); const float* gup = INF(16);
    const int c = C.tid, h = C.wave, j = C.lane;
    const float mu_r = smu[c], mu_k = smu[RW + c], mu_v = smu[2 * RW + c];
    const float w0 = INF(12)[c], a0 = INF(14)[c], kkc = INF(17)[c], kac = INF(18)[c], rkc = INF(19)[c];
    for (int tile = C.vcu; tile < MT / 32; tile += C.G) {
        const int m0 = tile * 32;
        __syncthreads();
        {
            const int tok = C.tid >> 4, cg = C.tid & 15, m = m0 + tok, col0 = 1536 + cg * 16;
            const float* prow = PRW + (size_t)m * SC + col0; const float* pprev = prow - SC; bool zero = false;
            if (m < MP) { zero = (m & (TP - 1)) == 0; } else { const int ms = m - MP; if ((ms & 3) == 0) pprev = sst + (size_t)(ms >> 2) * SC + col0; }
#pragma unroll
            for (int i = 0; i < 4; ++i) {
                const f32x4 p = *(const f32x4*)(prow + 4 * i); f32x4 q = (f32x4){0.f, 0.f, 0.f, 0.f}; if (!zero) q = *(const f32x4*)(pprev + 4 * i);
                const f32x4 mu = *(const f32x4*)(smu + col0 + 4 * i); f32x4 s = p + (q - p) * mu;
                if (cg < 4) { for (int e = 0; e < 4; ++e) { const float ex = __expf(2.f * s[e]); s[e] = 1.f - 2.f / (ex + 1.f); } }
                else if (cg >= 8) { for (int e = 0; e < 4; ++e) s[e] = sigmoidf_(s[e]); }
                *(LAS f32x4*)(act + tok * 256 + cg * 16 + 4 * i) = s;
            }
        }
        __syncthreads();
        float aw[32], aa[32], ag[32];
#pragma unroll
        for (int t = 0; t < 32; ++t) { aw[t] = 0.f; aa[t] = 0.f; ag[t] = 0.f; }
        for (int k = 0; k < 64; k += 4) {
            const float w_0 = wup[(k + 0) * RW + c], w_1 = wup[(k + 1) * RW + c], w_2 = wup[(k + 2) * RW + c], w_3 = wup[(k + 3) * RW + c];
            const float a_0 = aup[(k + 0) * RW + c], a_1 = aup[(k + 1) * RW + c], a_2 = aup[(k + 2) * RW + c], a_3 = aup[(k + 3) * RW + c];
#pragma unroll
            for (int t = 0; t < 32; ++t) {
                const f32x4 x = *(const LAS f32x4*)(act + t * 256 + k); const f32x4 y = *(const LAS f32x4*)(act + t * 256 + 64 + k);
                aw[t] += x[0] * w_0 + x[1] * w_1 + x[2] * w_2 + x[3] * w_3; aa[t] += y[0] * a_0 + y[1] * a_1 + y[2] * a_2 + y[3] * a_3;
            }
        }
        for (int k = 0; k < 128; k += 4) {
            const float g_0 = gup[(k + 0) * RW + c], g_1 = gup[(k + 1) * RW + c], g_2 = gup[(k + 2) * RW + c], g_3 = gup[(k + 3) * RW + c];
#pragma unroll
            for (int t = 0; t < 32; ++t) { const f32x4 x = *(const LAS f32x4*)(act + t * 256 + 128 + k); ag[t] += x[0] * g_0 + x[1] * g_1 + x[2] * g_2 + x[3] * g_3; }
        }
        float pr_p = 0.f, pk_p = 0.f, pv_p = 0.f;
        if (m0 < MP) { if ((m0 & (TP - 1)) != 0) { const float* pp = PRW + (size_t)(m0 - 1) * SC; pr_p = pp[c]; pk_p = pp[RW + c]; pv_p = pp[2 * RW + c]; } }
#pragma unroll
        for (int t = 0; t < 32; ++t) {
            const int m = m0 + t; const float* pc = PRW + (size_t)m * SC;
            const float pr = pc[c], pk = pc[RW + c], pv = pc[2 * RW + c];
            if (m0 >= MP && (t & 3) == 0) { const float* ss = sst + (size_t)((m - MP) >> 2) * SC; pr_p = ss[c]; pk_p = ss[RW + c]; pv_p = ss[2 * RW + c]; }
            const float r = pr + (pr_p - pr) * mu_r, k = pk + (pk_p - pk) * mu_k, v = pv + (pv_p - pv) * mu_v;
            pr_p = pr; pk_p = pk; pv_p = pv;
            const float u = w0 + aw[t];
            const float wlog = -__logf(1.f + __expf(-u)) - 0.5f;
            const float decay = __expf(-__expf(wlog));
            const float a = sigmoidf_(a0 + aa[t]);
            float kk = k * kkc; const float ss2 = wave_sum(kk * kk); kk *= rsqrtf(fmaxf(ss2, 1e-24f));
            const float kp = k * (1.f + (a - 1.f) * kac);
            const float bb = kk * a, wr = decay * r;
            const float br = wave_sum(bb * r), kr = wave_sum(kp * r), rkr = wave_sum(r * kp * rkc);
            float* rec = SCAN + ((size_t)m * 8 + h) * SREC;
            rec[j] = decay; rec[64 + j] = kk; rec[128 + j] = bb; rec[192 + j] = kp; rec[256 + j] = wr;
            *(f32x4*)(rec + 320 + 4 * j) = (f32x4){v, v * kr, br, 0.f};
            Gb[(size_t)m * RW + c] = ag[t]; BG[(size_t)m * RW + c] = rkr * v * ag[t];
        }
    }
}

__device__ __forceinline__ unsigned long long topk_select(const LAS float* vals, int nvis, int lane) {
    const int nreg = (nvis + 63) >> 6;
    unsigned key[64];
#pragma unroll
    for (int g = 0; g < 8; ++g) {
        if (g * 8 < nreg) {
#pragma unroll
            for (int e = 0; e < 8; ++e) { const int i = g * 8 + e; const int kidx = 64 * i + lane;
                unsigned u = 0u;
                if (kidx < nvis) { const float v = vals[kidx]; u = __builtin_bit_cast(unsigned, v); if ((u << 1) == 0u) u = 0u; u = (u & 0x80000000u) ? ~u : (u | 0x80000000u); }
                key[i] = u; }
        } else {
#pragma unroll
            for (int e = 0; e < 8; ++e) key[g * 8 + e] = 0u;
        }
    }
    unsigned long long myword = 0ull;
    const unsigned long long lt = (lane == 0) ? 0ull : (~0ull >> (64 - lane));
    if (nvis <= 256) {
#pragma unroll
        for (int i = 0; i < 4; ++i) { const unsigned long long m = __ballot(64 * i + lane < nvis); if (lane == i) myword = m; }
        return myword;
    }
    unsigned T = 0u;
    for (int bit = 31; bit >= 0; --bit) {
        const unsigned cand = T | (1u << bit); int cnt = 0;
#pragma unroll
        for (int g = 0; g < 8; ++g) if (g * 8 < nreg) {
#pragma unroll
            for (int e = 0; e < 8; ++e) cnt += __popcll(__ballot(key[g * 8 + e] >= cand));
        }
        if (cnt >= 256) T = cand;
    }
    int cgt = 0;
#pragma unroll
    for (int g = 0; g < 8; ++g) if (g * 8 < nreg) {
#pragma unroll
        for (int e = 0; e < 8; ++e) cgt += __popcll(__ballot(key[g * 8 + e] > T));
    }
    const int need = 256 - cgt; int run = 0;
#pragma unroll
    for (int g = 0; g < 8; ++g) if (g * 8 < nreg) {
#pragma unroll
        for (int e = 0; e < 8; ++e) { const int i = g * 8 + e;
            const bool eq = key[i] == T; const unsigned long long em = __ballot(eq);
            const int before = run + __popcll(em & lt);
            const bool s = (key[i] > T) || (eq && before < need); run += __popcll(em);
            const unsigned long long m = __ballot(s); if (lane == i) myword = m; }
    }
    return myword;
}
__device__ __forceinline__ void p3_topk(const Ctx& C, const void* const* in) {
    const float* QI = (const float*)(C.ws + WS_QI); const float* WI = (const float*)(C.ws + WS_WI);
    unsigned long long* MASK = (unsigned long long*)(C.ws + WS_MASK); int* SEL = (int*)(C.ws + WS_SEL);
    const int lane = C.lane, wave = C.wave, hi = lane >> 5;
    constexpr int NU_P = MP / 8, NU = NU_P + BS;
    for (int unit = C.vcu; unit < NU; unit += C.G) {
        __syncthreads();
        if (unit < NU_P) {
            LAS float* idx = (LAS float*)C.lds;
            const int kk_ = unit >> 8, vv_ = unit & 255, b = kk_ >> 1, t0 = ((kk_ & 1) ? 511 - vv_ : vv_) * 8, nkeys = t0 + 8;
            const int rho = lane & 31, q = rho >> 2, hh = rho & 3;
            const float* qrow = QI + ((size_t)(b * TP + t0 + q)) * 256 + hh * 64 + 8 * hi;
            bf16x8 af[4];
#pragma unroll
            for (int s = 0; s < 4; ++s) af[s] = pack_bf8(*(const f32x4*)(qrow + 16 * s), *(const f32x4*)(qrow + 16 * s + 4));
            f32x4 wiv[4];
#pragma unroll
            for (int g = 0; g < 4; ++g) wiv[g] = *(const f32x4*)(WI + ((size_t)(b * TP + t0 + 2 * g + hi)) * 4) * 0.125f;
            const float* KI = C.out + O_KIP + (size_t)b * TP * 64;
            const int ntile = (nkeys + 31) >> 5;
            for (int tile = wave; tile < ntile; tile += 8) {
                const int key = tile * 32 + rho;
                const float* krow = KI + (size_t)key * 64 + 8 * hi;
                f32x16 acc;
#pragma unroll
                for (int r = 0; r < 16; ++r) acc[r] = 0.f;
#pragma unroll
                for (int s = 0; s < 4; ++s) { const bf16x8 bf = pack_bf8(*(const f32x4*)(krow + 16 * s), *(const f32x4*)(krow + 16 * s + 4));
                    acc = __builtin_amdgcn_mfma_f32_32x32x16_bf16(af[s], bf, acc, 0, 0, 0); }
#pragma unroll
                for (int g = 0; g < 4; ++g) {
                    float v = 0.f;
#pragma unroll
                    for (int e = 0; e < 4; ++e) v += wiv[g][e] * fmaxf(acc[4 * g + e], 0.f);
                    idx[(2 * g + hi) * 4096 + key] = v;
                }
            }
            __syncthreads();
            const int t = t0 + wave;
            const unsigned long long w = topk_select(idx + wave * 4096, t + 1, lane);
            MASK[((size_t)(b * TP + t)) * 64 + lane] = w;
        } else {
            const int b = unit - NU_P;
            LAS float* qis = (LAS float*)C.lds;
            LAS float* wis = qis + 1024;
            LAS float* idx = qis + 1280;
            if (C.tid < 256) { const int row = C.tid >> 4, c4 = (C.tid & 15) * 4;
                *(LAS f32x4*)(qis + row * 64 + c4) = *(const f32x4*)(QI + ((size_t)(MP + b * 4 + (row >> 2))) * 256 + (row & 3) * 64 + c4); }
            if (C.tid < 16) wis[C.tid] = WI[((size_t)(MP + b * 4 + (C.tid >> 2))) * 4 + (C.tid & 3)] * 0.125f;
            __syncthreads();
            const int* pt = (const int*)in[5] + b * NPAGES;
            for (int s = C.tid; s < LS; s += NTHR) {
                const float* krow = (s < PAST) ? INF(4) + ((size_t)pt[s >> 7] * 128 + (s & 127)) * 64 : C.out + O_KIS + (size_t)(b * 4 + (s - PAST)) * 64;
                f32x4 kx[16];
#pragma unroll
                for (int i = 0; i < 16; ++i) kx[i] = *(const f32x4*)(krow + 4 * i);
#pragma unroll
                for (int t = 0; t < 4; ++t) {
                    float v = 0.f;
#pragma unroll
                    for (int hh = 0; hh < 4; ++hh) {
                        float d0 = 0.f, d1 = 0.f;
#pragma unroll
                        for (int i = 0; i < 16; i += 2) { const f32x4 qa = *(const LAS f32x4*)(qis + (t * 4 + hh) * 64 + 4 * i), qb = *(const LAS f32x4*)(qis + (t * 4 + hh) * 64 + 4 * i + 4);
                            d0 += kx[i][0] * qa[0] + kx[i][1] * qa[1] + kx[i][2] * qa[2] + kx[i][3] * qa[3];
                            d1 += kx[i + 1][0] * qb[0] + kx[i + 1][1] * qb[1] + kx[i + 1][2] * qb[2] + kx[i + 1][3] * qb[3]; }
                        v += wis[t * 4 + hh] * fmaxf(d0 + d1, 0.f);
                    }
                    idx[t * 2112 + s] = v;
                }
            }
            __syncthreads();
            if (wave < 4) {
                const int t = wave;
                unsigned long long w = topk_select(idx + t * 2112, PAST + t + 1, lane);
                int cnt = __popcll(w), pre = cnt;
#pragma unroll
                for (int o = 1; o < 64; o <<= 1) { const int x = __shfl_up(pre, o); if (lane >= o) pre += x; }
                int pos = pre - cnt; int* sel = SEL + (size_t)(b * 4 + t) * 256;
                while (w) { const int bit = __builtin_ctzll(w); if (pos < 256) sel[pos] = 64 * lane + bit; ++pos; w &= w - 1; }
            }
        }
    }
}

struct ScanVec { f32x4 w, kk, b, k, wr, tri; };
__device__ __forceinline__ f32x2 fma2(f32x2 a, f32x2 b, f32x2 c) { return __builtin_elementwise_fma(a, b, c); }
__device__ __forceinline__ float scan_step(f32x2& S01, f32x2& S23, const ScanVec& x) {
    f32x2 q1 = S01 * (f32x2){x.kk[0], x.kk[1]}; q1 = fma2(S23, (f32x2){x.kk[2], x.kk[3]}, q1);
    f32x2 q2 = S01 * (f32x2){x.wr[0], x.wr[1]}; q2 = fma2(S23, (f32x2){x.wr[2], x.wr[3]}, q2);
    float p1 = q1[0] + q1[1], p2 = q2[0] + q2[1];
    const f32x2 vv = (f32x2){x.tri[0], x.tri[0]};
    f32x2 t01 = vv * (f32x2){x.k[0], x.k[1]}; t01 = fma2(S01, (f32x2){x.w[0], x.w[1]}, t01);
    f32x2 t23 = vv * (f32x2){x.k[2], x.k[3]}; t23 = fma2(S23, (f32x2){x.w[2], x.w[3]}, t23);
    p1 = sum16(p1); p2 = sum16(p2);
    const f32x2 nsa = (f32x2){-p1, -p1};
    S01 = fma2(nsa, (f32x2){x.b[0], x.b[1]}, t01); S23 = fma2(nsa, (f32x2){x.b[2], x.b[3]}, t23);
    return p2 - p1 * x.tri[2] + x.tri[1];
}
__device__ __forceinline__ void p4_scan(const Ctx& C, const void* const* in) {
    const float* SCAN = (const float*)(C.ws + WS_SCAN); float* YST = (float*)(C.ws + WS_YS); float* YSS = YST + (size_t)MP * RW;
    const int lane = C.lane, wave = C.wave, rg = lane >> 4, jl = lane & 15;
    {
        const float* st = INF(6);
        for (int u = C.vcu * NWAVES + wave; u < BS * 8 * 16; u += C.G * NWAVES) {
            const int bh = u >> 4, b = bh >> 3, h = bh & 7, i = (u & 15) * 4 + rg;
            const f32x4 s4 = *(const f32x4*)(st + ((size_t)bh * 64 + i) * 64 + 4 * jl);
            f32x2 S01 = (f32x2){s4[0], s4[1]}, S23 = (f32x2){s4[2], s4[3]};
#pragma unroll
            for (int t = 0; t < 4; ++t) {
                const int m = MP + b * 4 + t; const float* rec = SCAN + ((size_t)m * 8 + h) * SREC;
                ScanVec x; x.w = *(const f32x4*)(rec + 4 * jl); x.kk = *(const f32x4*)(rec + 64 + 4 * jl); x.b = *(const f32x4*)(rec + 128 + 4 * jl);
                x.k = *(const f32x4*)(rec + 192 + 4 * jl); x.wr = *(const f32x4*)(rec + 256 + 4 * jl); x.tri = *(const f32x4*)(rec + 320 + 4 * i);
                const float y = scan_step(S01, S23, x);
                if (jl == 0) YSS[(size_t)(b * 4 + t) * RW + h * 64 + i] = y;
            }
            *(f32x4*)(C.out + O_WKVS + ((size_t)bh * 64 + i) * 64 + 4 * jl) = (f32x4){S01[0], S01[1], S23[0], S23[1]};
        }
    }
    __syncthreads();
    constexpr int CH = 16, CHB = CH * SREC * 4;
    for (int unit = C.vcu; unit < 256; unit += C.G) {
        const int bh = unit >> 3, b = bh >> 3, h = bh & 7, i = (unit & 7) * 8 + (wave & 1) * 4 + rg;
        const float* base = SCAN + ((size_t)(b * TP) * 8 + h) * SREC;
        const int ltid = C.tid - 128;
        const unsigned lv = (unsigned)jl * 16u, lt = 1280u + (unsigned)i * 16u;
#define SC_BAR() do { asm volatile("" ::: "memory"); __builtin_amdgcn_s_barrier(); asm volatile("" ::: "memory"); } while (0)
        if (wave >= 2) {
            unsigned goff[6];
#pragma unroll
            for (int k_ = 0; k_ < 6; ++k_) { const unsigned q_ = (unsigned)ltid + 384u * k_; const unsigned s_ = q_ / 144u, off_ = q_ - s_ * 144u; goff[k_] = s_ * (8u * SREC * 4u) + off_ * 16u; }
            f32x4 sA[6], sB[6], sC[6];
#define SC_GLOAD(ST, c_) do { const char* cbase_ = (const char*)(base + (size_t)(c_) * CH * 8 * SREC); _Pragma("unroll") for (int k_ = 0; k_ < 6; ++k_) ST[k_] = *(const f32x4*)(cbase_ + goff[k_]); } while (0)
#define SC_LSTORE(ST, boff_) do { _Pragma("unroll") for (int k_ = 0; k_ < 6; ++k_) *(LAS f32x4*)(C.lds + (boff_) + (ltid + 384 * k_) * 16) = ST[k_]; } while (0)
            SC_GLOAD(sA, 0); SC_GLOAD(sB, 1); SC_LSTORE(sA, 0); SC_LSTORE(sB, CHB);
            SC_GLOAD(sA, 2); SC_GLOAD(sB, 3); SC_GLOAD(sC, 4);
            asm volatile("s_waitcnt lgkmcnt(0)" ::: "memory"); SC_BAR();
            int b2 = 2 * CHB;
#define SC_LSUB(ST, c_) do { if ((c_) < TP / CH) { if ((c_) + 2 < TP / CH) SC_LSTORE(ST, b2); if ((c_) + 5 < TP / CH) SC_GLOAD(ST, (c_) + 5); \
                b2 = (b2 == 2 * CHB) ? 0 : b2 + CHB; asm volatile("s_waitcnt lgkmcnt(0)" ::: "memory"); SC_BAR(); } } while (0)
            for (int ch = 0; ch < TP / CH; ch += 3) { SC_LSUB(sA, ch); SC_LSUB(sB, ch + 1); SC_LSUB(sC, ch + 2); }
#undef SC_LSUB
#undef SC_GLOAD
#undef SC_LSTORE
        } else {
            SC_BAR();
            f32x2 S01 = (f32x2){0.f, 0.f}, S23 = (f32x2){0.f, 0.f};
            float* yrow = YST + ((size_t)bh * 64 + i) * TP + jl;
#define SC_LD(X, bufb, s_) do { const LAS unsigned char* r_ = C.lds + (bufb) + (s_) * (SREC * 4); \
            X.w = *(const LAS f32x4*)(r_ + lv); X.kk = *(const LAS f32x4*)(r_ + 256 + lv); X.b = *(const LAS f32x4*)(r_ + 512 + lv); \
            X.k = *(const LAS f32x4*)(r_ + 768 + lv); X.wr = *(const LAS f32x4*)(r_ + 1024 + lv); X.tri = *(const LAS f32x4*)(r_ + lt); } while (0)
            ScanVec xa, xb;
            SC_LD(xa, 0, 0);
            int cb = 0, nb = CHB;
            for (int ch = 0; ch < TP / CH; ++ch) {
                float ykeep = 0.f;
#define SC_STEP(XC, XN, s_) do { if ((s_) + 1 < CH) SC_LD(XN, cb, (s_) + 1); else if (ch + 1 < TP / CH) SC_LD(XN, nb, 0); \
                    __builtin_amdgcn_sched_barrier(0); \
                    { const float y_ = scan_step(S01, S23, XC); ykeep = (jl == (s_)) ? y_ : ykeep; asm volatile("" :: "v"(XC.tri[3])); } \
                    __builtin_amdgcn_sched_barrier(0); } while (0)
                SC_STEP(xa, xb, 0); SC_STEP(xb, xa, 1); SC_STEP(xa, xb, 2); SC_STEP(xb, xa, 3);
                SC_STEP(xa, xb, 4); SC_STEP(xb, xa, 5); SC_STEP(xa, xb, 6); SC_STEP(xb, xa, 7);
                SC_STEP(xa, xb, 8); SC_STEP(xb, xa, 9); SC_STEP(xa, xb, 10); SC_STEP(xb, xa, 11);
                SC_STEP(xa, xb, 12); SC_STEP(xb, xa, 13); SC_STEP(xa, xb, 14); SC_STEP(xb, xa, 15);
                yrow[ch * CH] = ykeep;
                cb = nb; nb = (nb == 2 * CHB) ? 0 : nb + CHB;
                SC_BAR();
            }
#undef SC_STEP
#undef SC_LD
            *(f32x4*)(C.out + O_WKVP + ((size_t)bh * 64 + i) * 64 + 4 * jl) = (f32x4){S01[0], S01[1], S23[0], S23[1]};
        }
#undef SC_BAR
        __syncthreads();
    }
}
__device__ __forceinline__ float wave_sum_fast(float x) { x = sum16(x); x += __shfl_xor(x, 16); x += __shfl_xor(x, 32); return x; }
__device__ __forceinline__ void p5_post(const Ctx& C, const void* const* in) {
    const float* YST = (const float*)(C.ws + WS_YS); const float* YSS = YST + (size_t)MP * RW;
    const float* Gb = (const float*)(C.ws + WS_G); const float* BG = (const float*)(C.ws + WS_BG); bf16* MIX = (bf16*)(C.ws + WS_MIX);
    const int c = C.tid, h = C.wave, j = C.lane;
    const float gg = INF(20)[c], gb = INF(21)[c];
    for (int u = C.vcu; u < MT / 16; u += C.G) {
        const int m0 = u * 16;
        float yv[16];
        if (m0 < MP) { const int b = m0 >> 12, t0 = m0 & (TP - 1); const float* yp = YST + ((size_t)(b * 8 + h) * 64 + j) * TP + t0;
#pragma unroll
            for (int q = 0; q < 4; ++q) { const f32x4 v = *(const f32x4*)(yp + 4 * q); yv[4 * q] = v[0]; yv[4 * q + 1] = v[1]; yv[4 * q + 2] = v[2]; yv[4 * q + 3] = v[3]; }
        } else {
#pragma unroll
            for (int t = 0; t < 16; ++t) yv[t] = YSS[(size_t)(m0 - MP + t) * RW + c];
        }
#pragma unroll
        for (int t = 0; t < 16; ++t) {
            const int m = m0 + t; const float y = yv[t];
            const float mu = wave_sum_fast(y) * (1.f / 64.f); const float d = y - mu; const float var = wave_sum_fast(d * d) * (1.f / 64.f);
            const float yn = d * rsqrtf(var + GN_EPS) * gg + gb;
            const float o = yn * Gb[(size_t)m * RW + c] + BG[(size_t)m * RW + c];
            MIX[(size_t)m * DM + c] = (bf16)f2bf(o);
        }
    }
}
__device__ __forceinline__ int t5_bucket(int d) {
    if (d < 16) return d;
    int b = 16;
    b += (d >= 19); b += (d >= 21); b += (d >= 24); b += (d >= 27); b += (d >= 31); b += (d >= 35); b += (d >= 40); b += (d >= 46);
    b += (d >= 52); b += (d >= 59); b += (d >= 67); b += (d >= 77); b += (d >= 87); b += (d >= 99); b += (d >= 113);
    return b;
}
constexpr int KROW = 72, VROW = 68;
constexpr int ATT_KB = 64 * KROW * 2, ATT_VB = 64 * VROW * 2;
__device__ __forceinline__ void attn_prompt_unit(const Ctx& C, int b, int h, int qb, const LAS float* btab) {
    const bf16* QB = (const bf16*)(C.ws + WS_QB); const bf16* KB = (const bf16*)(C.ws + WS_KB); const bf16* VB = (const bf16*)(C.ws + WS_VB);
    const unsigned long long* MASK = (const unsigned long long*)(C.ws + WS_MASK); bf16* MIX = (bf16*)(C.ws + WS_MIX);
    LAS unsigned char* kbuf = C.lds; LAS unsigned char* vbuf = C.lds + 2 * ATT_KB;
    const int lane = C.lane, wave = C.wave, r32 = lane & 31, hi = lane >> 5;
    const int q0 = qb * 256, qw0 = q0 + wave * 32, q = qw0 + r32;
    const size_t rowb = (size_t)b * TP;
    const int NT = (q0 + 256) / 64;
    bf16x8 qf[4];
#pragma unroll
    for (int s = 0; s < 4; ++s) qf[s] = *(const bf16x8*)(QB + (rowb + q) * RW + h * 64 + 16 * s + 8 * hi);
    const unsigned long long* mrow = MASK + (rowb + q) * 64;
    const int srow = C.tid >> 3, sch = C.tid & 7;
    const bf16* kg = KB + (rowb + srow) * RW + h * 64 + sch * 8; const bf16* vg = VB + (rowb + srow) * RW + h * 64 + sch * 8;
    v4u kst, vst;
#define ATT_GLOAD(t) do { kst = *(const v4u*)(kg + (size_t)(t) * 64 * RW); vst = *(const v4u*)(vg + (size_t)(t) * 64 * RW); } while (0)
#define ATT_LSTORE(bi) do { *(LAS v4u*)(kbuf + (bi) * ATT_KB + srow * (KROW * 2) + sch * 16) = kst; \
        LAS unsigned short* vt_ = (LAS unsigned short*)(vbuf + (bi) * ATT_VB) + (sch * 8) * VROW + srow; \
        vt_[0 * VROW] = (unsigned short)(vst.x & 0xffffu); vt_[1 * VROW] = (unsigned short)(vst.x >> 16); vt_[2 * VROW] = (unsigned short)(vst.y & 0xffffu); vt_[3 * VROW] = (unsigned short)(vst.y >> 16); \
        vt_[4 * VROW] = (unsigned short)(vst.z & 0xffffu); vt_[5 * VROW] = (unsigned short)(vst.z >> 16); vt_[6 * VROW] = (unsigned short)(vst.w & 0xffffu); vt_[7 * VROW] = (unsigned short)(vst.w >> 16); } while (0)
    __syncthreads();
    ATT_GLOAD(0); ATT_LSTORE(0);
    __syncthreads();
    f32x16 o0, o1;
#pragma unroll
    for (int r = 0; r < 16; ++r) { o0[r] = 0.f; o1[r] = 0.f; }
    float mrun = -1e30f, lrun = 0.f;
    unsigned long long mw = mrow[0];
    for (int t = 0; t < NT; ++t) {
        const int bi = t & 1;
        if (t + 1 < NT) ATT_GLOAD(t + 1);
        const unsigned long long mcur = mw; if (t + 1 < NT) mw = mrow[t + 1];
        const int kv0 = t * 64;
        if (kv0 <= qw0 + 31) {
            f32x16 p0, p1;
#pragma unroll
            for (int r = 0; r < 16; ++r) { p0[r] = 0.f; p1[r] = 0.f; }
            const LAS unsigned char* kb0 = kbuf + bi * ATT_KB + r32 * (KROW * 2) + hi * 16;
#pragma unroll
            for (int s = 0; s < 4; ++s) {
                const bf16x8 ka = *(const LAS bf16x8*)(kb0 + s * 32), kb2 = *(const LAS bf16x8*)(kb0 + 32 * (KROW * 2) + s * 32);
                p0 = __builtin_amdgcn_mfma_f32_32x32x16_bf16(ka, qf[s], p0, 0, 0, 0);
                p1 = __builtin_amdgcn_mfma_f32_32x32x16_bf16(kb2, qf[s], p1, 0, 0, 0);
            }
            if (kv0 + 63 + 113 > qw0) {
#pragma unroll
                for (int r = 0; r < 16; ++r) { const int kv = kv0 + (r & 3) + 8 * (r >> 2) + 4 * hi;
                    int d0 = q - kv; d0 = d0 < 0 ? 0 : (d0 > 127 ? 127 : d0); int d1 = q - kv - 32; d1 = d1 < 0 ? 0 : (d1 > 127 ? 127 : d1);
                    p0[r] += btab[h * 128 + d0]; p1[r] += btab[h * 128 + d1]; }
            }
            float mx = p0[0];
#pragma unroll
            for (int r = 1; r < 16; ++r) mx = fmaxf(mx, p0[r]);
#pragma unroll
            for (int r = 0; r < 16; ++r) mx = fmaxf(mx, p1[r]);
            mx = fmaxf(mx, __shfl_xor(mx, 32));
            const float mnew = fmaxf(mrun, mx);
            const float alpha = __builtin_amdgcn_exp2f(mrun - mnew);
            mrun = mnew;
            const unsigned wlo = (unsigned)mcur >> (4 * hi), whi = (unsigned)(mcur >> 32) >> (4 * hi);
            float ls = 0.f;
#pragma unroll
            for (int r = 0; r < 16; ++r) { const int pos = (r & 3) + 8 * (r >> 2);
                const int m0 = __builtin_amdgcn_sbfe(wlo, pos, 1), m1 = __builtin_amdgcn_sbfe(whi, pos, 1);
                const float e0 = __builtin_amdgcn_exp2f(p0[r] - mnew), e1 = __builtin_amdgcn_exp2f(p1[r] - mnew);
                p0[r] = __builtin_bit_cast(float, __builtin_bit_cast(int, e0) & m0); p1[r] = __builtin_bit_cast(float, __builtin_bit_cast(int, e1) & m1);
                ls += p0[r] + p1[r]; }
            lrun = lrun * alpha + ls;
            if (__any(alpha != 1.f)) {
#pragma unroll
                for (int r = 0; r < 16; ++r) { o0[r] *= alpha; o1[r] *= alpha; }
            }
            const LAS unsigned char* vb0 = vbuf + bi * ATT_VB + r32 * (VROW * 2) + hi * 8;
#pragma unroll
            for (int jj = 0; jj < 4; ++jj) {
                f32x4 pa, pb;
                if (jj == 0) { pa = (f32x4){p0[0], p0[1], p0[2], p0[3]}; pb = (f32x4){p0[4], p0[5], p0[6], p0[7]}; }
                else if (jj == 1) { pa = (f32x4){p0[8], p0[9], p0[10], p0[11]}; pb = (f32x4){p0[12], p0[13], p0[14], p0[15]}; }
                else if (jj == 2) { pa = (f32x4){p1[0], p1[1], p1[2], p1[3]}; pb = (f32x4){p1[4], p1[5], p1[6], p1[7]}; }
                else { pa = (f32x4){p1[8], p1[9], p1[10], p1[11]}; pb = (f32x4){p1[12], p1[13], p1[14], p1[15]}; }
                const bf16x8 pf = pack_bf8(pa, pb);
                typedef unsigned u32x2 __attribute__((ext_vector_type(2)));
                const u32x2 a0 = *(const LAS u32x2*)(vb0 + jj * 32), a1 = *(const LAS u32x2*)(vb0 + jj * 32 + 16);
                const u32x2 c0 = *(const LAS u32x2*)(vb0 + 32 * (VROW * 2) + jj * 32), c1 = *(const LAS u32x2*)(vb0 + 32 * (VROW * 2) + jj * 32 + 16);
                const bf16x8 va = __builtin_bit_cast(bf16x8, (v4u){a0.x, a0.y, a1.x, a1.y}), vc = __builtin_bit_cast(bf16x8, (v4u){c0.x, c0.y, c1.x, c1.y});
                o0 = __builtin_amdgcn_mfma_f32_32x32x16_bf16(va, pf, o0, 0, 0, 0);
                o1 = __builtin_amdgcn_mfma_f32_32x32x16_bf16(vc, pf, o1, 0, 0, 0);
            }
        }
        if (t + 1 < NT) ATT_LSTORE(bi ^ 1);
        __syncthreads();
    }
#undef ATT_GLOAD
#undef ATT_LSTORE
    const float ltot = lrun + __shfl_xor(lrun, 32);
    const float inv = 1.f / ltot;
    bf16* orow = MIX + (rowb + q) * DM + RW + h * 64;
#pragma unroll
    for (int g = 0; g < 4; ++g) {
        const int d = 8 * g + 4 * hi;
        typedef unsigned u32x2 __attribute__((ext_vector_type(2)));
        u32x2 w0, w1;
        w0.x = pk2(o0[4 * g] * inv, o0[4 * g + 1] * inv); w0.y = pk2(o0[4 * g + 2] * inv, o0[4 * g + 3] * inv);
        w1.x = pk2(o1[4 * g] * inv, o1[4 * g + 1] * inv); w1.y = pk2(o1[4 * g + 2] * inv, o1[4 * g + 3] * inv);
        *(u32x2*)(orow + d) = w0; *(u32x2*)(orow + 32 + d) = w1;
    }
}
__device__ __forceinline__ void attn_sample_pair(const Ctx& C, const void* const* in, int pair, const LAS float* btab, LAS float* comb) {
    const bf16* QB = (const bf16*)(C.ws + WS_QB); const int* SEL = (const int*)(C.ws + WS_SEL); bf16* MIX = (bf16*)(C.ws + WS_MIX);
    const int lane = C.lane, hh = lane >> 3, ch = lane & 7, wq = C.wave >> 2, part = C.wave & 3;
    const int qi_ = pair * 2 + wq, b = qi_ >> 2, t = qi_ & 3, m = MP + qi_, qpos = PAST + t;
    float qv[8];
    { const v4u qq = *(const v4u*)(QB + (size_t)m * RW + hh * 64 + ch * 8);
      qv[0] = bf2f(qq.x & 0xffffu); qv[1] = bf2f(qq.x >> 16); qv[2] = bf2f(qq.y & 0xffffu); qv[3] = bf2f(qq.y >> 16);
      qv[4] = bf2f(qq.z & 0xffffu); qv[5] = bf2f(qq.z >> 16); qv[6] = bf2f(qq.w & 0xffffu); qv[7] = bf2f(qq.w >> 16); }
    const int* pt = (const int*)in[5] + b * NPAGES;
    const int* sel = SEL + (size_t)qi_ * 256 + part * 64;
    const float* ck = INF(2); const float* cv = INF(3);
    float acc[8] = {0.f, 0.f, 0.f, 0.f, 0.f, 0.f, 0.f, 0.f}; float mrun = -1e30f, lrun = 0.f;
    for (int j0 = 0; j0 < 64; j0 += 8) {
        f32x4 k0[8], k1[8], v0[8], v1[8]; float bias[8];
#pragma unroll
        for (int u = 0; u < 8; ++u) {
            const int s = sel[j0 + u];
            const float *kr, *vr;
            if (s < PAST) { const size_t row = (size_t)pt[s >> 7] * 128 + (s & 127); kr = ck + row * RW; vr = cv + row * RW; }
            else { const size_t row = (size_t)(b * 4 + (s - PAST)); kr = C.out + O_KS + row * RW; vr = C.out + O_VS + row * RW; }
            kr += hh * 64 + ch * 8; vr += hh * 64 + ch * 8;
            k0[u] = *(const f32x4*)kr; k1[u] = *(const f32x4*)(kr + 4); v0[u] = *(const f32x4*)vr; v1[u] = *(const f32x4*)(vr + 4);
            int d = qpos - s; d = d < 0 ? 0 : (d > 127 ? 127 : d); bias[u] = btab[1024 + hh * 128 + d];
        }
#pragma unroll
        for (int u = 0; u < 8; ++u) {
            float p = qv[0] * k0[u][0] + qv[1] * k0[u][1] + qv[2] * k0[u][2] + qv[3] * k0[u][3] + qv[4] * k1[u][0] + qv[5] * k1[u][1] + qv[6] * k1[u][2] + qv[7] * k1[u][3];
            p = sum8(p) + bias[u];
            const float mnew = fmaxf(mrun, p); const float alpha = __builtin_amdgcn_exp2f(mrun - mnew), e = __builtin_amdgcn_exp2f(p - mnew);
            mrun = mnew; lrun = lrun * alpha + e;
            acc[0] = acc[0] * alpha + e * v0[u][0]; acc[1] = acc[1] * alpha + e * v0[u][1]; acc[2] = acc[2] * alpha + e * v0[u][2]; acc[3] = acc[3] * alpha + e * v0[u][3];
            acc[4] = acc[4] * alpha + e * v1[u][0]; acc[5] = acc[5] * alpha + e * v1[u][1]; acc[6] = acc[6] * alpha + e * v1[u][2]; acc[7] = acc[7] * alpha + e * v1[u][3];
        }
    }
    LAS float* cw = comb + ((wq * 4 + part) * 64 + lane) * 12;
    *(LAS f32x4*)cw = (f32x4){acc[0], acc[1], acc[2], acc[3]}; *(LAS f32x4*)(cw + 4) = (f32x4){acc[4], acc[5], acc[6], acc[7]}; *(LAS f32x2*)(cw + 8) = (f32x2){mrun, lrun};
    __syncthreads();
    if (part == 0) {
        float M = mrun;
#pragma unroll
        for (int p = 1; p < 4; ++p) M = fmaxf(M, comb[((wq * 4 + p) * 64 + lane) * 12 + 8]);
        float f = __builtin_amdgcn_exp2f(mrun - M), L = lrun * f;
#pragma unroll
        for (int e = 0; e < 8; ++e) acc[e] *= f;
#pragma unroll
        for (int p = 1; p < 4; ++p) { const LAS float* cp = comb + ((wq * 4 + p) * 64 + lane) * 12; const f32x4 a0 = *(const LAS f32x4*)cp, a1 = *(const LAS f32x4*)(cp + 4); const f32x2 ml = *(const LAS f32x2*)(cp + 8);
            const float fp = __builtin_amdgcn_exp2f(ml[0] - M); L += ml[1] * fp;
            acc[0] += a0[0] * fp; acc[1] += a0[1] * fp; acc[2] += a0[2] * fp; acc[3] += a0[3] * fp; acc[4] += a1[0] * fp; acc[5] += a1[1] * fp; acc[6] += a1[2] * fp; acc[7] += a1[3] * fp; }
        const float inv = 1.f / L;
        v4u w; w.x = pk2(acc[0] * inv, acc[1] * inv); w.y = pk2(acc[2] * inv, acc[3] * inv); w.z = pk2(acc[4] * inv, acc[5] * inv); w.w = pk2(acc[6] * inv, acc[7] * inv);
        *(v4u*)(MIX + (size_t)m * DM + RW + hh * 64 + ch * 8) = w;
    }
    __syncthreads();
}
__device__ __forceinline__ void p5_attn(const Ctx& C, const void* const* in, int rep_s, int rep_p) {
    LAS float* btab = (LAS float*)(C.lds + 2 * ATT_KB + 2 * ATT_VB);
    const float* rb = INF(9);
    for (int i = C.tid; i < 1024; i += NTHR) { const int hh = i >> 7, d = i & 127; const float bv = rb[t5_bucket(d) * 8 + hh];
        btab[i] = (bv - rb[31 * 8 + hh]) * LOG2E; btab[1024 + i] = bv * LOG2E; }
    __syncthreads();
    for (int rr = 0; rr < rep_s; ++rr) for (int pr = C.vcu; pr < MS / 2; pr += C.G) attn_sample_pair(C, in, pr, btab, btab + 2048);
    for (int rr = 0; rr < rep_p; ++rr) for (int u = C.vcu; u < 512; u += C.G) {
        const int bh = (u & 255) >> 3, s = u & 7, qb = (u < 256) ? s : 15 - s;
        attn_prompt_unit(C, bh >> 3, bh & 7, qb, btab);
    }
}

__device__ __forceinline__ void ln_rows(const Ctx& C, const float* Z, const float* g, const float* bt, float* outP, float* outS, bf16* ob) {
    const int gw = C.vcu * NWAVES + C.wave, NGW = C.G * NWAVES;
    f32x4 gv[4], bv[4];
#pragma unroll
    for (int j = 0; j < 4; ++j) { gv[j] = *((const f32x4*)g + C.lane + 64 * j); bv[j] = *((const f32x4*)bt + C.lane + 64 * j); }
    for (int m = gw; m < MT; m += NGW) {
        const f32x4* zr = (const f32x4*)(Z + (size_t)m * DM) + C.lane;
        f32x4 v[4]; float s = 0.f;
#pragma unroll
        for (int j = 0; j < 4; ++j) { v[j] = zr[64 * j]; s += (v[j].x + v[j].y) + (v[j].z + v[j].w); }
        const float mean = wave_sum(s) * (1.f / DM); float s2 = 0.f;
#pragma unroll
        for (int j = 0; j < 4; ++j) { v[j] = v[j] - mean; s2 += (v[j].x * v[j].x + v[j].y * v[j].y) + (v[j].z * v[j].z + v[j].w * v[j].w); }
        const float rstd = rsqrtf(wave_sum(s2) * (1.f / DM) + LN_EPS);
        float* orow = (m < MP) ? outP + (size_t)m * DM : outS + (size_t)(m - MP) * DM;
#pragma unroll
        for (int j = 0; j < 4; ++j) { const f32x4 o = v[j] * rstd * gv[j] + bv[j]; *((f32x4*)orow + C.lane + 64 * j) = o;
            if (ob) *((unsigned long long*)(ob + (size_t)m * DM) + C.lane + 64 * j) = (unsigned long long)pk2(o.x, o.y) | ((unsigned long long)pk2(o.z, o.w) << 32); }
    }
}

__device__ __forceinline__ void p9_conv(const Ctx& C, const void* const* in) {
    const bf16* UC = (const bf16*)(C.ws + WS_UC); const bf16* UL = (const bf16*)(C.ws + WS_UL); bf16* H = (bf16*)(C.ws + WS_H);
    const float* cw = INF(26); const float* cb = INF(27); const float* cst = INF(8);
    constexpr int CPR = FF / 8;
    const long total = (long)MT * CPR;
    for (long it = (long)C.vcu * NTHR + C.tid; it < total; it += (long)C.G * NTHR) {
        const int m = (int)(it / CPR), c = (int)(it - (long)m * CPR) * 8;
        int t; const float* prev = nullptr;
        if (m < MP) t = m & (TP - 1); else { const int ms = m - MP; t = ms & 3; prev = cst + (size_t)(ms >> 2) * 2 * FF; }
        float u0[8], u1[8], u2[8], ul[8];
        { const v4u a = *(const v4u*)(UC + (size_t)m * FF + c); const v4u l = *(const v4u*)(UL + (size_t)m * FF + c);
          u2[0] = bf2f(a.x & 0xffffu); u2[1] = bf2f(a.x >> 16); u2[2] = bf2f(a.y & 0xffffu); u2[3] = bf2f(a.y >> 16); u2[4] = bf2f(a.z & 0xffffu); u2[5] = bf2f(a.z >> 16); u2[6] = bf2f(a.w & 0xffffu); u2[7] = bf2f(a.w >> 16);
          ul[0] = bf2f(l.x & 0xffffu); ul[1] = bf2f(l.x >> 16); ul[2] = bf2f(l.y & 0xffffu); ul[3] = bf2f(l.y >> 16); ul[4] = bf2f(l.z & 0xffffu); ul[5] = bf2f(l.z >> 16); ul[6] = bf2f(l.w & 0xffffu); ul[7] = bf2f(l.w >> 16); }
        if (t >= 1) { const v4u a = *(const v4u*)(UC + (size_t)(m - 1) * FF + c);
          u1[0] = bf2f(a.x & 0xffffu); u1[1] = bf2f(a.x >> 16); u1[2] = bf2f(a.y & 0xffffu); u1[3] = bf2f(a.y >> 16); u1[4] = bf2f(a.z & 0xffffu); u1[5] = bf2f(a.z >> 16); u1[6] = bf2f(a.w & 0xffffu); u1[7] = bf2f(a.w >> 16); }
        else { for (int e = 0; e < 8; ++e) u1[e] = prev ? prev[FF + c + e] : 0.f; }
        if (t >= 2) { const v4u a = *(const v4u*)(UC + (size_t)(m - 2) * FF + c);
          u0[0] = bf2f(a.x & 0xffffu); u0[1] = bf2f(a.x >> 16); u0[2] = bf2f(a.y & 0xffffu); u0[3] = bf2f(a.y >> 16); u0[4] = bf2f(a.z & 0xffffu); u0[5] = bf2f(a.z >> 16); u0[6] = bf2f(a.w & 0xffffu); u0[7] = bf2f(a.w >> 16); }
        else { for (int e = 0; e < 8; ++e) u0[e] = prev ? prev[t * FF + c + e] : 0.f; }
        float hv[8];
#pragma unroll
        for (int e = 0; e < 8; ++e) { const float cv = u0[e] * cw[c + e] + u1[e] * cw[FF + c + e] + u2[e] * cw[2 * FF + c + e] + cb[c + e];
            hv[e] = cv / (1.f + __expf(-cv)) * ul[e]; }
        v4u w; w.x = pk2(hv[0], hv[1]); w.y = pk2(hv[2], hv[3]); w.z = pk2(hv[4], hv[5]); w.w = pk2(hv[6], hv[7]);
        *(v4u*)(H + (size_t)m * FF + c) = w;
    }
}

#ifndef PROBE_PHASE
#define PROBE_PHASE -1
#endif
struct Args { const void* in[31]; float* out; unsigned char* ws; int ph_lo, ph_hi; };
__global__ void __launch_bounds__(NTHR, 2) fwd_kernel(Args args) {
    extern __shared__ __attribute__((aligned(16))) unsigned char lds_raw[];
    Ctx C;
    C.lds = (LAS unsigned char*)lds_raw; C.tid = threadIdx.x; C.lane = C.tid & 63; C.wave = __builtin_amdgcn_readfirstlane(C.tid >> 6);
    C.G = gridDim.x; { const int bx = blockIdx.x; C.vcu = (C.G % 8 == 0) ? (bx % 8) * (C.G / 8) + bx / 8 : bx; }
    C.out = args.out; C.ws = args.ws;
    const void* const* in = args.in;
    volatile LAS unsigned* MISC = (volatile LAS unsigned*)(C.lds + MISC_OFF);
    for (int u = C.tid; u < (LDS_BYTES - LDSCTL_OFF) / 4; u += NTHR) ((LAS unsigned*)(C.lds + LDSCTL_OFF))[u] = 0u;
    __syncthreads();
    const int lo = args.ph_lo, hi = args.ph_hi;
    const bool multi = (hi - lo) > 1;
    XcdBarrier bar; bar.bar = (unsigned*)(C.ws + WS_CTL) + CW_BAR; bar.x = 0; bar.st = nullptr;
    if (multi) bar = xcd_barrier_post((unsigned*)(C.ws + WS_CTL) + CW_BAR, MISC + 8);
#define IN(k) (lo <= (k) && (k) < hi)
#define SEAM(k) do { if (IN(k) && IN((k) + 1)) xcd_barrier(bar); } while (0)
    bf16* XB = (bf16*)(C.ws + WS_XB); bf16* MIX = (bf16*)(C.ws + WS_MIX); bf16* X1B = (bf16*)(C.ws + WS_X1B); bf16* HB = (bf16*)(C.ws + WS_H);
    float* Z = (float*)(C.ws + WS_Z); float* X1 = (float*)(C.ws + WS_X1);

#define RUN0 do { p0_prologue(C, in); } while (0)
#define RUN1 do { pg8::Gemm g{XB, (const bf16*)(C.ws + WS_WIN), MT, NINP, DM}; pg8::StaticOrder S; S.init(MT, NINP, C.G, (int)blockIdx.x); \
        pg8::EpiIn E{(float*)(C.ws + WS_PRW), (bf16*)(C.ws + WS_QB), (bf16*)(C.ws + WS_KB), (bf16*)(C.ws + WS_VB), (float*)(C.ws + WS_QI), (float*)(C.ws + WS_WI), C.out}; \
        pg8::gemm_phase<pg8::EpiIn, pg8::StaticOrder, true, true>(C.lds, g, S, E); } while (0)
#define RUN2 do { p2_prep(C, in); } while (0)
#define RUN3 do { p3_topk(C, in); } while (0)
#define RUN4 do { p4_scan(C, in); } while (0)
#define RUN5 do { p5_post(C, in); if (PROBE_PHASE == 50) { __syncthreads(); p5_post(C, in); } p5_attn(C, in, PROBE_PHASE == 51 ? 2 : 1, PROBE_PHASE == 52 ? 2 : 1); } while (0)
#define RUN6 do { pg8::Gemm g{MIX, (const bf16*)(C.ws + WS_WOUT), MT, DM, DM}; pg8::StaticOrder S; S.init(MT, DM, C.G, (int)blockIdx.x); \
        pg8::EpiRes E{INF(0), INF(1), Z}; pg8::gemm_phase<pg8::EpiRes, pg8::StaticOrder, true, true>(C.lds, g, S, E); } while (0)
#define RUN7 do { ln_rows(C, Z, INF(23), INF(24), X1, X1 + (size_t)MP * DM, X1B); } while (0)
#define RUN8 do { pg8::Gemm g{X1B, (const bf16*)(C.ws + WS_WUP), MT, NUP, DM}; pg8::StaticOrder S; S.init(MT, NUP, C.G, (int)blockIdx.x); \
        pg8::EpiUp E{(bf16*)(C.ws + WS_UC), (bf16*)(C.ws + WS_UL), C.out}; pg8::gemm_phase<pg8::EpiUp, pg8::StaticOrder, true, true>(C.lds, g, S, E); } while (0)
#define RUN9 do { p9_conv(C, in); } while (0)
#define RUN10 do { pg8::Gemm g{HB, (const bf16*)(C.ws + WS_WDN), MT, DM, FF}; pg8::StaticOrder S; S.init(MT, DM, C.G, (int)blockIdx.x); \
        pg8::EpiRes E{X1, X1 + (size_t)MP * DM, Z}; pg8::gemm_phase<pg8::EpiRes, pg8::StaticOrder, true, true>(C.lds, g, S, E); } while (0)
#define RUN11 do { ln_rows(C, Z, INF(29), INF(30), C.out + O_YP, C.out + O_YS, nullptr); } while (0)
#define PHASE(k, RUN) do { if (IN(k)) { RUN; if (PROBE_PHASE == (k)) { __syncthreads(); xcd_barrier(bar); RUN; } } SEAM(k); } while (0)
    PHASE(0, RUN0); PHASE(1, RUN1); PHASE(2, RUN2); PHASE(3, RUN3); PHASE(4, RUN4); PHASE(5, RUN5);
    PHASE(6, RUN6); PHASE(7, RUN7); PHASE(8, RUN8); PHASE(9, RUN9); PHASE(10, RUN10); PHASE(11, RUN11);
#undef IN
#undef SEAM
}

#ifndef N_LAUNCH_MODE
#define N_LAUNCH_MODE 1
#endif
extern "C" void kernel_launch(void* const* d_in, const int* in_sizes, int n_in, void* d_out, int out_size, void* d_ws, size_t ws_size, hipStream_t stream) {
    static int grid = 0;
    if (grid == 0) {
        if (n_in != 31 || out_size != (int)O_END || ws_size < WS_END) { fprintf(stderr, "kernel_launch: unexpected shapes (n_in %d, out %d, ws %zu)\n", n_in, out_size, ws_size); grid = -1; return; }
        int dev = 0, cus = 0, per_cu = 0;
        if (hipGetDevice(&dev) != hipSuccess || hipDeviceGetAttribute(&cus, hipDeviceAttributeMultiprocessorCount, dev) != hipSuccess) { grid = -1; return; }
        if (hipFuncSetAttribute((const void*)fwd_kernel, hipFuncAttributeMaxDynamicSharedMemorySize, LDS_BYTES) != hipSuccess) { fprintf(stderr, "kernel_launch: hipFuncSetAttribute failed\n"); grid = -1; return; }
        if (hipOccupancyMaxActiveBlocksPerMultiprocessor(&per_cu, (const void*)fwd_kernel, NTHR, LDS_BYTES) != hipSuccess || per_cu < 1) fprintf(stderr, "kernel_launch: occupancy query says %d\n", per_cu);
        (void)hipGetLastError();
        grid = cus;
    }
    if (grid < 0) return;
    (void)hipMemsetAsync((char*)d_ws + WS_CTL, 0, CTL_ZERO_BYTES, stream);
    Args a{};
    for (int i = 0; i < 31; ++i) a.in[i] = d_in[i];
    a.out = (float*)d_out; a.ws = (unsigned char*)d_ws;
#if N_LAUNCH_MODE == 1
    a.ph_lo = 0; a.ph_hi = NPHASE;
    hipLaunchKernelGGL(fwd_kernel, dim3(grid), dim3(NTHR), LDS_BYTES, stream, a);
#else
    for (int p = 0; p < NPHASE; ++p) { a.ph_lo = p; a.ph_hi = p + 1; hipLaunchKernelGGL(fwd_kernel, dim3(grid), dim3(NTHR), LDS_BYTES, stream, a); }
#endif
    const hipError_t le = hipPeekAtLastError();
    if (le != hipSuccess) fprintf(stderr, "kernel_launch: launch failed: %s\n", hipGetErrorName(le));
}
```

```cpp
#include <hip/hip_runtime.h>
#include <cstdio>
#include <cstdint>
namespace pg8 {
#define PG8_LAS __attribute__((address_space(3)))
typedef unsigned short bf16_t;
typedef short bf16x8 __attribute__((ext_vector_type(8)));
typedef float f32x4 __attribute__((ext_vector_type(4)));
typedef unsigned u32x4 __attribute__((ext_vector_type(4)));
constexpr int BM = 256, BK = 64, HALF = 128, HTB = HALF * BK * 2  , STAGE_BYTES = 8 * HTB, NXCD = 8, WGM = 8;

__host__ __device__ __forceinline__ int lds_byte(int r, int c) { const int st = (r >> 4) * 2 + (c >> 5), rr = r & 15, cc = c & 31, ob = rr * 64 + cc * 2; return st * 1024 + (ob ^ (((ob >> 9) & 1) << 5)); }
__host__ __device__ __forceinline__ void stage_rc(int b, int& R, int& C) { const int st = b / 1024, sb = b % 1024, swz = sb ^ (((sb >> 9) & 1) << 5); R = (st >> 1) * 16 + swz / 64; C = (st & 1) * 32 + (swz % 64) / 2; }
__host__ __device__ __forceinline__ int perm32(int rho) { const int n = rho >> 4, i = rho & 15; return 8 * (i >> 2) + 4 * n + (i & 3); }

struct Unit { int pm, pn; };
struct Gemm { const bf16_t* A; const bf16_t* Bt; int M, N, K; };

struct StaticOrder {
    int nM, nN, nwg, G, c;
    __host__ __device__ void init(int M, int N, int G_, int c_) { nM = M / BM; nN = N / BM; nwg = nM * nN; G = G_; c = c_; }
    __host__ __device__ bool next(int i, Unit& u) const {
        const long L = (long)i * G + c; if (L >= nwg) return false;
        int wgid = (int)L; { const int q = nwg / NXCD, r = nwg % NXCD, xcd = wgid % NXCD, off = wgid / NXCD; wgid = (xcd < r ? xcd * (q + 1) : r * (q + 1) + (xcd - r) * q) + off; }
        const int nig = WGM * nN, gid = wgid / nig, fm = gid * WGM, gsz = (nM - fm) < WGM ? (nM - fm) : WGM;
        u.pm = fm + ((wgid % nig) % gsz); u.pn = (wgid % nig) / gsz; return true;
    }
    __device__ __forceinline__ void a_ready(const Unit&) const {}
    __device__ __forceinline__ void done(const Unit&) const {}
};

__device__ __forceinline__ unsigned cvt_pk_bf16(float lo, float hi) { unsigned r; asm volatile("v_cvt_pk_bf16_f32 %0, %1, %2" : "=v"(r) : "v"(lo), "v"(hi)); return r; }
typedef float f32x2 __attribute__((ext_vector_type(2)));
template <class Epi, class Sched, bool ALIGN_EPI = false, bool SP2 = false>
__device__ __forceinline__ void gemm_phase(PG8_LAS unsigned char* lds, const Gemm g, const Sched& S, const Epi& E) {
    const int tid = threadIdx.x, wid = __builtin_amdgcn_readfirstlane(tid >> 6), lane = tid & 63, wr = wid >> 2, wc = wid & 3, fr = lane & 15, fq = lane >> 4;
    const int K = g.K, nt = K / BK;
    unsigned voffA[2], voffB[2];
#pragma unroll
    for (int i = 0; i < 2; ++i) { int R, C; stage_rc(tid * 16 + i * 8192, R, C); const int Rb = Epi::PERM ? ((R & ~31) + perm32(R & 31)) : R;
        voffA[i] = (unsigned)(R * K + C) * 2u; voffB[i] = (unsigned)(Rb * K + C) * 2u; }
    const size_t kstep = (size_t)(BK * 2);
    const size_t hstep = (size_t)HALF * K * 2;
    const size_t tstep = 2 * hstep;
    const unsigned ldsw = (unsigned)wid * 1024u;
    const int aoff = lds_byte(wr * 64 + fr, fq * 8), boff = lds_byte(wc * 32 + fr, fq * 8);
#define PG8_SA(b, h) (((b) * 2 + (h)) * HTB)
#define PG8_SB(b, h) ((4 + (b) * 2 + (h)) * HTB)
#define PG8_STAGE(bufoff, gbase, voff) do { _Pragma("unroll") for (int _i = 0; _i < 2; ++_i) \
        __builtin_amdgcn_global_load_lds((const unsigned*)((const char*)(gbase) + (voff)[_i]), (PG8_LAS unsigned*)(lds + (bufoff) + ldsw + _i * 8192), 16, 0, 0); } while (0)
#define PG8_LDA(dst, b, h) do { _Pragma("unroll") for (int m = 0; m < 4; ++m) _Pragma("unroll") for (int k = 0; k < 2; ++k) dst[m][k] = *(const PG8_LAS bf16x8*)(lds + PG8_SA(b, h) + aoff + m * 2048 + k * 1024); } while (0)
#define PG8_LDB(dst, b, h) do { _Pragma("unroll") for (int n = 0; n < 2; ++n) _Pragma("unroll") for (int k = 0; k < 2; ++k) dst[n][k] = *(const PG8_LAS bf16x8*)(lds + PG8_SB(b, h) + boff + n * 2048 + k * 1024); } while (0)
#define PG8_MMA(ai, bj, At, Bt) do { __builtin_amdgcn_s_setprio(1); _Pragma("unroll") for (int m = 0; m < 4; ++m) _Pragma("unroll") for (int n = 0; n < 2; ++n) _Pragma("unroll") for (int k = 0; k < 2; ++k) \
        acc[ai][bj][m][n] = __builtin_amdgcn_mfma_f32_16x16x32_bf16(Bt[n][k], At[m][k], acc[ai][bj][m][n], 0, 0, 0); __builtin_amdgcn_s_setprio(0); } while (0)
#define PG8_WAIT_V(n) asm volatile("s_waitcnt vmcnt(" #n ")" ::: "memory")
#define PG8_WAIT_L(n) asm volatile("s_waitcnt lgkmcnt(" #n ")" ::: "memory")
#define PG8_BAR __builtin_amdgcn_s_barrier()
#define PG8_SCHED __builtin_amdgcn_sched_barrier(0)
    Unit cur, nxt; int ui = 0;
    if (!S.next(0, cur)) return;
    f32x4 acc[2][2][4][2];
#pragma unroll
    for (int a = 0; a < 2; ++a)
#pragma unroll
        for (int b = 0; b < 2; ++b)
#pragma unroll
            for (int m = 0; m < 4; ++m)
#pragma unroll
                for (int n = 0; n < 2; ++n) acc[a][b][m][n] = (f32x4){0.f, 0.f, 0.f, 0.f};
    bf16x8 At[4][2], B0[2][2], B1[2][2];
    const char* cA = (const char*)g.A + (size_t)cur.pm * tstep; const char* cB = (const char*)g.Bt + (size_t)cur.pn * tstep;
    S.a_ready(cur);
    if constexpr (SP2) {
        PG8_STAGE(PG8_SB(0, 0), cB, voffB); PG8_STAGE(PG8_SB(0, 1), cB + hstep, voffB); PG8_STAGE(PG8_SA(0, 0), cA, voffA); PG8_STAGE(PG8_SA(0, 1), cA + hstep, voffA);
        if (wr == 1) PG8_BAR;
        PG8_WAIT_V(2); PG8_BAR;
        PG8_STAGE(PG8_SB(1, 0), cB + kstep, voffB); PG8_STAGE(PG8_SA(1, 0), cA + kstep, voffA); PG8_STAGE(PG8_SB(1, 1), cB + hstep + kstep, voffB);
        PG8_WAIT_V(6); PG8_BAR;
    } else {
        PG8_STAGE(PG8_SB(0, 0), cB, voffB); PG8_STAGE(PG8_SA(0, 0), cA, voffA); PG8_STAGE(PG8_SB(0, 1), cB + hstep, voffB); PG8_STAGE(PG8_SA(0, 1), cA + hstep, voffA);
        if (wr == 1) PG8_BAR;
        PG8_WAIT_V(4); PG8_BAR;
        PG8_STAGE(PG8_SB(1, 0), cB + kstep, voffB); PG8_STAGE(PG8_SA(1, 0), cA + kstep, voffA); PG8_STAGE(PG8_SB(1, 1), cB + hstep + kstep, voffB);
        PG8_WAIT_V(6); PG8_BAR;
    }
    for (;;) {
        const bool has_next = S.next(ui + 1, nxt);
        const char* nA = has_next ? (const char*)g.A + (size_t)nxt.pm * tstep : cA; const char* nB = has_next ? (const char*)g.Bt + (size_t)nxt.pn * tstep : cB;
        for (int t = 0; t < nt; t += 2) {
            const bool last = (t == nt - 2);
            const char* a1 = cA + (size_t)(t + 1) * kstep;
            const char* a2 = last ? nA : cA + (size_t)(t + 2) * kstep; const char* b2 = last ? nB : cB + (size_t)(t + 2) * kstep;
            const char* a3 = a2 + kstep; const char* b3 = b2 + kstep;
            if (last && has_next) S.a_ready(nxt);
            if constexpr (SP2) {
            PG8_LDB(B0, 0, 0); PG8_LDB(B1, 0, 1); PG8_SCHED; PG8_LDA(At, 0, 0); PG8_STAGE(PG8_SA(1, 1), a1 + hstep, voffA);
            PG8_WAIT_V(8); PG8_WAIT_L(0); PG8_BAR; PG8_MMA(0, 0, At, B0); PG8_MMA(0, 1, At, B1); PG8_BAR; PG8_SCHED;
            PG8_LDA(At, 0, 1); PG8_STAGE(PG8_SB(0, 0), b2, voffB); PG8_STAGE(PG8_SB(0, 1), b2 + hstep, voffB); PG8_STAGE(PG8_SA(0, 0), a2, voffA);
            PG8_WAIT_V(8); PG8_WAIT_L(0); PG8_BAR; PG8_MMA(1, 0, At, B0); PG8_MMA(1, 1, At, B1); PG8_BAR; PG8_SCHED;
            PG8_LDB(B0, 1, 0); PG8_LDB(B1, 1, 1); PG8_SCHED; PG8_LDA(At, 1, 0); PG8_STAGE(PG8_SA(0, 1), a2 + hstep, voffA);
            PG8_WAIT_V(8); PG8_WAIT_L(0); PG8_BAR; PG8_MMA(0, 0, At, B0); PG8_MMA(0, 1, At, B1); PG8_BAR; PG8_SCHED;
            PG8_LDA(At, 1, 1); PG8_STAGE(PG8_SB(1, 0), b3, voffB); PG8_STAGE(PG8_SB(1, 1), b3 + hstep, voffB); PG8_STAGE(PG8_SA(1, 0), a3, voffA);
            PG8_WAIT_V(8); PG8_WAIT_L(0); PG8_BAR; PG8_MMA(1, 0, At, B0); PG8_MMA(1, 1, At, B1); PG8_BAR; PG8_SCHED;
            } else {
            PG8_LDB(B0, 0, 0); PG8_SCHED; PG8_LDA(At, 0, 0); PG8_STAGE(PG8_SA(1, 1), a1 + hstep, voffA);
            PG8_WAIT_L(8); PG8_BAR; PG8_WAIT_L(0); PG8_MMA(0, 0, At, B0); PG8_BAR; PG8_SCHED;
            PG8_LDB(B1, 0, 1); PG8_STAGE(PG8_SB(0, 0), b2, voffB);
            PG8_BAR; PG8_WAIT_L(0); PG8_MMA(0, 1, At, B1); PG8_BAR;
            PG8_LDA(At, 0, 1); PG8_STAGE(PG8_SA(0, 0), a2, voffA);
            PG8_BAR; PG8_WAIT_L(0); PG8_MMA(1, 0, At, B0); PG8_BAR; PG8_SCHED;
            PG8_STAGE(PG8_SB(0, 1), b2 + hstep, voffB);
            PG8_WAIT_V(6); PG8_BAR; PG8_MMA(1, 1, At, B1); PG8_BAR;
            PG8_LDB(B0, 1, 0); PG8_SCHED; PG8_LDA(At, 1, 0); PG8_STAGE(PG8_SA(0, 1), a2 + hstep, voffA);
            PG8_WAIT_L(8); PG8_BAR; PG8_WAIT_L(0); PG8_MMA(0, 0, At, B0); PG8_BAR; PG8_SCHED;
            PG8_LDB(B1, 1, 1); PG8_STAGE(PG8_SB(1, 0), b3, voffB);
            PG8_BAR; PG8_WAIT_L(0); PG8_MMA(0, 1, At, B1); PG8_BAR;
            PG8_LDA(At, 1, 1); PG8_STAGE(PG8_SA(1, 0), a3, voffA);
            PG8_BAR; PG8_WAIT_L(0); PG8_MMA(1, 0, At, B0); PG8_BAR; PG8_SCHED;
            PG8_STAGE(PG8_SB(1, 1), b3 + hstep, voffB);
            PG8_WAIT_V(6); PG8_BAR; PG8_MMA(1, 1, At, B1); PG8_BAR;
            }
        }
        if constexpr (ALIGN_EPI) { if (wr == 0) PG8_BAR; }
        if constexpr (!Epi::AFTER_DRAIN) { E(acc, cur, wr, wc, fr, fq); S.done(cur); }
        if (!has_next) break;
#pragma unroll
        for (int a = 0; a < 2; ++a)
#pragma unroll
            for (int b = 0; b < 2; ++b)
#pragma unroll
                for (int m = 0; m < 4; ++m)
#pragma unroll
                    for (int n = 0; n < 2; ++n) acc[a][b][m][n] = (f32x4){0.f, 0.f, 0.f, 0.f};
        cur = nxt; cA = nA; cB = nB; ++ui;
        if constexpr (ALIGN_EPI) { if (wr == 1) PG8_BAR; }
    }
    PG8_WAIT_V(0);
    if constexpr (!ALIGN_EPI) { if (wr == 0) PG8_BAR; }
    PG8_BAR;
    if constexpr (Epi::AFTER_DRAIN) { E.fused(acc, cur, wr, wc, fr, fq, lds, wid, lane); S.done(cur); }
#undef PG8_SA
#undef PG8_SB
#undef PG8_STAGE
#undef PG8_LDA
#undef PG8_LDB
#undef PG8_MMA
#undef PG8_WAIT_V
#undef PG8_WAIT_L
#undef PG8_BAR
#undef PG8_SCHED
}
}
#define GAS __attribute__((address_space(1)))
#define LAS __attribute__((address_space(3)))
typedef unsigned short bf16;
typedef unsigned v4u __attribute__((ext_vector_type(4)));
typedef float f32x4 __attribute__((ext_vector_type(4)));
typedef short bf16x8 __attribute__((ext_vector_type(8)));
typedef GAS unsigned gu32;
typedef GAS unsigned long long gu64;
#define RLX_AGENT __ATOMIC_RELAXED, __HIP_MEMORY_SCOPE_AGENT
#define LDS_WAIT() asm volatile("s_waitcnt lgkmcnt(0)" ::: "memory")
#define VM_WAIT() asm volatile("s_waitcnt vmcnt(0)" ::: "memory")
__device__ __forceinline__ unsigned long long rt() { return __builtin_amdgcn_s_memrealtime(); }
__device__ __forceinline__ unsigned f2bf(float f) { unsigned u = __builtin_bit_cast(unsigned, f); return (u + 0x7fffu + ((u >> 16) & 1u)) >> 16; }
typedef float pk2_f32x2 __attribute__((ext_vector_type(2))); typedef __bf16 pk2_bf16x2 __attribute__((ext_vector_type(2)));
__device__ __forceinline__ unsigned pk2(float lo, float hi) { pk2_f32x2 v = {lo, hi}; pk2_bf16x2 b = __builtin_convertvector(v, pk2_bf16x2); return __builtin_bit_cast(unsigned, b); }

#define XB_TMO      128
#define XB_XCNT(j)  (256  + 64 * (j))
#define XB_XSUB(j)  (1280 + 64 * (j))
#define XB_XGEN(j)  (2304 + 64 * (j))
#define XB_TOP      3328
#define XB_TOPGEN   3392
#define XCD_BAR_WORDS 3456
#define XB_SPIN_CAP (1u << 18)

__device__ __forceinline__ unsigned xb_ld(unsigned* p)              { return __hip_atomic_load(p, __ATOMIC_RELAXED, __HIP_MEMORY_SCOPE_AGENT); }
__device__ __forceinline__ unsigned xb_add(unsigned* p, unsigned v) { return __hip_atomic_fetch_add(p, v, __ATOMIC_RELAXED, __HIP_MEMORY_SCOPE_AGENT); }
__device__ __forceinline__ unsigned xb_xcc_id() { return (unsigned)__builtin_amdgcn_s_getreg((3 << 11) | 20) & 0xFu; }
#define XB_SPIN(cond, bar) do { unsigned _sp = 0; while (cond) { __builtin_amdgcn_s_sleep(1); \
    if ((++_sp & 255u) == 0u) { if (xb_ld(&(bar)[XB_TMO])) break; if (_sp > XB_SPIN_CAP) { atomicAdd(&(bar)[XB_TMO], 1u); break; } } } } while (0)

struct XcdBarrier {
    unsigned* bar; unsigned x;
    volatile LAS unsigned* st;
};

__device__ __forceinline__ XcdBarrier xcd_barrier_post(unsigned* bar, volatile LAS unsigned* st) {
    XcdBarrier b; b.bar = bar; b.x = xb_xcc_id(); b.st = st;
    if (threadIdx.x == 0) (void)xb_add(&bar[XB_XCNT(b.x)], 1u);
    return b;
}
__device__ __forceinline__ void xcd_barrier_complete(unsigned* bar, unsigned x, unsigned& nloc, unsigned& nx) {
    const unsigned G = gridDim.x * gridDim.y * gridDim.z;
    unsigned sum, cnt, mine, sp = 0u;
    for (;;) {
        sum = 0u; cnt = 0u; mine = 0u;
#pragma unroll
        for (unsigned j = 0; j < 16; ++j) { const unsigned c = xb_ld(&bar[XB_XCNT(j)]); sum += c; cnt += (c > 0u) ? 1u : 0u; mine = (j == x) ? c : mine; }
        if (sum == G) break;
        __builtin_amdgcn_s_sleep(1);
        if ((++sp & 255u) == 0u) { if (xb_ld(&bar[XB_TMO])) break; if (sp > XB_SPIN_CAP) { atomicAdd(&bar[XB_TMO], 1u); break; } }
    }
    nloc = mine > 0u ? mine : 1u; nx = cnt > 0u ? cnt : 1u;
}

__device__ __forceinline__ void xcd_barrier(const XcdBarrier& b) {
    asm volatile("s_waitcnt vmcnt(0)" ::: "memory");
    __syncthreads();
    if (threadIdx.x == 0) {
        unsigned* bar = b.bar;
        __builtin_amdgcn_s_waitcnt(0);
        unsigned nloc = b.st[0], nx = b.st[1];
        if (nloc == 0u) { xcd_barrier_complete(bar, b.x, nloc, nx); b.st[0] = nloc; b.st[1] = nx; }
        const unsigned old = xb_add(&bar[XB_XSUB(b.x)], 1u);
        const unsigned gen = old / nloc;
        if (old + 1u == (gen + 1u) * nloc) {
            __builtin_amdgcn_fence(__ATOMIC_RELEASE, "agent");
            asm volatile("s_waitcnt vmcnt(0)" ::: "memory");
            const unsigned og = xb_add(&bar[XB_TOP], 1u);
            const unsigned tg = og / nx;
            if (og + 1u == (tg + 1u) * nx) xb_add(&bar[XB_TOPGEN], 1u);
            else XB_SPIN(xb_ld(&bar[XB_TOPGEN]) == tg, bar);
            __builtin_amdgcn_fence(__ATOMIC_ACQUIRE, "agent");
            xb_add(&bar[XB_XGEN(b.x)], 1u);
            asm volatile("s_waitcnt vmcnt(0)" ::: "memory");
        } else {
            XB_SPIN(xb_ld(&bar[XB_XGEN(b.x)]) == gen, bar);
            __builtin_amdgcn_fence(__ATOMIC_ACQUIRE, "agent");
            asm volatile("s_waitcnt vmcnt(0)" ::: "memory");
        }
    }
    __syncthreads();
}
#ifndef PROBE_PHASE
#define PROBE_PHASE -1
#endif
constexpr int TP = 4096, BP = 4, MP = BP * TP;
constexpr int BS = 128, TS = 4, MS = BS * TS;
constexpr int MT = MP + MS;
constexpr int DM = 1024, RW = 512, SC = 1792, NINP = 3840, FF = 2816, NUP = 5632;
constexpr int PAST = 2048, NPAGES = 16, LS = PAST + TS;
constexpr float ALPHA = 1.189207115002721f;
constexpr float LN_EPS = 1e-5f, GN_EPS = 64e-5f;
constexpr float QSCALE = 0.125f * 1.4426950408889634f;
constexpr float LOG2E = 1.4426950408889634f;
constexpr size_t O_YP = 0, O_YS = 16777216, O_KP = 17301504, O_VP = 25690112, O_KIP = 34078720, O_WKVP = 35127296, O_SHP = 35258368, O_CVP = 35265536,
                 O_KS = 35288064, O_VS = 35550208, O_KIS = 35812352, O_WKVS = 35845120, O_SHS = 40039424, O_CVS = 40268800, O_END = 40989696;

namespace pg8 {
__device__ __forceinline__ u32x4 pack8(const f32x4 a, const f32x4 b) { u32x4 w; w.x = cvt_pk_bf16(a[0], a[1]); w.y = cvt_pk_bf16(a[2], a[3]); w.z = cvt_pk_bf16(b[0], b[1]); w.w = cvt_pk_bf16(b[2], b[3]); return w; }
struct EpiIn {
    static constexpr bool PERM = true, AFTER_DRAIN = false;
    float* prw; bf16_t* qb; bf16_t* kb; bf16_t* vb; float* qi; float* wi; float* out;
    __device__ __forceinline__ void operator()(const f32x4 (&acc)[2][2][4][2], const Unit& u, int wr, int wc, int fr, int fq) const {
        const int pn = u.pn; const bool samp = u.pm >= 64;
#pragma unroll
        for (int ai = 0; ai < 2; ++ai)
#pragma unroll
            for (int m = 0; m < 4; ++m) {
                const int row = u.pm * BM + ai * HALF + wr * 64 + m * 16 + fr;
                const int rs = row - MP;
#pragma unroll
                for (int bj = 0; bj < 2; ++bj) {
                    const int col = pn * BM + bj * HALF + wc * 32 + 8 * fq;
                    const f32x4 v0 = acc[ai][bj][m][0], v1 = acc[ai][bj][m][1];
                    if (pn < 7) {
                        float* p = prw + (size_t)row * SC + col; *(f32x4*)p = v0; *(f32x4*)(p + 4) = v1;
                        const bool last = samp ? ((rs & 3) == 3) : ((row & (TP - 1)) == TP - 1);
                        if (last) { float* o = samp ? out + O_SHS + (size_t)(rs >> 2) * SC + col : out + O_SHP + (size_t)(row >> 12) * SC + col; *(f32x4*)o = v0; *(f32x4*)(o + 4) = v1; }
                    } else if (pn < 9) {
                        const int c = col - 1792; *(u32x4*)(qb + (size_t)row * RW + c) = pack8(v0 * QSCALE, v1 * QSCALE);
                    } else if (pn < 11) {
                        const int c = col - 2304; float* o = samp ? out + O_KS + (size_t)rs * RW + c : out + O_KP + (size_t)row * RW + c; *(f32x4*)o = v0; *(f32x4*)(o + 4) = v1;
                        *(u32x4*)(kb + (size_t)row * RW + c) = pack8(v0, v1);
                    } else if (pn < 13) {
                        const int c = col - 2816; float* o = samp ? out + O_VS + (size_t)rs * RW + c : out + O_VP + (size_t)row * RW + c; *(f32x4*)o = v0; *(f32x4*)(o + 4) = v1;
                        *(u32x4*)(vb + (size_t)row * RW + c) = pack8(v0, v1);
                    } else if (pn == 13) {
                        const int c = col - 3328; float* o = qi + (size_t)row * 256 + c; *(f32x4*)o = v0; *(f32x4*)(o + 4) = v1;
                    } else {
                        const int c = col - 3584;
                        if (c < 64) { float* o = samp ? out + O_KIS + (size_t)rs * 64 + c : out + O_KIP + (size_t)row * 64 + c; *(f32x4*)o = v0; *(f32x4*)(o + 4) = v1; }
                        else if (c == 64) { *(f32x4*)(wi + (size_t)row * 4) = v0 * 0.5f; }
                    }
                }
            }
    }
};
struct EpiRes {
    static constexpr bool PERM = true, AFTER_DRAIN = false;
    const float* resP; const float* resS; float* out;
    __device__ __forceinline__ void operator()(const f32x4 (&acc)[2][2][4][2], const Unit& u, int wr, int wc, int fr, int fq) const {
        const bool samp = u.pm >= 64;
#pragma unroll
        for (int ai = 0; ai < 2; ++ai)
#pragma unroll
            for (int m = 0; m < 4; ++m) {
                const int row = u.pm * BM + ai * HALF + wr * 64 + m * 16 + fr;
                const float* rr = samp ? resS + (size_t)(row - MP) * DM : resP + (size_t)row * DM;
#pragma unroll
                for (int bj = 0; bj < 2; ++bj) {
                    const int col = u.pn * BM + bj * HALF + wc * 32 + 8 * fq;
                    const f32x4 r0 = *(const f32x4*)(rr + col), r1 = *(const f32x4*)(rr + col + 4);
                    float* o = out + (size_t)row * DM + col;
                    *(f32x4*)o = r0 * ALPHA + acc[ai][bj][m][0]; *(f32x4*)(o + 4) = r1 * ALPHA + acc[ai][bj][m][1];
                }
            }
    }
};
struct EpiUp {
    static constexpr bool PERM = true, AFTER_DRAIN = false;
    bf16_t* uc; bf16_t* ul; float* out;
    __device__ __forceinline__ void operator()(const f32x4 (&acc)[2][2][4][2], const Unit& u, int wr, int wc, int fr, int fq) const {
        const bool samp = u.pm >= 64;
#pragma unroll
        for (int ai = 0; ai < 2; ++ai)
#pragma unroll
            for (int m = 0; m < 4; ++m) {
                const int row = u.pm * BM + ai * HALF + wr * 64 + m * 16 + fr;
                const int c = u.pn * HALF + wc * 32 + 8 * fq;
                *(u32x4*)(uc + (size_t)row * FF + c) = pack8(acc[ai][0][m][0], acc[ai][0][m][1]);
                *(u32x4*)(ul + (size_t)row * FF + c) = pack8(acc[ai][1][m][0], acc[ai][1][m][1]);
                if (samp) { const int rs = row - MP, t = rs & 3; if (t >= 2) { float* o = out + O_CVS + ((size_t)(rs >> 2) * 2 + (t - 2)) * FF + c; *(f32x4*)o = acc[ai][0][m][0]; *(f32x4*)(o + 4) = acc[ai][0][m][1]; } }
                else { const int t = row & (TP - 1); if (t >= TP - 2) { float* o = out + O_CVP + ((size_t)(row >> 12) * 2 + (t - (TP - 2))) * FF + c; *(f32x4*)o = acc[ai][0][m][0]; *(f32x4*)(o + 4) = acc[ai][0][m][1]; } }
            }
    }
};
}
constexpr size_t MiB = 1u << 20;
constexpr size_t WS_CTL = 0, CTL_ZERO_BYTES = 1 * MiB;
constexpr size_t WS_WIN = 2 * MiB;
constexpr size_t WS_WOUT = 10 * MiB;
constexpr size_t WS_WUP = 12 * MiB;
constexpr size_t WS_WDN = 24 * MiB;
constexpr size_t WS_XB = 32 * MiB;
constexpr size_t WS_PRW = 66 * MiB;
constexpr size_t WS_QB = 182 * MiB;
constexpr size_t WS_KB = 199 * MiB;
constexpr size_t WS_VB = 216 * MiB;
constexpr size_t WS_QI = 233 * MiB;
constexpr size_t WS_WI = 250 * MiB;
constexpr size_t WS_SCAN = 1024 * MiB;
constexpr size_t WS_G = 454 * MiB;
constexpr size_t WS_BG = 251 * MiB;
constexpr size_t WS_YS = 489 * MiB;
constexpr size_t WS_MASK = 523 * MiB;
constexpr size_t WS_SEL = 532 * MiB;
constexpr size_t WS_MIX = 533 * MiB;
constexpr size_t WS_Z = 567 * MiB;
constexpr size_t WS_X1 = 634 * MiB;
constexpr size_t WS_X1B = 701 * MiB;
constexpr size_t WS_UC = 735 * MiB;
constexpr size_t WS_UL = 826 * MiB;
constexpr size_t WS_H = 917 * MiB;
constexpr size_t WS_END = 1330 * MiB;
constexpr int CW_BAR = 4096;
constexpr int CW_Q = 64;
constexpr int SREC = 576;

constexpr int RING_BYTES = 131072, LDSCTL_OFF = RING_BYTES, MISC_OFF = LDSCTL_OFF + 320, LDS_BYTES = 147456;
constexpr int NWAVES = 8, NTHR = 512;
constexpr int NPHASE = 12;

__device__ __forceinline__ float bf2f(unsigned short h) { return __builtin_bit_cast(float, (unsigned)h << 16); }
__device__ __forceinline__ float wave_sum(float v) {
#pragma unroll
    for (int o = 1; o < 64; o <<= 1) v += __shfl_xor(v, o);
    return v;
}
template <int CTRL> __device__ __forceinline__ float dppf(float x) { return __builtin_bit_cast(float, __builtin_amdgcn_update_dpp(0, __builtin_bit_cast(int, x), CTRL, 0xf, 0xf, true)); }
__device__ __forceinline__ float sum16(float x) {
    x += dppf<0xB1>(x); x += dppf<0x4E>(x); x += dppf<0x141>(x); x += dppf<0x140>(x); return x;
}
__device__ __forceinline__ float sum8(float x) {
    x += dppf<0xB1>(x); x += dppf<0x4E>(x); x += dppf<0x141>(x); return x;
}
__device__ __forceinline__ bf16x8 pack_bf8(const f32x4 a, const f32x4 b) {
    v4u w; w.x = pk2(a[0], a[1]); w.y = pk2(a[2], a[3]); w.z = pk2(b[0], b[1]); w.w = pk2(b[2], b[3]); return __builtin_bit_cast(bf16x8, w);
}
typedef float f32x16 __attribute__((ext_vector_type(16)));
typedef float f32x2 __attribute__((ext_vector_type(2)));

struct Ctx {
    LAS unsigned char* lds; int tid, lane, wave, vcu, G;
    const void* const* in_; float* out; unsigned char* ws;
};
#define INF(k) ((const float*)in[k])

template <int MODE> __device__ __forceinline__ void p0_tr_item(const float* W, int K, int N, int nblk, bf16* WT, LAS float* scr, int item, int lane) {
    const int kb = item / nblk, nb = item % nblk, k0 = 64 * kb, n0 = 32 * nb;
    const int nl0 = lane & 31; const bool okn = (n0 + nl0) < N;
#pragma unroll 8
    for (int i = 0; i < 32; ++i) { const int kk = 2 * i + (lane >> 5); scr[kk * 33 + nl0] = okn ? W[(size_t)(k0 + kk) * N + n0 + nl0] : 0.f; }
    asm volatile("s_waitcnt lgkmcnt(0)" ::: "memory");
    const int c = lane & 7;
#pragma unroll
    for (int j = 0; j < 4; ++j) { const int nl = (lane >> 3) + 8 * j; const int n = n0 + nl; const LAS float* s = scr + (8 * c) * 33 + nl;
        int row = n;
        if (MODE == 2) row = (n < FF) ? 256 * (n >> 7) + (n & 127) : 256 * ((n - FF) >> 7) + 128 + ((n - FF) & 127);
        v4u o; o.x = pk2(s[0 * 33], s[1 * 33]); o.y = pk2(s[2 * 33], s[3 * 33]); o.z = pk2(s[4 * 33], s[5 * 33]); o.w = pk2(s[6 * 33], s[7 * 33]);
        *(GAS v4u*)(WT + (size_t)row * K + k0 + 8 * c) = o; }
    asm volatile("s_waitcnt lgkmcnt(0)" ::: "memory");
}
__device__ __forceinline__ void p0_prologue(const Ctx& C, const void* const* in) {
    LAS float* scr = (LAS float*)(C.lds + C.wave * 16384);
    const int gw = C.vcu * NWAVES + C.wave, NGW = C.G * NWAVES;
    constexpr int I_IN = 16 * 120, I_OUT = 16 * 32, I_UP = 16 * 176, I_DN = 44 * 32, NITEMS = I_IN + I_OUT + I_UP + I_DN;
    bf16* win = (bf16*)(C.ws + WS_WIN); bf16* wout = (bf16*)(C.ws + WS_WOUT); bf16* wup = (bf16*)(C.ws + WS_WUP); bf16* wdn = (bf16*)(C.ws + WS_WDN);
    for (int it = gw; it < NITEMS; it += NGW) {
        int r = it;
        if (r < I_IN) { p0_tr_item<0>(INF(10), DM, 3652, 120, win, scr, r, C.lane); continue; } r -= I_IN;
        if (r < I_OUT) { p0_tr_item<0>(INF(22), DM, DM, 32, wout, scr, r, C.lane); continue; } r -= I_OUT;
        if (r < I_UP) { p0_tr_item<2>(INF(25), DM, NUP, 176, wup, scr, r, C.lane); continue; } r -= I_UP;
        p0_tr_item<0>(INF(28), FF, DM, 32, wdn, scr, r, C.lane);
    }
    bf16* xb = (bf16*)(C.ws + WS_XB);
    for (int m = gw; m < MT; m += NGW) {
        const float* xr = (m < MP) ? INF(0) + (size_t)m * DM : INF(1) + (size_t)(m - MP) * DM;
        const GAS f32x4* x4 = (const GAS f32x4*)xr + C.lane;
        GAS unsigned long long* o8 = (GAS unsigned long long*)(xb + (size_t)m * DM) + C.lane;
#pragma unroll
        for (int j = 0; j < 4; ++j) { const f32x4 v = x4[64 * j]; o8[64 * j] = (unsigned long long)pk2(v.x, v.y) | ((unsigned long long)pk2(v.z, v.w) << 32); }
    }
}

__device__ __forceinline__ float sigmoidf_(float x) { return 1.f / (1.f + __expf(-x)); }
__device__ __forceinline__ void p2_prep(const Ctx& C, const void* const* in) {
    LAS float* act = (LAS float*)C.lds;
    const float* PRW = (const float*)(C.ws + WS_PRW);
    float* SCAN = (float*)(C.ws + WS_SCAN); float* Gb = (float*)(C.ws + WS_G); float* BG = (float*)(C.ws + WS_BG);
    const float* smu = INF(11); const float* sst = INF(7);
    const float* wup = INF(13); const float* aup = INF(15); const float* gup = INF(16);
    const int c = C.tid, h = C.wave, j = C.lane;
    const float mu_r = smu[c], mu_k = smu[RW + c], mu_v = smu[2 * RW + c];
    const float w0 = INF(12)[c], a0 = INF(14)[c], kkc = INF(17)[c], kac = INF(18)[c], rkc = INF(19)[c];
    for (int tile = C.vcu; tile < MT / 32; tile += C.G) {
        const int m0 = tile * 32;
        __syncthreads();
        {
            const int tok = C.tid >> 4, cg = C.tid & 15, m = m0 + tok, col0 = 1536 + cg * 16;
            const float* prow = PRW + (size_t)m * SC + col0; const float* pprev = prow - SC; bool zero = false;
            if (m < MP) { zero = (m & (TP - 1)) == 0; } else { const int ms = m - MP; if ((ms & 3) == 0) pprev = sst + (size_t)(ms >> 2) * SC + col0; }
#pragma unroll
            for (int i = 0; i < 4; ++i) {
                const f32x4 p = *(const f32x4*)(prow + 4 * i); f32x4 q = (f32x4){0.f, 0.f, 0.f, 0.f}; if (!zero) q = *(const f32x4*)(pprev + 4 * i);
                const f32x4 mu = *(const f32x4*)(smu + col0 + 4 * i); f32x4 s = p + (q - p) * mu;
                if (cg < 4) { for (int e = 0; e < 4; ++e) { const float ex = __expf(2.f * s[e]); s[e] = 1.f - 2.f / (ex + 1.f); } }
                else if (cg >= 8) { for (int e = 0; e < 4; ++e) s[e] = sigmoidf_(s[e]); }
                *(LAS f32x4*)(act + tok * 256 + cg * 16 + 4 * i) = s;
            }
        }
        __syncthreads();
        float aw[32], aa[32], ag[32];
#pragma unroll
        for (int t = 0; t < 32; ++t) { aw[t] = 0.f; aa[t] = 0.f; ag[t] = 0.f; }
        for (int k = 0; k < 64; k += 4) {
            const float w_0 = wup[(k + 0) * RW + c], w_1 = wup[(k + 1) * RW + c], w_2 = wup[(k + 2) * RW + c], w_3 = wup[(k + 3) * RW + c];
            const float a_0 = aup[(k + 0) * RW + c], a_1 = aup[(k + 1) * RW + c], a_2 = aup[(k + 2) * RW + c], a_3 = aup[(k + 3) * RW + c];
#pragma unroll
            for (int t = 0; t < 32; ++t) {
                const f32x4 x = *(const LAS f32x4*)(act + t * 256 + k); const f32x4 y = *(const LAS f32x4*)(act + t * 256 + 64 + k);
                aw[t] += x[0] * w_0 + x[1] * w_1 + x[2] * w_2 + x[3] * w_3; aa[t] += y[0] * a_0 + y[1] * a_1 + y[2] * a_2 + y[3] * a_3;
            }
        }
        for (int k = 0; k < 128; k += 4) {
            const float g_0 = gup[(k + 0) * RW + c], g_1 = gup[(k + 1) * RW + c], g_2 = gup[(k + 2) * RW + c], g_3 = gup[(k + 3) * RW + c];
#pragma unroll
            for (int t = 0; t < 32; ++t) { const f32x4 x = *(const LAS f32x4*)(act + t * 256 + 128 + k); ag[t] += x[0] * g_0 + x[1] * g_1 + x[2] * g_2 + x[3] * g_3; }
        }
        float pr_p = 0.f, pk_p = 0.f, pv_p = 0.f;
        if (m0 < MP) { if ((m0 & (TP - 1)) != 0) { const float* pp = PRW + (size_t)(m0 - 1) * SC; pr_p = pp[c]; pk_p = pp[RW + c]; pv_p = pp[2 * RW + c]; } }
#pragma unroll
        for (int t = 0; t < 32; ++t) {
            const int m = m0 + t; const float* pc = PRW + (size_t)m * SC;
            const float pr = pc[c], pk = pc[RW + c], pv = pc[2 * RW + c];
            if (m0 >= MP && (t & 3) == 0) { const float* ss = sst + (size_t)((m - MP) >> 2) * SC; pr_p = ss[c]; pk_p = ss[RW + c]; pv_p = ss[2 * RW + c]; }
            const float r = pr + (pr_p - pr) * mu_r, k = pk + (pk_p - pk) * mu_k, v = pv + (pv_p - pv) * mu_v;
            pr_p = pr; pk_p = pk; pv_p = pv;
            const float u = w0 + aw[t];
            const float wlog = -__logf(1.f + __expf(-u)) - 0.5f;
            const float decay = __expf(-__expf(wlog));
            const float a = sigmoidf_(a0 + aa[t]);
            float kk = k * kkc; const float ss2 = wave_sum(kk * kk); kk *= rsqrtf(fmaxf(ss2, 1e-24f));
            const float kp = k * (1.f + (a - 1.f) * kac);
            const float bb = kk * a, wr = decay * r;
            const float br = wave_sum(bb * r), kr = wave_sum(kp * r), rkr = wave_sum(r * kp * rkc);
            float* rec = SCAN + ((size_t)m * 8 + h) * SREC;
            rec[j] = decay; rec[64 + j] = kk; rec[128 + j] = bb; rec[192 + j] = kp; rec[256 + j] = wr;
            *(f32x4*)(rec + 320 + 4 * j) = (f32x4){v, v * kr, br, 0.f};
            Gb[(size_t)m * RW + c] = ag[t]; BG[(size_t)m * RW + c] = rkr * v * ag[t];
        }
    }
}

__device__ __forceinline__ unsigned long long topk_select(const LAS float* vals, int nvis, int lane) {
    const int nreg = (nvis + 63) >> 6;
    unsigned key[64];
#pragma unroll
    for (int g = 0; g < 8; ++g) {
        if (g * 8 < nreg) {
#pragma unroll
            for (int e = 0; e < 8; ++e) { const int i = g * 8 + e; const int kidx = 64 * i + lane;
                unsigned u = 0u;
                if (kidx < nvis) { const float v = vals[kidx]; u = __builtin_bit_cast(unsigned, v); if ((u << 1) == 0u) u = 0u; u = (u & 0x80000000u) ? ~u : (u | 0x80000000u); }
                key[i] = u; }
        } else {
#pragma unroll
            for (int e = 0; e < 8; ++e) key[g * 8 + e] = 0u;
        }
    }
    unsigned long long myword = 0ull;
    const unsigned long long lt = (lane == 0) ? 0ull : (~0ull >> (64 - lane));
    if (nvis <= 256) {
#pragma unroll
        for (int i = 0; i < 4; ++i) { const unsigned long long m = __ballot(64 * i + lane < nvis); if (lane == i) myword = m; }
        return myword;
    }
    unsigned T = 0u;
    for (int bit = 31; bit >= 0; --bit) {
        const unsigned cand = T | (1u << bit); int cnt = 0;
#pragma unroll
        for (int g = 0; g < 8; ++g) if (g * 8 < nreg) {
#pragma unroll
            for (int e = 0; e < 8; ++e) cnt += __popcll(__ballot(key[g * 8 + e] >= cand));
        }
        if (cnt >= 256) T = cand;
    }
    int cgt = 0;
#pragma unroll
    for (int g = 0; g < 8; ++g) if (g * 8 < nreg) {
#pragma unroll
        for (int e = 0; e < 8; ++e) cgt += __popcll(__ballot(key[g * 8 + e] > T));
    }
    const int need = 256 - cgt; int run = 0;
#pragma unroll
    for (int g = 0; g < 8; ++g) if (g * 8 < nreg) {
#pragma unroll
        for (int e = 0; e < 8; ++e) { const int i = g * 8 + e;
            const bool eq = key[i] == T; const unsigned long long em = __ballot(eq);
            const int before = run + __popcll(em & lt);
            const bool s = (key[i] > T) || (eq && before < need); run += __popcll(em);
            const unsigned long long m = __ballot(s); if (lane == i) myword = m; }
    }
    return myword;
}
__device__ __forceinline__ void p3_topk(const Ctx& C, const void* const* in) {
    const float* QI = (const float*)(C.ws + WS_QI); const float* WI = (const float*)(C.ws + WS_WI);
    unsigned long long* MASK = (unsigned long long*)(C.ws + WS_MASK); int* SEL = (int*)(C.ws + WS_SEL);
    const int lane = C.lane, wave = C.wave, hi = lane >> 5;
    constexpr int NU_P = MP / 8, NU = NU_P + BS;
    gu32* qctr = (gu32*)(C.ws + WS_CTL) + CW_Q;
    volatile LAS unsigned* qslot = (volatile LAS unsigned*)(C.lds + MISC_OFF + 64);
    for (;;) {
        __syncthreads();
        if (C.tid == 0) *qslot = __hip_atomic_fetch_add(qctr, 1u, __ATOMIC_RELAXED, __HIP_MEMORY_SCOPE_AGENT);
        __syncthreads();
        const int qu = (int)*qslot;
        if (qu >= NU) break;
        const int unit = (qu < BS) ? NU_P + qu : qu - BS;
        LAS float* selvals; int selnvis, seltgt;
        if (unit < NU_P) {
            LAS float* idx = (LAS float*)C.lds;
            const int b = unit & 3, t0 = (511 - (unit >> 2)) * 8, nkeys = t0 + 8;
            const int rho = lane & 31, q = rho >> 2, hh = rho & 3;
            const float* qrow = QI + ((size_t)(b * TP + t0 + q)) * 256 + hh * 64 + 8 * hi;
            bf16x8 af[4];
#pragma unroll
            for (int s = 0; s < 4; ++s) af[s] = pack_bf8(*(const f32x4*)(qrow + 16 * s), *(const f32x4*)(qrow + 16 * s + 4));
            f32x4 wiv[4];
#pragma unroll
            for (int g = 0; g < 4; ++g) wiv[g] = *(const f32x4*)(WI + ((size_t)(b * TP + t0 + 2 * g + hi)) * 4) * 0.125f;
            const float* KI = C.out + O_KIP + (size_t)b * TP * 64;
            const int ntile = (nkeys + 31) >> 5;
            for (int rr_ = 0; rr_ < (PROBE_PHASE == 30 ? 2 : 1); ++rr_) {
            f32x4 kn[8];
            if (wave < ntile) { const float* kr_ = KI + (size_t)(wave * 32 + rho) * 64 + 8 * hi;
#pragma unroll
                for (int s = 0; s < 4; ++s) { kn[2 * s] = *(const f32x4*)(kr_ + 16 * s); kn[2 * s + 1] = *(const f32x4*)(kr_ + 16 * s + 4); } }
            for (int tile = wave; tile < ntile; tile += 8) {
                const int key = tile * 32 + rho;
                f32x4 kc[8];
#pragma unroll
                for (int s = 0; s < 8; ++s) kc[s] = kn[s];
                if (tile + 8 < ntile) { const float* kr_ = KI + (size_t)(key + 256) * 64 + 8 * hi;
#pragma unroll
                    for (int s = 0; s < 4; ++s) { kn[2 * s] = *(const f32x4*)(kr_ + 16 * s); kn[2 * s + 1] = *(const f32x4*)(kr_ + 16 * s + 4); } }
                f32x16 acc;
#pragma unroll
                for (int r = 0; r < 16; ++r) acc[r] = 0.f;
#pragma unroll
                for (int s = 0; s < 4; ++s) { const bf16x8 bf = pack_bf8(kc[2 * s], kc[2 * s + 1]);
                    acc = __builtin_amdgcn_mfma_f32_32x32x16_bf16(af[s], bf, acc, 0, 0, 0); }
#pragma unroll
                for (int g = 0; g < 4; ++g) {
                    float v = 0.f;
#pragma unroll
                    for (int e = 0; e < 4; ++e) v += wiv[g][e] * fmaxf(acc[4 * g + e], 0.f);
                    idx[(2 * g + hi) * 4096 + key] = v;
                }
            }
            }
            __syncthreads();
            selvals = idx + wave * 4096; selnvis = t0 + wave + 1; seltgt = b * TP + t0 + wave;
        } else {
            const int b = unit - NU_P;
            LAS float* qis = (LAS float*)C.lds;
            LAS float* wis = qis + 1024;
            LAS float* idx = qis + 1280;
            if (C.tid < 256) { const int row = C.tid >> 4, c4 = (C.tid & 15) * 4;
                *(LAS f32x4*)(qis + row * 64 + c4) = *(const f32x4*)(QI + ((size_t)(MP + b * 4 + (row >> 2))) * 256 + (row & 3) * 64 + c4); }
            if (C.tid < 16) wis[C.tid] = WI[((size_t)(MP + b * 4 + (C.tid >> 2))) * 4 + (C.tid & 3)] * 0.125f;
            __syncthreads();
            const int* pt = (const int*)in[5] + b * NPAGES;
            for (int s = C.tid; s < LS; s += NTHR) {
                const float* krow = (s < PAST) ? INF(4) + ((size_t)pt[s >> 7] * 128 + (s & 127)) * 64 : C.out + O_KIS + (size_t)(b * 4 + (s - PAST)) * 64;
                f32x4 kx[16];
#pragma unroll
                for (int i = 0; i < 16; ++i) kx[i] = *(const f32x4*)(krow + 4 * i);
#pragma unroll
                for (int t = 0; t < 4; ++t) {
                    float v = 0.f;
#pragma unroll
                    for (int hh = 0; hh < 4; ++hh) {
                        float d0 = 0.f, d1 = 0.f;
#pragma unroll
                        for (int i = 0; i < 16; i += 2) { const f32x4 qa = *(const LAS f32x4*)(qis + (t * 4 + hh) * 64 + 4 * i), qb = *(const LAS f32x4*)(qis + (t * 4 + hh) * 64 + 4 * i + 4);
                            d0 += kx[i][0] * qa[0] + kx[i][1] * qa[1] + kx[i][2] * qa[2] + kx[i][3] * qa[3];
                            d1 += kx[i + 1][0] * qb[0] + kx[i + 1][1] * qb[1] + kx[i + 1][2] * qb[2] + kx[i + 1][3] * qb[3]; }
                        v += wis[t * 4 + hh] * fmaxf(d0 + d1, 0.f);
                    }
                    idx[t * 2112 + s] = v;
                }
            }
            __syncthreads();
            selvals = idx + (wave & 3) * 2112; selnvis = PAST + (wave & 3) + 1; seltgt = (wave < 4) ? b * 4 + wave : -1;
        }
        if (seltgt >= 0) {
            unsigned long long w = topk_select(selvals, selnvis, lane);
            if (PROBE_PHASE == 31) { asm volatile("" ::: "memory"); w = topk_select(selvals, selnvis, lane); }
            if (unit < NU_P) MASK[(size_t)seltgt * 64 + lane] = w;
            else {
                int cnt = __popcll(w), pre = cnt;
#pragma unroll
                for (int o = 1; o < 64; o <<= 1) { const int x = __shfl_up(pre, o); if (lane >= o) pre += x; }
                int pos = pre - cnt; int* sel = SEL + (size_t)seltgt * 256;
                while (w) { const int bit = __builtin_ctzll(w); if (pos < 256) sel[pos] = 64 * lane + bit; ++pos; w &= w - 1; }
            }
        }
    }
}

struct ScanVec { f32x4 w, kk, b, k, wr, tri; };
__device__ __forceinline__ f32x2 fma2(f32x2 a, f32x2 b, f32x2 c) { return __builtin_elementwise_fma(a, b, c); }
__device__ __forceinline__ float scan_step(f32x2& S01, f32x2& S23, const ScanVec& x) {
    f32x2 q1 = S01 * (f32x2){x.kk[0], x.kk[1]}; q1 = fma2(S23, (f32x2){x.kk[2], x.kk[3]}, q1);
    f32x2 q2 = S01 * (f32x2){x.wr[0], x.wr[1]}; q2 = fma2(S23, (f32x2){x.wr[2], x.wr[3]}, q2);
    float p1 = q1[0] + q1[1], p2 = q2[0] + q2[1];
    const f32x2 vv = (f32x2){x.tri[0], x.tri[0]};
    f32x2 t01 = vv * (f32x2){x.k[0], x.k[1]}; t01 = fma2(S01, (f32x2){x.w[0], x.w[1]}, t01);
    f32x2 t23 = vv * (f32x2){x.k[2], x.k[3]}; t23 = fma2(S23, (f32x2){x.w[2], x.w[3]}, t23);
    p1 = sum16(p1); p2 = sum16(p2);
    const f32x2 nsa = (f32x2){-p1, -p1};
    S01 = fma2(nsa, (f32x2){x.b[0], x.b[1]}, t01); S23 = fma2(nsa, (f32x2){x.b[2], x.b[3]}, t23);
    return p2 - p1 * x.tri[2] + x.tri[1];
}
__device__ __forceinline__ void p4_scan(const Ctx& C, const void* const* in) {
    const float* SCAN = (const float*)(C.ws + WS_SCAN); float* YST = (float*)(C.ws + WS_YS); float* YSS = YST + (size_t)MP * RW;
    const int lane = C.lane, wave = C.wave, rg = lane >> 4, jl = lane & 15;
    {
        const float* st = INF(6);
        for (int u = C.vcu * NWAVES + wave; u < BS * 8 * 16; u += C.G * NWAVES) {
            const int bh = u >> 4, b = bh >> 3, h = bh & 7, i = (u & 15) * 4 + rg;
            const f32x4 s4 = *(const f32x4*)(st + ((size_t)bh * 64 + i) * 64 + 4 * jl);
            f32x2 S01 = (f32x2){s4[0], s4[1]}, S23 = (f32x2){s4[2], s4[3]};
#pragma unroll
            for (int t = 0; t < 4; ++t) {
                const int m = MP + b * 4 + t; const float* rec = SCAN + ((size_t)m * 8 + h) * SREC;
                ScanVec x; x.w = *(const f32x4*)(rec + 4 * jl); x.kk = *(const f32x4*)(rec + 64 + 4 * jl); x.b = *(const f32x4*)(rec + 128 + 4 * jl);
                x.k = *(const f32x4*)(rec + 192 + 4 * jl); x.wr = *(const f32x4*)(rec + 256 + 4 * jl); x.tri = *(const f32x4*)(rec + 320 + 4 * i);
                const float y = scan_step(S01, S23, x);
                if (jl == 0) YSS[(size_t)(b * 4 + t) * RW + h * 64 + i] = y;
            }
            *(f32x4*)(C.out + O_WKVS + ((size_t)bh * 64 + i) * 64 + 4 * jl) = (f32x4){S01[0], S01[1], S23[0], S23[1]};
        }
    }
    __syncthreads();
    constexpr int CH = 16, CHB = CH * SREC * 4;
    for (int unit = C.vcu; unit < 128; unit += C.G) {
        const int bh = unit >> 2, b = bh >> 3, h = bh & 7, i = (unit & 3) * 16 + (wave & 3) * 4 + rg;
        const float* base = SCAN + ((size_t)(b * TP) * 8 + h) * SREC;
        const int ltid = C.tid - 256;
        const unsigned lv = (unsigned)jl * 16u, lt = 1280u + (unsigned)i * 16u;
#define SC_BAR() do { asm volatile("" ::: "memory"); __builtin_amdgcn_s_barrier(); asm volatile("" ::: "memory"); } while (0)
        if (wave >= 4) {
            unsigned goff[9];
#pragma unroll
            for (int k_ = 0; k_ < 9; ++k_) { const unsigned q_ = (unsigned)ltid + 256u * k_; const unsigned s_ = q_ / 144u, off_ = q_ - s_ * 144u; goff[k_] = s_ * (8u * SREC * 4u) + off_ * 16u; }
            f32x4 sA[9], sB[9], sC[9];
#define SC_GLOAD(ST, c_) do { const char* cbase_ = (const char*)(base + (size_t)(c_) * CH * 8 * SREC); _Pragma("unroll") for (int k_ = 0; k_ < 9; ++k_) ST[k_] = *(const f32x4*)(cbase_ + goff[k_]); } while (0)
#define SC_LSTORE(ST, boff_) do { _Pragma("unroll") for (int k_ = 0; k_ < 9; ++k_) *(LAS f32x4*)(C.lds + (boff_) + (ltid + 256 * k_) * 16) = ST[k_]; } while (0)
            SC_GLOAD(sA, 0); SC_GLOAD(sB, 1); SC_LSTORE(sA, 0); SC_LSTORE(sB, CHB);
            SC_GLOAD(sA, 2); SC_GLOAD(sB, 3); SC_GLOAD(sC, 4);
            asm volatile("s_waitcnt lgkmcnt(0)" ::: "memory"); SC_BAR();
            int b2 = 2 * CHB;
#define SC_LSUB(ST, c_) do { if ((c_) < TP / CH) { if ((c_) + 2 < TP / CH) SC_LSTORE(ST, b2); if ((c_) + 5 < TP / CH) SC_GLOAD(ST, (c_) + 5); \
                b2 = (b2 == 2 * CHB) ? 0 : b2 + CHB; asm volatile("s_waitcnt lgkmcnt(0)" ::: "memory"); SC_BAR(); } } while (0)
            for (int ch = 0; ch < TP / CH; ch += 3) { SC_LSUB(sA, ch); SC_LSUB(sB, ch + 1); SC_LSUB(sC, ch + 2); }
#undef SC_LSUB
#undef SC_GLOAD
#undef SC_LSTORE
        } else {
            SC_BAR();
            f32x2 S01 = (f32x2){0.f, 0.f}, S23 = (f32x2){0.f, 0.f};
            float* yrow = YST + ((size_t)bh * 64 + i) * TP + jl;
#define SC_LD(X, bufb, s_) do { const LAS unsigned char* r_ = C.lds + (bufb) + (s_) * (SREC * 4); \
            X.w = *(const LAS f32x4*)(r_ + lv); X.kk = *(const LAS f32x4*)(r_ + 256 + lv); X.b = *(const LAS f32x4*)(r_ + 512 + lv); \
            X.k = *(const LAS f32x4*)(r_ + 768 + lv); X.wr = *(const LAS f32x4*)(r_ + 1024 + lv); X.tri = *(const LAS f32x4*)(r_ + lt); } while (0)
            ScanVec xa, xb;
            SC_LD(xa, 0, 0);
            int cb = 0, nb = CHB;
            for (int ch = 0; ch < TP / CH; ++ch) {
                float ykeep = 0.f;
#define SC_STEP(XC, XN, s_) do { if ((s_) + 1 < CH) SC_LD(XN, cb, (s_) + 1); else if (ch + 1 < TP / CH) SC_LD(XN, nb, 0); \
                    __builtin_amdgcn_sched_barrier(0); \
                    { const float y_ = scan_step(S01, S23, XC); ykeep = (jl == (s_)) ? y_ : ykeep; asm volatile("" :: "v"(XC.tri[3])); } \
                    __builtin_amdgcn_sched_barrier(0); } while (0)
                SC_STEP(xa, xb, 0); SC_STEP(xb, xa, 1); SC_STEP(xa, xb, 2); SC_STEP(xb, xa, 3);
                SC_STEP(xa, xb, 4); SC_STEP(xb, xa, 5); SC_STEP(xa, xb, 6); SC_STEP(xb, xa, 7);
                SC_STEP(xa, xb, 8); SC_STEP(xb, xa, 9); SC_STEP(xa, xb, 10); SC_STEP(xb, xa, 11);
                SC_STEP(xa, xb, 12); SC_STEP(xb, xa, 13); SC_STEP(xa, xb, 14); SC_STEP(xb, xa, 15);
                yrow[ch * CH] = ykeep;
                cb = nb; nb = (nb == 2 * CHB) ? 0 : nb + CHB;
                SC_BAR();
            }
#undef SC_STEP
#undef SC_LD
            *(f32x4*)(C.out + O_WKVP + ((size_t)bh * 64 + i) * 64 + 4 * jl) = (f32x4){S01[0], S01[1], S23[0], S23[1]};
        }
#undef SC_BAR
        __syncthreads();
    }
}
__device__ __forceinline__ float wave_sum_fast(float x) { x = sum16(x); x += __shfl_xor(x, 16); x += __shfl_xor(x, 32); return x; }
__device__ __forceinline__ void p5_post(const Ctx& C, const void* const* in) {
    const float* YST = (const float*)(C.ws + WS_YS); const float* YSS = YST + (size_t)MP * RW;
    const float* Gb = (const float*)(C.ws + WS_G); const float* BG = (const float*)(C.ws + WS_BG); bf16* MIX = (bf16*)(C.ws + WS_MIX);
    const int c = C.tid, h = C.wave, j = C.lane;
    const float gg = INF(20)[c], gb = INF(21)[c];
    for (int u = C.vcu; u < MT / 16; u += C.G) {
        const int m0 = u * 16;
        float yv[16];
        if (m0 < MP) { const int b = m0 >> 12, t0 = m0 & (TP - 1); const float* yp = YST + ((size_t)(b * 8 + h) * 64 + j) * TP + t0;
#pragma unroll
            for (int q = 0; q < 4; ++q) { const f32x4 v = *(const f32x4*)(yp + 4 * q); yv[4 * q] = v[0]; yv[4 * q + 1] = v[1]; yv[4 * q + 2] = v[2]; yv[4 * q + 3] = v[3]; }
        } else {
#pragma unroll
            for (int t = 0; t < 16; ++t) yv[t] = YSS[(size_t)(m0 - MP + t) * RW + c];
        }
#pragma unroll
        for (int t = 0; t < 16; ++t) {
            const int m = m0 + t; const float y = yv[t];
            const float mu = wave_sum_fast(y) * (1.f / 64.f); const float d = y - mu; const float var = wave_sum_fast(d * d) * (1.f / 64.f);
            const float yn = d * rsqrtf(var + GN_EPS) * gg + gb;
            const float o = yn * Gb[(size_t)m * RW + c] + BG[(size_t)m * RW + c];
            MIX[(size_t)m * DM + c] = (bf16)f2bf(o);
        }
    }
}
__device__ __forceinline__ int t5_bucket(int d) {
    if (d < 16) return d;
    int b = 16;
    b += (d >= 19); b += (d >= 21); b += (d >= 24); b += (d >= 27); b += (d >= 31); b += (d >= 35); b += (d >= 40); b += (d >= 46);
    b += (d >= 52); b += (d >= 59); b += (d >= 67); b += (d >= 77); b += (d >= 87); b += (d >= 99); b += (d >= 113);
    return b;
}
constexpr int KROW = 72, VROW = 68;
constexpr int ATT_KB = 64 * KROW * 2, ATT_VB = 64 * VROW * 2;
__device__ __forceinline__ void attn_prompt_unit(const Ctx& C, int b, int h, int qb, const LAS float* btab) {
    const bf16* QB = (const bf16*)(C.ws + WS_QB); const bf16* KB = (const bf16*)(C.ws + WS_KB); const bf16* VB = (const bf16*)(C.ws + WS_VB);
    const unsigned long long* MASK = (const unsigned long long*)(C.ws + WS_MASK); bf16* MIX = (bf16*)(C.ws + WS_MIX);
    LAS unsigned char* kbuf = C.lds; LAS unsigned char* vbuf = C.lds + 2 * ATT_KB;
    const int lane = C.lane, wave = C.wave, r32 = lane & 31, hi = lane >> 5;
    const int q0 = qb * 256, qw0 = q0 + wave * 32, q = qw0 + r32;
    const size_t rowb = (size_t)b * TP;
    const int NT = (q0 + 256) / 64;
    bf16x8 qf[4];
#pragma unroll
    for (int s = 0; s < 4; ++s) qf[s] = *(const bf16x8*)(QB + (rowb + q) * RW + h * 64 + 16 * s + 8 * hi);
    const unsigned long long* mrow = MASK + (rowb + q) * 64;
    const int srow = C.tid >> 3, sch = C.tid & 7;
    const bf16* kg = KB + (rowb + srow) * RW + h * 64 + sch * 8; const bf16* vg = VB + (rowb + srow) * RW + h * 64 + sch * 8;
    v4u kst, vst;
#define ATT_GLOAD(t) do { kst = *(const v4u*)(kg + (size_t)(t) * 64 * RW); vst = *(const v4u*)(vg + (size_t)(t) * 64 * RW); } while (0)
#define ATT_LSTORE(bi) do { *(LAS v4u*)(kbuf + (bi) * ATT_KB + srow * (KROW * 2) + sch * 16) = kst; \
        LAS unsigned short* vt_ = (LAS unsigned short*)(vbuf + (bi) * ATT_VB) + (sch * 8) * VROW + srow; \
        vt_[0 * VROW] = (unsigned short)(vst.x & 0xffffu); vt_[1 * VROW] = (unsigned short)(vst.x >> 16); vt_[2 * VROW] = (unsigned short)(vst.y & 0xffffu); vt_[3 * VROW] = (unsigned short)(vst.y >> 16); \
        vt_[4 * VROW] = (unsigned short)(vst.z & 0xffffu); vt_[5 * VROW] = (unsigned short)(vst.z >> 16); vt_[6 * VROW] = (unsigned short)(vst.w & 0xffffu); vt_[7 * VROW] = (unsigned short)(vst.w >> 16); } while (0)
    __syncthreads();
    ATT_GLOAD(0); ATT_LSTORE(0);
    __syncthreads();
    f32x16 o0, o1;
#pragma unroll
    for (int r = 0; r < 16; ++r) { o0[r] = 0.f; o1[r] = 0.f; }
    float mrun = -1e30f, lrun = 0.f;
    unsigned long long mw = mrow[0];
    for (int t = 0; t < NT; ++t) {
        const int bi = t & 1;
        if (t + 1 < NT) ATT_GLOAD(t + 1);
        const unsigned long long mcur = mw; if (t + 1 < NT) mw = mrow[t + 1];
        const int kv0 = t * 64;
        if (kv0 <= qw0 + 31) {
            f32x16 p0, p1;
#pragma unroll
            for (int r = 0; r < 16; ++r) { p0[r] = 0.f; p1[r] = 0.f; }
            const LAS unsigned char* kb0 = kbuf + bi * ATT_KB + r32 * (KROW * 2) + hi * 16;
#pragma unroll
            for (int s = 0; s < 4; ++s) {
                const bf16x8 ka = *(const LAS bf16x8*)(kb0 + s * 32), kb2 = *(const LAS bf16x8*)(kb0 + 32 * (KROW * 2) + s * 32);
                p0 = __builtin_amdgcn_mfma_f32_32x32x16_bf16(ka, qf[s], p0, 0, 0, 0);
                p1 = __builtin_amdgcn_mfma_f32_32x32x16_bf16(kb2, qf[s], p1, 0, 0, 0);
            }
            if (kv0 + 63 + 113 > qw0) {
#pragma unroll
                for (int r = 0; r < 16; ++r) { const int kv = kv0 + (r & 3) + 8 * (r >> 2) + 4 * hi;
                    int d0 = q - kv; d0 = d0 < 0 ? 0 : (d0 > 127 ? 127 : d0); int d1 = q - kv - 32; d1 = d1 < 0 ? 0 : (d1 > 127 ? 127 : d1);
                    p0[r] += btab[h * 128 + d0]; p1[r] += btab[h * 128 + d1]; }
            }
            float mx = p0[0];
#pragma unroll
            for (int r = 1; r < 16; ++r) mx = fmaxf(mx, p0[r]);
#pragma unroll
            for (int r = 0; r < 16; ++r) mx = fmaxf(mx, p1[r]);
            mx = fmaxf(mx, __shfl_xor(mx, 32));
            const float mnew = fmaxf(mrun, mx);
            const float alpha = __builtin_amdgcn_exp2f(mrun - mnew);
            mrun = mnew;
            const unsigned wlo = (unsigned)mcur >> (4 * hi), whi = (unsigned)(mcur >> 32) >> (4 * hi);
            float ls = 0.f;
#pragma unroll
            for (int r = 0; r < 16; ++r) { const int pos = (r & 3) + 8 * (r >> 2);
                const int m0 = __builtin_amdgcn_sbfe(wlo, pos, 1), m1 = __builtin_amdgcn_sbfe(whi, pos, 1);
                const float e0 = __builtin_amdgcn_exp2f(p0[r] - mnew), e1 = __builtin_amdgcn_exp2f(p1[r] - mnew);
                p0[r] = __builtin_bit_cast(float, __builtin_bit_cast(int, e0) & m0); p1[r] = __builtin_bit_cast(float, __builtin_bit_cast(int, e1) & m1);
                ls += p0[r] + p1[r]; }
            lrun = lrun * alpha + ls;
            if (__any(alpha != 1.f)) {
#pragma unroll
                for (int r = 0; r < 16; ++r) { o0[r] *= alpha; o1[r] *= alpha; }
            }
            const LAS unsigned char* vb0 = vbuf + bi * ATT_VB + r32 * (VROW * 2) + hi * 8;
#pragma unroll
            for (int jj = 0; jj < 4; ++jj) {
                f32x4 pa, pb;
                if (jj == 0) { pa = (f32x4){p0[0], p0[1], p0[2], p0[3]}; pb = (f32x4){p0[4], p0[5], p0[6], p0[7]}; }
                else if (jj == 1) { pa = (f32x4){p0[8], p0[9], p0[10], p0[11]}; pb = (f32x4){p0[12], p0[13], p0[14], p0[15]}; }
                else if (jj == 2) { pa = (f32x4){p1[0], p1[1], p1[2], p1[3]}; pb = (f32x4){p1[4], p1[5], p1[6], p1[7]}; }
                else { pa = (f32x4){p1[8], p1[9], p1[10], p1[11]}; pb = (f32x4){p1[12], p1[13], p1[14], p1[15]}; }
                const bf16x8 pf = pack_bf8(pa, pb);
                typedef unsigned u32x2 __attribute__((ext_vector_type(2)));
                const u32x2 a0 = *(const LAS u32x2*)(vb0 + jj * 32), a1 = *(const LAS u32x2*)(vb0 + jj * 32 + 16);
                const u32x2 c0 = *(const LAS u32x2*)(vb0 + 32 * (VROW * 2) + jj * 32), c1 = *(const LAS u32x2*)(vb0 + 32 * (VROW * 2) + jj * 32 + 16);
                const bf16x8 va = __builtin_bit_cast(bf16x8, (v4u){a0.x, a0.y, a1.x, a1.y}), vc = __builtin_bit_cast(bf16x8, (v4u){c0.x, c0.y, c1.x, c1.y});
                o0 = __builtin_amdgcn_mfma_f32_32x32x16_bf16(va, pf, o0, 0, 0, 0);
                o1 = __builtin_amdgcn_mfma_f32_32x32x16_bf16(vc, pf, o1, 0, 0, 0);
            }
        }
        if (t + 1 < NT) ATT_LSTORE(bi ^ 1);
        __syncthreads();
    }
#undef ATT_GLOAD
#undef ATT_LSTORE
    const float ltot = lrun + __shfl_xor(lrun, 32);
    const float inv = 1.f / ltot;
    bf16* orow = MIX + (rowb + q) * DM + RW + h * 64;
#pragma unroll
    for (int g = 0; g < 4; ++g) {
        const int d = 8 * g + 4 * hi;
        typedef unsigned u32x2 __attribute__((ext_vector_type(2)));
        u32x2 w0, w1;
        w0.x = pk2(o0[4 * g] * inv, o0[4 * g + 1] * inv); w0.y = pk2(o0[4 * g + 2] * inv, o0[4 * g + 3] * inv);
        w1.x = pk2(o1[4 * g] * inv, o1[4 * g + 1] * inv); w1.y = pk2(o1[4 * g + 2] * inv, o1[4 * g + 3] * inv);
        *(u32x2*)(orow + d) = w0; *(u32x2*)(orow + 32 + d) = w1;
    }
}
__device__ __forceinline__ void attn_sample_pair(const Ctx& C, const void* const* in, int pair, const LAS float* btab, LAS float* comb) {
    const bf16* QB = (const bf16*)(C.ws + WS_QB); const int* SEL = (const int*)(C.ws + WS_SEL); bf16* MIX = (bf16*)(C.ws + WS_MIX);
    const int lane = C.lane, hh = lane >> 3, ch = lane & 7, wq = C.wave >> 2, part = C.wave & 3;
    const int qi_ = pair * 2 + wq, b = qi_ >> 2, t = qi_ & 3, m = MP + qi_, qpos = PAST + t;
    float qv[8];
    { const v4u qq = *(const v4u*)(QB + (size_t)m * RW + hh * 64 + ch * 8);
      qv[0] = bf2f(qq.x & 0xffffu); qv[1] = bf2f(qq.x >> 16); qv[2] = bf2f(qq.y & 0xffffu); qv[3] = bf2f(qq.y >> 16);
      qv[4] = bf2f(qq.z & 0xffffu); qv[5] = bf2f(qq.z >> 16); qv[6] = bf2f(qq.w & 0xffffu); qv[7] = bf2f(qq.w >> 16); }
    const int* pt = (const int*)in[5] + b * NPAGES;
    const int* sel = SEL + (size_t)qi_ * 256 + part * 64;
    const float* ck = INF(2); const float* cv = INF(3);
    float acc[8] = {0.f, 0.f, 0.f, 0.f, 0.f, 0.f, 0.f, 0.f}; float mrun = -1e30f, lrun = 0.f;
    for (int j0 = 0; j0 < 64; j0 += 8) {
        f32x4 k0[8], k1[8], v0[8], v1[8]; float bias[8];
#pragma unroll
        for (int u = 0; u < 8; ++u) {
            const int s = sel[j0 + u];
            const float *kr, *vr;
            if (s < PAST) { const size_t row = (size_t)pt[s >> 7] * 128 + (s & 127); kr = ck + row * RW; vr = cv + row * RW; }
            else { const size_t row = (size_t)(b * 4 + (s - PAST)); kr = C.out + O_KS + row * RW; vr = C.out + O_VS + row * RW; }
            kr += hh * 64 + ch * 8; vr += hh * 64 + ch * 8;
            k0[u] = *(const f32x4*)kr; k1[u] = *(const f32x4*)(kr + 4); v0[u] = *(const f32x4*)vr; v1[u] = *(const f32x4*)(vr + 4);
            int d = qpos - s; d = d < 0 ? 0 : (d > 127 ? 127 : d); bias[u] = btab[1024 + hh * 128 + d];
        }
#pragma unroll
        for (int u = 0; u < 8; ++u) {
            float p = qv[0] * k0[u][0] + qv[1] * k0[u][1] + qv[2] * k0[u][2] + qv[3] * k0[u][3] + qv[4] * k1[u][0] + qv[5] * k1[u][1] + qv[6] * k1[u][2] + qv[7] * k1[u][3];
            p = sum8(p) + bias[u];
            const float mnew = fmaxf(mrun, p); const float alpha = __builtin_amdgcn_exp2f(mrun - mnew), e = __builtin_amdgcn_exp2f(p - mnew);
            mrun = mnew; lrun = lrun * alpha + e;
            acc[0] = acc[0] * alpha + e * v0[u][0]; acc[1] = acc[1] * alpha + e * v0[u][1]; acc[2] = acc[2] * alpha + e * v0[u][2]; acc[3] = acc[3] * alpha + e * v0[u][3];
            acc[4] = acc[4] * alpha + e * v1[u][0]; acc[5] = acc[5] * alpha + e * v1[u][1]; acc[6] = acc[6] * alpha + e * v1[u][2]; acc[7] = acc[7] * alpha + e * v1[u][3];
        }
    }
    LAS float* cw = comb + ((wq * 4 + part) * 64 + lane) * 12;
    *(LAS f32x4*)cw = (f32x4){acc[0], acc[1], acc[2], acc[3]}; *(LAS f32x4*)(cw + 4) = (f32x4){acc[4], acc[5], acc[6], acc[7]}; *(LAS f32x2*)(cw + 8) = (f32x2){mrun, lrun};
    __syncthreads();
    if (part == 0) {
        float M = mrun;
#pragma unroll
        for (int p = 1; p < 4; ++p) M = fmaxf(M, comb[((wq * 4 + p) * 64 + lane) * 12 + 8]);
        float f = __builtin_amdgcn_exp2f(mrun - M), L = lrun * f;
#pragma unroll
        for (int e = 0; e < 8; ++e) acc[e] *= f;
#pragma unroll
        for (int p = 1; p < 4; ++p) { const LAS float* cp = comb + ((wq * 4 + p) * 64 + lane) * 12; const f32x4 a0 = *(const LAS f32x4*)cp, a1 = *(const LAS f32x4*)(cp + 4); const f32x2 ml = *(const LAS f32x2*)(cp + 8);
            const float fp = __builtin_amdgcn_exp2f(ml[0] - M); L += ml[1] * fp;
            acc[0] += a0[0] * fp; acc[1] += a0[1] * fp; acc[2] += a0[2] * fp; acc[3] += a0[3] * fp; acc[4] += a1[0] * fp; acc[5] += a1[1] * fp; acc[6] += a1[2] * fp; acc[7] += a1[3] * fp; }
        const float inv = 1.f / L;
        v4u w; w.x = pk2(acc[0] * inv, acc[1] * inv); w.y = pk2(acc[2] * inv, acc[3] * inv); w.z = pk2(acc[4] * inv, acc[5] * inv); w.w = pk2(acc[6] * inv, acc[7] * inv);
        *(v4u*)(MIX + (size_t)m * DM + RW + hh * 64 + ch * 8) = w;
    }
    __syncthreads();
}
__device__ __forceinline__ void p5_attn(const Ctx& C, const void* const* in, int rep_s, int rep_p) {
    LAS float* btab = (LAS float*)(C.lds + 2 * ATT_KB + 2 * ATT_VB);
    const float* rb = INF(9);
    for (int i = C.tid; i < 1024; i += NTHR) { const int hh = i >> 7, d = i & 127; const float bv = rb[t5_bucket(d) * 8 + hh];
        btab[i] = (bv - rb[31 * 8 + hh]) * LOG2E; btab[1024 + i] = bv * LOG2E; }
    __syncthreads();
    for (int rr = 0; rr < rep_s; ++rr) for (int pr = C.vcu; pr < MS / 2; pr += C.G) attn_sample_pair(C, in, pr, btab, btab + 2048);
    for (int rr = 0; rr < rep_p; ++rr) for (int u = C.vcu; u < 512; u += C.G) {
        const int bh = (u & 255) >> 3, s = u & 7, qb = (u < 256) ? s : 15 - s;
        attn_prompt_unit(C, bh >> 3, bh & 7, qb, btab);
    }
}

__device__ __forceinline__ void ln_rows(const Ctx& C, const float* Z, const float* g, const float* bt, float* outP, float* outS, bf16* ob) {
    const int gw = C.vcu * NWAVES + C.wave, NGW = C.G * NWAVES;
    f32x4 gv[4], bv[4];
#pragma unroll
    for (int j = 0; j < 4; ++j) { gv[j] = *((const f32x4*)g + C.lane + 64 * j); bv[j] = *((const f32x4*)bt + C.lane + 64 * j); }
    for (int m = gw; m < MT; m += NGW) {
        const f32x4* zr = (const f32x4*)(Z + (size_t)m * DM) + C.lane;
        f32x4 v[4]; float s = 0.f;
#pragma unroll
        for (int j = 0; j < 4; ++j) { v[j] = zr[64 * j]; s += (v[j].x + v[j].y) + (v[j].z + v[j].w); }
        const float mean = wave_sum(s) * (1.f / DM); float s2 = 0.f;
#pragma unroll
        for (int j = 0; j < 4; ++j) { v[j] = v[j] - mean; s2 += (v[j].x * v[j].x + v[j].y * v[j].y) + (v[j].z * v[j].z + v[j].w * v[j].w); }
        const float rstd = rsqrtf(wave_sum(s2) * (1.f / DM) + LN_EPS);
        float* orow = (m < MP) ? outP + (size_t)m * DM : outS + (size_t)(m - MP) * DM;
#pragma unroll
        for (int j = 0; j < 4; ++j) { const f32x4 o = v[j] * rstd * gv[j] + bv[j]; *((f32x4*)orow + C.lane + 64 * j) = o;
            if (ob) *((unsigned long long*)(ob + (size_t)m * DM) + C.lane + 64 * j) = (unsigned long long)pk2(o.x, o.y) | ((unsigned long long)pk2(o.z, o.w) << 32); }
    }
}

__device__ __forceinline__ void p9_conv(const Ctx& C, const void* const* in) {
    const bf16* UC = (const bf16*)(C.ws + WS_UC); const bf16* UL = (const bf16*)(C.ws + WS_UL); bf16* H = (bf16*)(C.ws + WS_H);
    const float* cw = INF(26); const float* cb = INF(27); const float* cst = INF(8);
    constexpr int CPR = FF / 8;
    const long total = (long)MT * CPR;
    for (long it = (long)C.vcu * NTHR + C.tid; it < total; it += (long)C.G * NTHR) {
        const int m = (int)(it / CPR), c = (int)(it - (long)m * CPR) * 8;
        int t; const float* prev = nullptr;
        if (m < MP) t = m & (TP - 1); else { const int ms = m - MP; t = ms & 3; prev = cst + (size_t)(ms >> 2) * 2 * FF; }
        float u0[8], u1[8], u2[8], ul[8];
        { const v4u a = *(const v4u*)(UC + (size_t)m * FF + c); const v4u l = *(const v4u*)(UL + (size_t)m * FF + c);
          u2[0] = bf2f(a.x & 0xffffu); u2[1] = bf2f(a.x >> 16); u2[2] = bf2f(a.y & 0xffffu); u2[3] = bf2f(a.y >> 16); u2[4] = bf2f(a.z & 0xffffu); u2[5] = bf2f(a.z >> 16); u2[6] = bf2f(a.w & 0xffffu); u2[7] = bf2f(a.w >> 16);
          ul[0] = bf2f(l.x & 0xffffu); ul[1] = bf2f(l.x >> 16); ul[2] = bf2f(l.y & 0xffffu); ul[3] = bf2f(l.y >> 16); ul[4] = bf2f(l.z & 0xffffu); ul[5] = bf2f(l.z >> 16); ul[6] = bf2f(l.w & 0xffffu); ul[7] = bf2f(l.w >> 16); }
        if (t >= 1) { const v4u a = *(const v4u*)(UC + (size_t)(m - 1) * FF + c);
          u1[0] = bf2f(a.x & 0xffffu); u1[1] = bf2f(a.x >> 16); u1[2] = bf2f(a.y & 0xffffu); u1[3] = bf2f(a.y >> 16); u1[4] = bf2f(a.z & 0xffffu); u1[5] = bf2f(a.z >> 16); u1[6] = bf2f(a.w & 0xffffu); u1[7] = bf2f(a.w >> 16); }
        else { for (int e = 0; e < 8; ++e) u1[e] = prev ? prev[FF + c + e] : 0.f; }
        if (t >= 2) { const v4u a = *(const v4u*)(UC + (size_t)(m - 2) * FF + c);
          u0[0] = bf2f(a.x & 0xffffu); u0[1] = bf2f(a.x >> 16); u0[2] = bf2f(a.y & 0xffffu); u0[3] = bf2f(a.y >> 16); u0[4] = bf2f(a.z & 0xffffu); u0[5] = bf2f(a.z >> 16); u0[6] = bf2f(a.w & 0xffffu); u0[7] = bf2f(a.w >> 16); }
        else { for (int e = 0; e < 8; ++e) u0[e] = prev ? prev[t * FF + c + e] : 0.f; }
        float hv[8];
#pragma unroll
        for (int e = 0; e < 8; ++e) { const float cv = u0[e] * cw[c + e] + u1[e] * cw[FF + c + e] + u2[e] * cw[2 * FF + c + e] + cb[c + e];
            hv[e] = cv / (1.f + __expf(-cv)) * ul[e]; }
        v4u w; w.x = pk2(hv[0], hv[1]); w.y = pk2(hv[2], hv[3]); w.z = pk2(hv[4], hv[5]); w.w = pk2(hv[6], hv[7]);
        *(v4u*)(H + (size_t)m * FF + c) = w;
    }
}

#ifndef PROBE_PHASE
#define PROBE_PHASE -1
#endif
struct Args { const void* in[31]; float* out; unsigned char* ws; int ph_lo, ph_hi; };
__global__ void __launch_bounds__(NTHR, 2) fwd_kernel(Args args) {
    extern __shared__ __attribute__((aligned(16))) unsigned char lds_raw[];
    Ctx C;
    C.lds = (LAS unsigned char*)lds_raw; C.tid = threadIdx.x; C.lane = C.tid & 63; C.wave = __builtin_amdgcn_readfirstlane(C.tid >> 6);
    C.G = gridDim.x; { const int bx = blockIdx.x; C.vcu = (C.G % 8 == 0) ? (bx % 8) * (C.G / 8) + bx / 8 : bx; }
    C.out = args.out; C.ws = args.ws;
    const void* const* in = args.in;
    volatile LAS unsigned* MISC = (volatile LAS unsigned*)(C.lds + MISC_OFF);
    for (int u = C.tid; u < (LDS_BYTES - LDSCTL_OFF) / 4; u += NTHR) ((LAS unsigned*)(C.lds + LDSCTL_OFF))[u] = 0u;
    __syncthreads();
    const int lo = args.ph_lo, hi = args.ph_hi;
    const bool multi = (hi - lo) > 1;
    XcdBarrier bar; bar.bar = (unsigned*)(C.ws + WS_CTL) + CW_BAR; bar.x = 0; bar.st = nullptr;
    if (multi) bar = xcd_barrier_post((unsigned*)(C.ws + WS_CTL) + CW_BAR, MISC + 8);
#define IN(k) (lo <= (k) && (k) < hi)
#define SEAM(k) do { if (IN(k) && IN((k) + 1)) xcd_barrier(bar); } while (0)
    bf16* XB = (bf16*)(C.ws + WS_XB); bf16* MIX = (bf16*)(C.ws + WS_MIX); bf16* X1B = (bf16*)(C.ws + WS_X1B); bf16* HB = (bf16*)(C.ws + WS_H);
    float* Z = (float*)(C.ws + WS_Z); float* X1 = (float*)(C.ws + WS_X1);

#define RUN0 do { p0_prologue(C, in); } while (0)
#define RUN1 do { pg8::Gemm g{XB, (const bf16*)(C.ws + WS_WIN), MT, NINP, DM}; pg8::StaticOrder S; S.init(MT, NINP, C.G, (int)blockIdx.x); \
        pg8::EpiIn E{(float*)(C.ws + WS_PRW), (bf16*)(C.ws + WS_QB), (bf16*)(C.ws + WS_KB), (bf16*)(C.ws + WS_VB), (float*)(C.ws + WS_QI), (float*)(C.ws + WS_WI), C.out}; \
        pg8::gemm_phase<pg8::EpiIn, pg8::StaticOrder, true, true>(C.lds, g, S, E); } while (0)
#define RUN2 do { p2_prep(C, in); } while (0)
#define RUN3 do { p4_scan(C, in); p3_topk(C, in); } while (0)
#define RUN4 do { } while (0)
#define RUN5 do { p5_post(C, in); if (PROBE_PHASE == 50) { __syncthreads(); p5_post(C, in); } p5_attn(C, in, PROBE_PHASE == 51 ? 2 : 1, PROBE_PHASE == 52 ? 2 : 1); } while (0)
#define RUN6 do { pg8::Gemm g{MIX, (const bf16*)(C.ws + WS_WOUT), MT, DM, DM}; pg8::StaticOrder S; S.init(MT, DM, C.G, (int)blockIdx.x); \
        pg8::EpiRes E{INF(0), INF(1), Z}; pg8::gemm_phase<pg8::EpiRes, pg8::StaticOrder, true, true>(C.lds, g, S, E); } while (0)
#define RUN7 do { ln_rows(C, Z, INF(23), INF(24), X1, X1 + (size_t)MP * DM, X1B); } while (0)
#define RUN8 do { pg8::Gemm g{X1B, (const bf16*)(C.ws + WS_WUP), MT, NUP, DM}; pg8::StaticOrder S; S.init(MT, NUP, C.G, (int)blockIdx.x); \
        pg8::EpiUp E{(bf16*)(C.ws + WS_UC), (bf16*)(C.ws + WS_UL), C.out}; pg8::gemm_phase<pg8::EpiUp, pg8::StaticOrder, true, true>(C.lds, g, S, E); } while (0)
#define RUN9 do { p9_conv(C, in); } while (0)
#define RUN10 do { pg8::Gemm g{HB, (const bf16*)(C.ws + WS_WDN), MT, DM, FF}; pg8::StaticOrder S; S.init(MT, DM, C.G, (int)blockIdx.x); \
        pg8::EpiRes E{X1, X1 + (size_t)MP * DM, Z}; pg8::gemm_phase<pg8::EpiRes, pg8::StaticOrder, true, true>(C.lds, g, S, E); } while (0)
#define RUN11 do { ln_rows(C, Z, INF(29), INF(30), C.out + O_YP, C.out + O_YS, nullptr); } while (0)
#define PHASE(k, RUN) do { if (IN(k)) { RUN; if (PROBE_PHASE == (k)) { __syncthreads(); xcd_barrier(bar); RUN; } } SEAM(k); } while (0)
    PHASE(0, RUN0); PHASE(1, RUN1); PHASE(2, RUN2); PHASE(3, RUN3); PHASE(4, RUN4); PHASE(5, RUN5);
    PHASE(6, RUN6); PHASE(7, RUN7); PHASE(8, RUN8); PHASE(9, RUN9); PHASE(10, RUN10); PHASE(11, RUN11);
#undef IN
#undef SEAM
}

#ifndef N_LAUNCH_MODE
#define N_LAUNCH_MODE 1
#endif
extern "C" void kernel_launch(void* const* d_in, const int* in_sizes, int n_in, void* d_out, int out_size, void* d_ws, size_t ws_size, hipStream_t stream) {
    static int grid = 0;
    if (grid == 0) {
        if (n_in != 31 || out_size != (int)O_END || ws_size < WS_END) { fprintf(stderr, "kernel_launch: unexpected shapes (n_in %d, out %d, ws %zu)\n", n_in, out_size, ws_size); grid = -1; return; }
        int dev = 0, cus = 0, per_cu = 0;
        if (hipGetDevice(&dev) != hipSuccess || hipDeviceGetAttribute(&cus, hipDeviceAttributeMultiprocessorCount, dev) != hipSuccess) { grid = -1; return; }
        if (hipFuncSetAttribute((const void*)fwd_kernel, hipFuncAttributeMaxDynamicSharedMemorySize, LDS_BYTES) != hipSuccess) { fprintf(stderr, "kernel_launch: hipFuncSetAttribute failed\n"); grid = -1; return; }
        if (hipOccupancyMaxActiveBlocksPerMultiprocessor(&per_cu, (const void*)fwd_kernel, NTHR, LDS_BYTES) != hipSuccess || per_cu < 1) fprintf(stderr, "kernel_launch: occupancy query says %d\n", per_cu);
        (void)hipGetLastError();
        grid = cus;
    }
    if (grid < 0) return;
    (void)hipMemsetAsync((char*)d_ws + WS_CTL, 0, CTL_ZERO_BYTES, stream);
    Args a{};
    for (int i = 0; i < 31; ++i) a.in[i] = d_in[i];
    a.out = (float*)d_out; a.ws = (unsigned char*)d_ws;
#if N_LAUNCH_MODE == 1
    a.ph_lo = 0; a.ph_hi = NPHASE;
    hipLaunchKernelGGL(fwd_kernel, dim3(grid), dim3(NTHR), LDS_BYTES, stream, a);
#else
    for (int p = 0; p < NPHASE; ++p) { a.ph_lo = p; a.ph_hi = p + 1; hipLaunchKernelGGL(fwd_kernel, dim3(grid), dim3(NTHR), LDS_BYTES, stream, a); }
#endif
    const hipError_t le = hipPeekAtLastError();
    if (le != hipSuccess) fprintf(stderr, "kernel_launch: launch failed: %s\n", hipGetErrorName(le));
}
```

```cpp
#include <hip/hip_runtime.h>
#include <cstdio>
#include <cstdint>
namespace pg8 {
#define PG8_LAS __attribute__((address_space(3)))
typedef unsigned short bf16_t;
typedef short bf16x8 __attribute__((ext_vector_type(8)));
typedef float f32x4 __attribute__((ext_vector_type(4)));
typedef unsigned u32x4 __attribute__((ext_vector_type(4)));
constexpr int BM = 256, BK = 64, HALF = 128, HTB = HALF * BK * 2  , STAGE_BYTES = 8 * HTB, NXCD = 8, WGM = 8;

__host__ __device__ __forceinline__ int lds_byte(int r, int c) { const int st = (r >> 4) * 2 + (c >> 5), rr = r & 15, cc = c & 31, ob = rr * 64 + cc * 2; return st * 1024 + (ob ^ (((ob >> 9) & 1) << 5)); }
__host__ __device__ __forceinline__ void stage_rc(int b, int& R, int& C) { const int st = b / 1024, sb = b % 1024, swz = sb ^ (((sb >> 9) & 1) << 5); R = (st >> 1) * 16 + swz / 64; C = (st & 1) * 32 + (swz % 64) / 2; }
__host__ __device__ __forceinline__ int perm32(int rho) { const int n = rho >> 4, i = rho & 15; return 8 * (i >> 2) + 4 * n + (i & 3); }

struct Unit { int pm, pn; };
struct Gemm { const bf16_t* A; const bf16_t* Bt; int M, N, K; };

struct StaticOrder {
    int nM, nN, nwg, G, c;
    __host__ __device__ void init(int M, int N, int G_, int c_) { nM = M / BM; nN = N / BM; nwg = nM * nN; G = G_; c = c_; }
    __host__ __device__ bool next(int i, Unit& u) const {
        const long L = (long)i * G + c; if (L >= nwg) return false;
        int wgid = (int)L; { const int q = nwg / NXCD, r = nwg % NXCD, xcd = wgid % NXCD, off = wgid / NXCD; wgid = (xcd < r ? xcd * (q + 1) : r * (q + 1) + (xcd - r) * q) + off; }
        const int nig = WGM * nN, gid = wgid / nig, fm = gid * WGM, gsz = (nM - fm) < WGM ? (nM - fm) : WGM;
        u.pm = fm + ((wgid % nig) % gsz); u.pn = (wgid % nig) / gsz; return true;
    }
    __device__ __forceinline__ void a_ready(const Unit&) const {}
    __device__ __forceinline__ void done(const Unit&) const {}
};

__device__ __forceinline__ unsigned cvt_pk_bf16(float lo, float hi) { unsigned r; asm volatile("v_cvt_pk_bf16_f32 %0, %1, %2" : "=v"(r) : "v"(lo), "v"(hi)); return r; }
typedef float f32x2 __attribute__((ext_vector_type(2)));
template <class Epi, class Sched, bool ALIGN_EPI = false, bool SP2 = false>
__device__ __forceinline__ void gemm_phase(PG8_LAS unsigned char* lds, const Gemm g, const Sched& S, const Epi& E) {
    const int tid = threadIdx.x, wid = __builtin_amdgcn_readfirstlane(tid >> 6), lane = tid & 63, wr = wid >> 2, wc = wid & 3, fr = lane & 15, fq = lane >> 4;
    const int K = g.K, nt = K / BK;
    unsigned voffA[2], voffB[2];
#pragma unroll
    for (int i = 0; i < 2; ++i) { int R, C; stage_rc(tid * 16 + i * 8192, R, C); const int Rb = Epi::PERM ? ((R & ~31) + perm32(R & 31)) : R;
        voffA[i] = (unsigned)(R * K + C) * 2u; voffB[i] = (unsigned)(Rb * K + C) * 2u; }
    const size_t kstep = (size_t)(BK * 2);
    const size_t hstep = (size_t)HALF * K * 2;
    const size_t tstep = 2 * hstep;
    const unsigned ldsw = (unsigned)wid * 1024u;
    const int aoff = lds_byte(wr * 64 + fr, fq * 8), boff = lds_byte(wc * 32 + fr, fq * 8);
#define PG8_SA(b, h) (((b) * 2 + (h)) * HTB)
#define PG8_SB(b, h) ((4 + (b) * 2 + (h)) * HTB)
#define PG8_STAGE(bufoff, gbase, voff) do { _Pragma("unroll") for (int _i = 0; _i < 2; ++_i) \
        __builtin_amdgcn_global_load_lds((const unsigned*)((const char*)(gbase) + (voff)[_i]), (PG8_LAS unsigned*)(lds + (bufoff) + ldsw + _i * 8192), 16, 0, 0); } while (0)
#define PG8_LDA(dst, b, h) do { _Pragma("unroll") for (int m = 0; m < 4; ++m) _Pragma("unroll") for (int k = 0; k < 2; ++k) dst[m][k] = *(const PG8_LAS bf16x8*)(lds + PG8_SA(b, h) + aoff + m * 2048 + k * 1024); } while (0)
#define PG8_LDB(dst, b, h) do { _Pragma("unroll") for (int n = 0; n < 2; ++n) _Pragma("unroll") for (int k = 0; k < 2; ++k) dst[n][k] = *(const PG8_LAS bf16x8*)(lds + PG8_SB(b, h) + boff + n * 2048 + k * 1024); } while (0)
#define PG8_MMA(ai, bj, At, Bt) do { __builtin_amdgcn_s_setprio(1); _Pragma("unroll") for (int m = 0; m < 4; ++m) _Pragma("unroll") for (int n = 0; n < 2; ++n) _Pragma("unroll") for (int k = 0; k < 2; ++k) \
        acc[ai][bj][m][n] = __builtin_amdgcn_mfma_f32_16x16x32_bf16(Bt[n][k], At[m][k], acc[ai][bj][m][n], 0, 0, 0); __builtin_amdgcn_s_setprio(0); } while (0)
#define PG8_WAIT_V(n) asm volatile("s_waitcnt vmcnt(" #n ")" ::: "memory")
#define PG8_WAIT_L(n) asm volatile("s_waitcnt lgkmcnt(" #n ")" ::: "memory")
#define PG8_BAR __builtin_amdgcn_s_barrier()
#define PG8_SCHED __builtin_amdgcn_sched_barrier(0)
    Unit cur, nxt; int ui = 0;
    if (!S.next(0, cur)) return;
    f32x4 acc[2][2][4][2];
#pragma unroll
    for (int a = 0; a < 2; ++a)
#pragma unroll
        for (int b = 0; b < 2; ++b)
#pragma unroll
            for (int m = 0; m < 4; ++m)
#pragma unroll
                for (int n = 0; n < 2; ++n) acc[a][b][m][n] = (f32x4){0.f, 0.f, 0.f, 0.f};
    bf16x8 At[4][2], B0[2][2], B1[2][2];
    const char* cA = (const char*)g.A + (size_t)cur.pm * tstep; const char* cB = (const char*)g.Bt + (size_t)cur.pn * tstep;
    S.a_ready(cur);
    if constexpr (SP2) {
        PG8_STAGE(PG8_SB(0, 0), cB, voffB); PG8_STAGE(PG8_SB(0, 1), cB + hstep, voffB); PG8_STAGE(PG8_SA(0, 0), cA, voffA); PG8_STAGE(PG8_SA(0, 1), cA + hstep, voffA);
        if (wr == 1) PG8_BAR;
        PG8_WAIT_V(2); PG8_BAR;
        PG8_STAGE(PG8_SB(1, 0), cB + kstep, voffB); PG8_STAGE(PG8_SA(1, 0), cA + kstep, voffA); PG8_STAGE(PG8_SB(1, 1), cB + hstep + kstep, voffB);
        PG8_WAIT_V(6); PG8_BAR;
    } else {
        PG8_STAGE(PG8_SB(0, 0), cB, voffB); PG8_STAGE(PG8_SA(0, 0), cA, voffA); PG8_STAGE(PG8_SB(0, 1), cB + hstep, voffB); PG8_STAGE(PG8_SA(0, 1), cA + hstep, voffA);
        if (wr == 1) PG8_BAR;
        PG8_WAIT_V(4); PG8_BAR;
        PG8_STAGE(PG8_SB(1, 0), cB + kstep, voffB); PG8_STAGE(PG8_SA(1, 0), cA + kstep, voffA); PG8_STAGE(PG8_SB(1, 1), cB + hstep + kstep, voffB);
        PG8_WAIT_V(6); PG8_BAR;
    }
    for (;;) {
        const bool has_next = S.next(ui + 1, nxt);
        const char* nA = has_next ? (const char*)g.A + (size_t)nxt.pm * tstep : cA; const char* nB = has_next ? (const char*)g.Bt + (size_t)nxt.pn * tstep : cB;
        for (int t = 0; t < nt; t += 2) {
            const bool last = (t == nt - 2);
            const char* a1 = cA + (size_t)(t + 1) * kstep;
            const char* a2 = last ? nA : cA + (size_t)(t + 2) * kstep; const char* b2 = last ? nB : cB + (size_t)(t + 2) * kstep;
            const char* a3 = a2 + kstep; const char* b3 = b2 + kstep;
            if (last && has_next) S.a_ready(nxt);
            if constexpr (SP2) {
            PG8_LDB(B0, 0, 0); PG8_LDB(B1, 0, 1); PG8_SCHED; PG8_LDA(At, 0, 0); PG8_STAGE(PG8_SA(1, 1), a1 + hstep, voffA);
            PG8_WAIT_V(8); PG8_WAIT_L(0); PG8_BAR; PG8_MMA(0, 0, At, B0); PG8_MMA(0, 1, At, B1); PG8_BAR; PG8_SCHED;
            PG8_LDA(At, 0, 1); PG8_STAGE(PG8_SB(0, 0), b2, voffB); PG8_STAGE(PG8_SB(0, 1), b2 + hstep, voffB); PG8_STAGE(PG8_SA(0, 0), a2, voffA);
            PG8_WAIT_V(8); PG8_WAIT_L(0); PG8_BAR; PG8_MMA(1, 0, At, B0); PG8_MMA(1, 1, At, B1); PG8_BAR; PG8_SCHED;
            PG8_LDB(B0, 1, 0); PG8_LDB(B1, 1, 1); PG8_SCHED; PG8_LDA(At, 1, 0); PG8_STAGE(PG8_SA(0, 1), a2 + hstep, voffA);
            PG8_WAIT_V(8); PG8_WAIT_L(0); PG8_BAR; PG8_MMA(0, 0, At, B0); PG8_MMA(0, 1, At, B1); PG8_BAR; PG8_SCHED;
            PG8_LDA(At, 1, 1); PG8_STAGE(PG8_SB(1, 0), b3, voffB); PG8_STAGE(PG8_SB(1, 1), b3 + hstep, voffB); PG8_STAGE(PG8_SA(1, 0), a3, voffA);
            PG8_WAIT_V(8); PG8_WAIT_L(0); PG8_BAR; PG8_MMA(1, 0, At, B0); PG8_MMA(1, 1, At, B1); PG8_BAR; PG8_SCHED;
            } else {
            PG8_LDB(B0, 0, 0); PG8_SCHED; PG8_LDA(At, 0, 0); PG8_STAGE(PG8_SA(1, 1), a1 + hstep, voffA);
            PG8_WAIT_L(8); PG8_BAR; PG8_WAIT_L(0); PG8_MMA(0, 0, At, B0); PG8_BAR; PG8_SCHED;
            PG8_LDB(B1, 0, 1); PG8_STAGE(PG8_SB(0, 0), b2, voffB);
            PG8_BAR; PG8_WAIT_L(0); PG8_MMA(0, 1, At, B1); PG8_BAR;
            PG8_LDA(At, 0, 1); PG8_STAGE(PG8_SA(0, 0), a2, voffA);
            PG8_BAR; PG8_WAIT_L(0); PG8_MMA(1, 0, At, B0); PG8_BAR; PG8_SCHED;
            PG8_STAGE(PG8_SB(0, 1), b2 + hstep, voffB);
            PG8_WAIT_V(6); PG8_BAR; PG8_MMA(1, 1, At, B1); PG8_BAR;
            PG8_LDB(B0, 1, 0); PG8_SCHED; PG8_LDA(At, 1, 0); PG8_STAGE(PG8_SA(0, 1), a2 + hstep, voffA);
            PG8_WAIT_L(8); PG8_BAR; PG8_WAIT_L(0); PG8_MMA(0, 0, At, B0); PG8_BAR; PG8_SCHED;
            PG8_LDB(B1, 1, 1); PG8_STAGE(PG8_SB(1, 0), b3, voffB);
            PG8_BAR; PG8_WAIT_L(0); PG8_MMA(0, 1, At, B1); PG8_BAR;
            PG8_LDA(At, 1, 1); PG8_STAGE(PG8_SA(1, 0), a3, voffA);
            PG8_BAR; PG8_WAIT_L(0); PG8_MMA(1, 0, At, B0); PG8_BAR; PG8_SCHED;
            PG8_STAGE(PG8_SB(1, 1), b3 + hstep, voffB);
            PG8_WAIT_V(6); PG8_BAR; PG8_MMA(1, 1, At, B1); PG8_BAR;
            }
        }
        if constexpr (ALIGN_EPI) { if (wr == 0) PG8_BAR; }
        if constexpr (!Epi::AFTER_DRAIN) { E(acc, cur, wr, wc, fr, fq); S.done(cur); }
        if (!has_next) break;
#pragma unroll
        for (int a = 0; a < 2; ++a)
#pragma unroll
            for (int b = 0; b < 2; ++b)
#pragma unroll
                for (int m = 0; m < 4; ++m)
#pragma unroll
                    for (int n = 0; n < 2; ++n) acc[a][b][m][n] = (f32x4){0.f, 0.f, 0.f, 0.f};
        cur = nxt; cA = nA; cB = nB; ++ui;
        if constexpr (ALIGN_EPI) { if (wr == 1) PG8_BAR; }
    }
    PG8_WAIT_V(0);
    if constexpr (!ALIGN_EPI) { if (wr == 0) PG8_BAR; }
    PG8_BAR;
    if constexpr (Epi::AFTER_DRAIN) { E.fused(acc, cur, wr, wc, fr, fq, lds, wid, lane); S.done(cur); }
#undef PG8_SA
#undef PG8_SB
#undef PG8_STAGE
#undef PG8_LDA
#undef PG8_LDB
#undef PG8_MMA
#undef PG8_WAIT_V
#undef PG8_WAIT_L
#undef PG8_BAR
#undef PG8_SCHED
}
}
#define GAS __attribute__((address_space(1)))
#define LAS __attribute__((address_space(3)))
typedef unsigned short bf16;
typedef unsigned v4u __attribute__((ext_vector_type(4)));
typedef float f32x4 __attribute__((ext_vector_type(4)));
typedef short bf16x8 __attribute__((ext_vector_type(8)));
typedef GAS unsigned gu32;
typedef GAS unsigned long long gu64;
#define RLX_AGENT __ATOMIC_RELAXED, __HIP_MEMORY_SCOPE_AGENT
#define LDS_WAIT() asm volatile("s_waitcnt lgkmcnt(0)" ::: "memory")
#define VM_WAIT() asm volatile("s_waitcnt vmcnt(0)" ::: "memory")
__device__ __forceinline__ unsigned long long rt() { return __builtin_amdgcn_s_memrealtime(); }
__device__ __forceinline__ unsigned f2bf(float f) { unsigned u = __builtin_bit_cast(unsigned, f); return (u + 0x7fffu + ((u >> 16) & 1u)) >> 16; }
typedef float pk2_f32x2 __attribute__((ext_vector_type(2))); typedef __bf16 pk2_bf16x2 __attribute__((ext_vector_type(2)));
__device__ __forceinline__ unsigned pk2(float lo, float hi) { pk2_f32x2 v = {lo, hi}; pk2_bf16x2 b = __builtin_convertvector(v, pk2_bf16x2); return __builtin_bit_cast(unsigned, b); }

#define XB_TMO      128
#define XB_XCNT(j)  (256  + 64 * (j))
#define XB_XSUB(j)  (1280 + 64 * (j))
#define XB_XGEN(j)  (2304 + 64 * (j))
#define XB_TOP      3328
#define XB_TOPGEN   3392
#define XCD_BAR_WORDS 3456
#define XB_SPIN_CAP (1u << 18)

__device__ __forceinline__ unsigned xb_ld(unsigned* p)              { return __hip_atomic_load(p, __ATOMIC_RELAXED, __HIP_MEMORY_SCOPE_AGENT); }
__device__ __forceinline__ unsigned xb_add(unsigned* p, unsigned v) { return __hip_atomic_fetch_add(p, v, __ATOMIC_RELAXED, __HIP_MEMORY_SCOPE_AGENT); }
__device__ __forceinline__ unsigned xb_xcc_id() { return (unsigned)__builtin_amdgcn_s_getreg((3 << 11) | 20) & 0xFu; }
#define XB_SPIN(cond, bar) do { unsigned _sp = 0; while (cond) { __builtin_amdgcn_s_sleep(1); \
    if ((++_sp & 255u) == 0u) { if (xb_ld(&(bar)[XB_TMO])) break; if (_sp > XB_SPIN_CAP) { atomicAdd(&(bar)[XB_TMO], 1u); break; } } } } while (0)

struct XcdBarrier {
    unsigned* bar; unsigned x;
    volatile LAS unsigned* st;
};

__device__ __forceinline__ XcdBarrier xcd_barrier_post(unsigned* bar, volatile LAS unsigned* st) {
    XcdBarrier b; b.bar = bar; b.x = xb_xcc_id(); b.st = st;
    if (threadIdx.x == 0) (void)xb_add(&bar[XB_XCNT(b.x)], 1u);
    return b;
}
__device__ __forceinline__ void xcd_barrier_complete(unsigned* bar, unsigned x, unsigned& nloc, unsigned& nx) {
    const unsigned G = gridDim.x * gridDim.y * gridDim.z;
    unsigned sum, cnt, mine, sp = 0u;
    for (;;) {
        sum = 0u; cnt = 0u; mine = 0u;
#pragma unroll
        for (unsigned j = 0; j < 16; ++j) { const unsigned c = xb_ld(&bar[XB_XCNT(j)]); sum += c; cnt += (c > 0u) ? 1u : 0u; mine = (j == x) ? c : mine; }
        if (sum == G) break;
        __builtin_amdgcn_s_sleep(1);
        if ((++sp & 255u) == 0u) { if (xb_ld(&bar[XB_TMO])) break; if (sp > XB_SPIN_CAP) { atomicAdd(&bar[XB_TMO], 1u); break; } }
    }
    nloc = mine > 0u ? mine : 1u; nx = cnt > 0u ? cnt : 1u;
}

__device__ __forceinline__ void xcd_barrier(const XcdBarrier& b) {
    asm volatile("s_waitcnt vmcnt(0)" ::: "memory");
    __syncthreads();
    if (threadIdx.x == 0) {
        unsigned* bar = b.bar;
        __builtin_amdgcn_s_waitcnt(0);
        unsigned nloc = b.st[0], nx = b.st[1];
        if (nloc == 0u) { xcd_barrier_complete(bar, b.x, nloc, nx); b.st[0] = nloc; b.st[1] = nx; }
        const unsigned old = xb_add(&bar[XB_XSUB(b.x)], 1u);
        const unsigned gen = old / nloc;
        if (old + 1u == (gen + 1u) * nloc) {
            __builtin_amdgcn_fence(__ATOMIC_RELEASE, "agent");
            asm volatile("s_waitcnt vmcnt(0)" ::: "memory");
            const unsigned og = xb_add(&bar[XB_TOP], 1u);
            const unsigned tg = og / nx;
            if (og + 1u == (tg + 1u) * nx) xb_add(&bar[XB_TOPGEN], 1u);
            else XB_SPIN(xb_ld(&bar[XB_TOPGEN]) == tg, bar);
            __builtin_amdgcn_fence(__ATOMIC_ACQUIRE, "agent");
            xb_add(&bar[XB_XGEN(b.x)], 1u);
            asm volatile("s_waitcnt vmcnt(0)" ::: "memory");
        } else {
            XB_SPIN(xb_ld(&bar[XB_XGEN(b.x)]) == gen, bar);
            __builtin_amdgcn_fence(__ATOMIC_ACQUIRE, "agent");
            asm volatile("s_waitcnt vmcnt(0)" ::: "memory");
        }
    }
    __syncthreads();
}
#ifndef PROBE_PHASE
#define PROBE_PHASE -1
#endif
constexpr int TP = 4096, BP = 4, MP = BP * TP;
constexpr int BS = 128, TS = 4, MS = BS * TS;
constexpr int MT = MP + MS;
constexpr int DM = 1024, RW = 512, SC = 1792, NINP = 3840, FF = 2816, NUP = 5632;
constexpr int PAST = 2048, NPAGES = 16, LS = PAST + TS;
constexpr float ALPHA = 1.189207115002721f;
constexpr float LN_EPS = 1e-5f, GN_EPS = 64e-5f;
constexpr float QSCALE = 0.125f * 1.4426950408889634f;
constexpr float LOG2E = 1.4426950408889634f;
constexpr size_t O_YP = 0, O_YS = 16777216, O_KP = 17301504, O_VP = 25690112, O_KIP = 34078720, O_WKVP = 35127296, O_SHP = 35258368, O_CVP = 35265536,
                 O_KS = 35288064, O_VS = 35550208, O_KIS = 35812352, O_WKVS = 35845120, O_SHS = 40039424, O_CVS = 40268800, O_END = 40989696;

namespace pg8 {
__device__ __forceinline__ u32x4 pack8(const f32x4 a, const f32x4 b) { u32x4 w; w.x = cvt_pk_bf16(a[0], a[1]); w.y = cvt_pk_bf16(a[2], a[3]); w.z = cvt_pk_bf16(b[0], b[1]); w.w = cvt_pk_bf16(b[2], b[3]); return w; }
struct EpiIn {
    static constexpr bool PERM = true, AFTER_DRAIN = false;
    float* prw; bf16_t* qb; bf16_t* kb; bf16_t* vb; float* qi; float* wi; float* out;
    __device__ __forceinline__ void operator()(const f32x4 (&acc)[2][2][4][2], const Unit& u, int wr, int wc, int fr, int fq) const {
        const int pn = u.pn; const bool samp = u.pm >= 64;
#pragma unroll
        for (int ai = 0; ai < 2; ++ai)
#pragma unroll
            for (int m = 0; m < 4; ++m) {
                const int row = u.pm * BM + ai * HALF + wr * 64 + m * 16 + fr;
                const int rs = row - MP;
#pragma unroll
                for (int bj = 0; bj < 2; ++bj) {
                    const int col = pn * BM + bj * HALF + wc * 32 + 8 * fq;
                    const f32x4 v0 = acc[ai][bj][m][0], v1 = acc[ai][bj][m][1];
                    if (pn < 7) {
                        float* p = prw + (size_t)row * SC + col; *(f32x4*)p = v0; *(f32x4*)(p + 4) = v1;
                        const bool last = samp ? ((rs & 3) == 3) : ((row & (TP - 1)) == TP - 1);
                        if (last) { float* o = samp ? out + O_SHS + (size_t)(rs >> 2) * SC + col : out + O_SHP + (size_t)(row >> 12) * SC + col; *(f32x4*)o = v0; *(f32x4*)(o + 4) = v1; }
                    } else if (pn < 9) {
                        const int c = col - 1792; *(u32x4*)(qb + (size_t)row * RW + c) = pack8(v0 * QSCALE, v1 * QSCALE);
                    } else if (pn < 11) {
                        const int c = col - 2304; float* o = samp ? out + O_KS + (size_t)rs * RW + c : out + O_KP + (size_t)row * RW + c; *(f32x4*)o = v0; *(f32x4*)(o + 4) = v1;
                        *(u32x4*)(kb + (size_t)row * RW + c) = pack8(v0, v1);
                    } else if (pn < 13) {
                        const int c = col - 2816; float* o = samp ? out + O_VS + (size_t)rs * RW + c : out + O_VP + (size_t)row * RW + c; *(f32x4*)o = v0; *(f32x4*)(o + 4) = v1;
                        *(u32x4*)(vb + (size_t)row * RW + c) = pack8(v0, v1);
                    } else if (pn == 13) {
                        const int c = col - 3328; float* o = qi + (size_t)row * 256 + c; *(f32x4*)o = v0; *(f32x4*)(o + 4) = v1;
                    } else {
                        const int c = col - 3584;
                        if (c < 64) { float* o = samp ? out + O_KIS + (size_t)rs * 64 + c : out + O_KIP + (size_t)row * 64 + c; *(f32x4*)o = v0; *(f32x4*)(o + 4) = v1; }
                        else if (c == 64) { *(f32x4*)(wi + (size_t)row * 4) = v0 * 0.5f; }
                    }
                }
            }
    }
};
struct EpiRes {
    static constexpr bool PERM = true, AFTER_DRAIN = false;
    const float* resP; const float* resS; float* out;
    __device__ __forceinline__ void operator()(const f32x4 (&acc)[2][2][4][2], const Unit& u, int wr, int wc, int fr, int fq) const {
        const bool samp = u.pm >= 64;
#pragma unroll
        for (int ai = 0; ai < 2; ++ai)
#pragma unroll
            for (int m = 0; m < 4; ++m) {
                const int row = u.pm * BM + ai * HALF + wr * 64 + m * 16 + fr;
                const float* rr = samp ? resS + (size_t)(row - MP) * DM : resP + (size_t)row * DM;
#pragma unroll
                for (int bj = 0; bj < 2; ++bj) {
                    const int col = u.pn * BM + bj * HALF + wc * 32 + 8 * fq;
                    const f32x4 r0 = *(const f32x4*)(rr + col), r1 = *(const f32x4*)(rr + col + 4);
                    float* o = out + (size_t)row * DM + col;
                    *(f32x4*)o = r0 * ALPHA + acc[ai][bj][m][0]; *(f32x4*)(o + 4) = r1 * ALPHA + acc[ai][bj][m][1];
                }
            }
    }
};
struct EpiUp {
    static constexpr bool PERM = true, AFTER_DRAIN = false;
    bf16_t* uc; bf16_t* ul; float* out;
    __device__ __forceinline__ void operator()(const f32x4 (&acc)[2][2][4][2], const Unit& u, int wr, int wc, int fr, int fq) const {
        const bool samp = u.pm >= 64;
#pragma unroll
        for (int ai = 0; ai < 2; ++ai)
#pragma unroll
            for (int m = 0; m < 4; ++m) {
                const int row = u.pm * BM + ai * HALF + wr * 64 + m * 16 + fr;
                const int c = u.pn * HALF + wc * 32 + 8 * fq;
                *(u32x4*)(uc + (size_t)row * FF + c) = pack8(acc[ai][0][m][0], acc[ai][0][m][1]);
                *(u32x4*)(ul + (size_t)row * FF + c) = pack8(acc[ai][1][m][0], acc[ai][1][m][1]);
                if (samp) { const int rs = row - MP, t = rs & 3; if (t >= 2) { float* o = out + O_CVS + ((size_t)(rs >> 2) * 2 + (t - 2)) * FF + c; *(f32x4*)o = acc[ai][0][m][0]; *(f32x4*)(o + 4) = acc[ai][0][m][1]; } }
                else { const int t = row & (TP - 1); if (t >= TP - 2) { float* o = out + O_CVP + ((size_t)(row >> 12) * 2 + (t - (TP - 2))) * FF + c; *(f32x4*)o = acc[ai][0][m][0]; *(f32x4*)(o + 4) = acc[ai][0][m][1]; } }
            }
    }
};
}
constexpr size_t MiB = 1u << 20;
constexpr size_t WS_CTL = 0, CTL_ZERO_BYTES = 1 * MiB;
constexpr size_t WS_WIN = 2 * MiB;
constexpr size_t WS_WOUT = 10 * MiB;
constexpr size_t WS_WUP = 12 * MiB;
constexpr size_t WS_WDN = 24 * MiB;
constexpr size_t WS_LW = 30 * MiB;
constexpr size_t WS_XB = 32 * MiB;
constexpr size_t WS_PRW = 66 * MiB;
constexpr size_t WS_QB = 182 * MiB;
constexpr size_t WS_KB = 199 * MiB;
constexpr size_t WS_VB = 216 * MiB;
constexpr size_t WS_QI = 233 * MiB;
constexpr size_t WS_WI = 250 * MiB;
constexpr size_t WS_SCAN = 1024 * MiB;
constexpr size_t WS_G = 454 * MiB;
constexpr size_t WS_BG = 251 * MiB;
constexpr size_t WS_YS = 489 * MiB;
constexpr size_t WS_MASK = 523 * MiB;
constexpr size_t WS_SEL = 532 * MiB;
constexpr size_t WS_MIX = 533 * MiB;
constexpr size_t WS_Z = 567 * MiB;
constexpr size_t WS_X1 = 634 * MiB;
constexpr size_t WS_X1B = 701 * MiB;
constexpr size_t WS_UC = 735 * MiB;
constexpr size_t WS_UL = 826 * MiB;
constexpr size_t WS_H = 917 * MiB;
constexpr size_t WS_END = 1330 * MiB;
constexpr int CW_BAR = 4096;
constexpr int CW_Q = 64;
constexpr int SREC = 576;

constexpr int RING_BYTES = 131072, LDSCTL_OFF = RING_BYTES, MISC_OFF = LDSCTL_OFF + 320, LDS_BYTES = 147456;
constexpr int NWAVES = 8, NTHR = 512;
constexpr int NPHASE = 12;

__device__ __forceinline__ float bf2f(unsigned short h) { return __builtin_bit_cast(float, (unsigned)h << 16); }
__device__ __forceinline__ float wave_sum(float v) {
#pragma unroll
    for (int o = 1; o < 64; o <<= 1) v += __shfl_xor(v, o);
    return v;
}
template <int CTRL> __device__ __forceinline__ float dppf(float x) { return __builtin_bit_cast(float, __builtin_amdgcn_update_dpp(0, __builtin_bit_cast(int, x), CTRL, 0xf, 0xf, true)); }
__device__ __forceinline__ float sum16(float x) {
    x += dppf<0xB1>(x); x += dppf<0x4E>(x); x += dppf<0x141>(x); x += dppf<0x140>(x); return x;
}
__device__ __forceinline__ float sum8(float x) {
    x += dppf<0xB1>(x); x += dppf<0x4E>(x); x += dppf<0x141>(x); return x;
}
__device__ __forceinline__ bf16x8 pack_bf8(const f32x4 a, const f32x4 b) {
    v4u w; w.x = pk2(a[0], a[1]); w.y = pk2(a[2], a[3]); w.z = pk2(b[0], b[1]); w.w = pk2(b[2], b[3]); return __builtin_bit_cast(bf16x8, w);
}
typedef float f32x16 __attribute__((ext_vector_type(16)));
typedef float f32x2 __attribute__((ext_vector_type(2)));

struct Ctx {
    LAS unsigned char* lds; int tid, lane, wave, vcu, G;
    const void* const* in_; float* out; unsigned char* ws;
};
#define INF(k) ((const float*)in[k])

template <int MODE> __device__ __forceinline__ void p0_tr_item(const float* W, int K, int N, int nblk, bf16* WT, LAS float* scr, int item, int lane) {
    const int kb = item / nblk, nb = item % nblk, k0 = 64 * kb, n0 = 32 * nb;
    const int nl0 = lane & 31; const bool okn = (n0 + nl0) < N;
#pragma unroll 8
    for (int i = 0; i < 32; ++i) { const int kk = 2 * i + (lane >> 5); scr[kk * 33 + nl0] = okn ? W[(size_t)(k0 + kk) * N + n0 + nl0] : 0.f; }
    asm volatile("s_waitcnt lgkmcnt(0)" ::: "memory");
    const int c = lane & 7;
#pragma unroll
    for (int j = 0; j < 4; ++j) { const int nl = (lane >> 3) + 8 * j; const int n = n0 + nl; const LAS float* s = scr + (8 * c) * 33 + nl;
        int row = n;
        if (MODE == 2) row = (n < FF) ? 256 * (n >> 7) + (n & 127) : 256 * ((n - FF) >> 7) + 128 + ((n - FF) & 127);
        v4u o; o.x = pk2(s[0 * 33], s[1 * 33]); o.y = pk2(s[2 * 33], s[3 * 33]); o.z = pk2(s[4 * 33], s[5 * 33]); o.w = pk2(s[6 * 33], s[7 * 33]);
        *(GAS v4u*)(WT + (size_t)row * K + k0 + 8 * c) = o; }
    asm volatile("s_waitcnt lgkmcnt(0)" ::: "memory");
}
__device__ __forceinline__ void p0_prologue(const Ctx& C, const void* const* in) {
    LAS float* scr = (LAS float*)(C.lds + C.wave * 16384);
    const int gw = C.vcu * NWAVES + C.wave, NGW = C.G * NWAVES;
    constexpr int I_IN = 16 * 120, I_OUT = 16 * 32, I_UP = 16 * 176, I_DN = 44 * 32, NITEMS = I_IN + I_OUT + I_UP + I_DN;
    bf16* win = (bf16*)(C.ws + WS_WIN); bf16* wout = (bf16*)(C.ws + WS_WOUT); bf16* wup = (bf16*)(C.ws + WS_WUP); bf16* wdn = (bf16*)(C.ws + WS_WDN);
    for (int it = gw; it < NITEMS; it += NGW) {
        int r = it;
        if (r < I_IN) { p0_tr_item<0>(INF(10), DM, 3652, 120, win, scr, r, C.lane); continue; } r -= I_IN;
        if (r < I_OUT) { p0_tr_item<0>(INF(22), DM, DM, 32, wout, scr, r, C.lane); continue; } r -= I_OUT;
        if (r < I_UP) { p0_tr_item<2>(INF(25), DM, NUP, 176, wup, scr, r, C.lane); continue; } r -= I_UP;
        p0_tr_item<0>(INF(28), FF, DM, 32, wdn, scr, r, C.lane);
    }
    {
        bf16* lw = (bf16*)(C.ws + WS_LW);
        for (int e = C.vcu * NTHR + C.tid; e < 512 * 256; e += C.G * NTHR) { const int ch = e & 511, k = e >> 9;
            const float v = (k < 64) ? INF(13)[k * RW + ch] : (k < 128) ? INF(15)[(k - 64) * RW + ch] : INF(16)[(k - 128) * RW + ch];
            lw[(size_t)ch * 256 + k] = (bf16)f2bf(v); }
    }
    bf16* xb = (bf16*)(C.ws + WS_XB);
    for (int m = gw; m < MT; m += NGW) {
        const float* xr = (m < MP) ? INF(0) + (size_t)m * DM : INF(1) + (size_t)(m - MP) * DM;
        const GAS f32x4* x4 = (const GAS f32x4*)xr + C.lane;
        GAS unsigned long long* o8 = (GAS unsigned long long*)(xb + (size_t)m * DM) + C.lane;
#pragma unroll
        for (int j = 0; j < 4; ++j) { const f32x4 v = x4[64 * j]; o8[64 * j] = (unsigned long long)pk2(v.x, v.y) | ((unsigned long long)pk2(v.z, v.w) << 32); }
    }
}

__device__ __forceinline__ float sigmoidf_(float x) { return 1.f / (1.f + __expf(-x)); }
__device__ __forceinline__ float sum32h(float x) {
    x = sum16(x);
    return x + __shfl_xor(x, 16);
}
constexpr int ACT_PITCH = 264;
__device__ __forceinline__ void p2_prep(const Ctx& C, const void* const* in) {
    LAS unsigned short* act = (LAS unsigned short*)C.lds;
    const float* PRW = (const float*)(C.ws + WS_PRW);
    float* SCAN = (float*)(C.ws + WS_SCAN); float* Gb = (float*)(C.ws + WS_G); float* BG = (float*)(C.ws + WS_BG);
    const bf16* LW = (const bf16*)(C.ws + WS_LW);
    const float* smu = INF(11); const float* sst = INF(7);
    const int h = C.wave, lane = C.lane, n32 = lane & 31, hi = lane >> 5;
    float mu_r[2], mu_k[2], mu_v[2], w0[2], a0[2], kkc[2], kac[2], rkc[2];
#pragma unroll
    for (int nt = 0; nt < 2; ++nt) { const int c = 64 * h + 32 * nt + n32; mu_r[nt] = smu[c]; mu_k[nt] = smu[RW + c]; mu_v[nt] = smu[2 * RW + c];
        w0[nt] = INF(12)[c]; a0[nt] = INF(14)[c]; kkc[nt] = INF(17)[c]; kac[nt] = INF(18)[c]; rkc[nt] = INF(19)[c]; }
    for (int tile = C.vcu; tile < MT / 32; tile += C.G) {
        const int m0 = tile * 32;
        __syncthreads();
        {
            const int tok = C.tid >> 4, cg = C.tid & 15, m = m0 + tok, col0 = 1536 + cg * 16;
            const float* prow = PRW + (size_t)m * SC + col0; const float* pprev = prow - SC; bool zero = false;
            if (m < MP) { zero = (m & (TP - 1)) == 0; } else { const int ms = m - MP; if ((ms & 3) == 0) pprev = sst + (size_t)(ms >> 2) * SC + col0; }
            f32x4 sv[4];
#pragma unroll
            for (int i = 0; i < 4; ++i) {
                const f32x4 p = *(const f32x4*)(prow + 4 * i); f32x4 q = (f32x4){0.f, 0.f, 0.f, 0.f}; if (!zero) q = *(const f32x4*)(pprev + 4 * i);
                const f32x4 mu = *(const f32x4*)(smu + col0 + 4 * i); f32x4 s = p + (q - p) * mu;
                if (cg < 4) { for (int e = 0; e < 4; ++e) { const float ex = __expf(2.f * s[e]); s[e] = 1.f - 2.f / (ex + 1.f); } }
                else if (cg >= 8) { for (int e = 0; e < 4; ++e) s[e] = sigmoidf_(s[e]); }
                sv[i] = s;
            }
            LAS unsigned short* dst = act + tok * ACT_PITCH + cg * 16;
            *(LAS v4u*)dst = (v4u){pk2(sv[0][0], sv[0][1]), pk2(sv[0][2], sv[0][3]), pk2(sv[1][0], sv[1][1]), pk2(sv[1][2], sv[1][3])};
            *(LAS v4u*)(dst + 8) = (v4u){pk2(sv[2][0], sv[2][1]), pk2(sv[2][2], sv[2][3]), pk2(sv[3][0], sv[3][1]), pk2(sv[3][2], sv[3][3])};
        }
        __syncthreads();
        f32x16 accW[2], accA[2], accG[2];
#pragma unroll
        for (int nt = 0; nt < 2; ++nt)
#pragma unroll
            for (int r = 0; r < 16; ++r) { accW[nt][r] = 0.f; accA[nt][r] = 0.f; accG[nt][r] = 0.f; }
        {
            const LAS unsigned short* arow = act + n32 * ACT_PITCH + 8 * hi;
#pragma unroll
            for (int nt = 0; nt < 2; ++nt) {
                const bf16* brow = LW + (size_t)(64 * h + 32 * nt + n32) * 256 + 8 * hi;
#pragma unroll
                for (int s = 0; s < 16; ++s) {
                    const bf16x8 af = *(const LAS bf16x8*)(arow + 16 * s); const bf16x8 bfr = *(const bf16x8*)(brow + 16 * s);
                    if (s < 4) accW[nt] = __builtin_amdgcn_mfma_f32_32x32x16_bf16(af, bfr, accW[nt], 0, 0, 0);
                    else if (s < 8) accA[nt] = __builtin_amdgcn_mfma_f32_32x32x16_bf16(af, bfr, accA[nt], 0, 0, 0);
                    else accG[nt] = __builtin_amdgcn_mfma_f32_32x32x16_bf16(af, bfr, accG[nt], 0, 0, 0);
                }
            }
        }
#pragma unroll
        for (int r = 0; r < 16; ++r) {
            const int tk = (r & 3) + 8 * (r >> 2) + 4 * hi, m = m0 + tk;
            const float* pc = PRW + (size_t)m * SC; const float* pp = pc - SC; bool zero = false;
            if (m < MP) { zero = (m & (TP - 1)) == 0; } else { const int ms = m - MP; if ((ms & 3) == 0) pp = sst + (size_t)(ms >> 2) * SC; }
            float rr_[2], kx_[2], vx_[2], dec[2], aa_[2], kk_[2], kp_[2];
            float s_kk = 0.f;
#pragma unroll
            for (int nt = 0; nt < 2; ++nt) {
                const int c = 64 * h + 32 * nt + n32;
                const float pr = pc[c], pk = pc[RW + c], pv = pc[2 * RW + c];
                float qr = 0.f, qk = 0.f, qv = 0.f; if (!zero) { qr = pp[c]; qk = pp[RW + c]; qv = pp[2 * RW + c]; }
                rr_[nt] = pr + (qr - pr) * mu_r[nt]; kx_[nt] = pk + (qk - pk) * mu_k[nt]; vx_[nt] = pv + (qv - pv) * mu_v[nt];
                const float u = w0[nt] + accW[nt][r];
                const float wlog = -__logf(1.f + __expf(-u)) - 0.5f;
                dec[nt] = __expf(-__expf(wlog));
                aa_[nt] = sigmoidf_(a0[nt] + accA[nt][r]);
                kk_[nt] = kx_[nt] * kkc[nt]; s_kk += kk_[nt] * kk_[nt];
                kp_[nt] = kx_[nt] * (1.f + (aa_[nt] - 1.f) * kac[nt]);
            }
            const float rn = rsqrtf(fmaxf(sum32h(s_kk), 1e-24f));
            float s_br = 0.f, s_kr = 0.f, s_rkr = 0.f; float bb_[2];
#pragma unroll
            for (int nt = 0; nt < 2; ++nt) { kk_[nt] *= rn; bb_[nt] = kk_[nt] * aa_[nt]; s_br += bb_[nt] * rr_[nt]; s_kr += kp_[nt] * rr_[nt]; s_rkr += rr_[nt] * kp_[nt] * rkc[nt]; }
            const float br = sum32h(s_br), kr = sum32h(s_kr), rkr = sum32h(s_rkr);
            float* rec = SCAN + ((size_t)m * 8 + h) * SREC;
#pragma unroll
            for (int nt = 0; nt < 2; ++nt) {
                const int j = 32 * nt + n32, c = 64 * h + j;
                rec[j] = dec[nt]; rec[64 + j] = kk_[nt]; rec[128 + j] = bb_[nt]; rec[192 + j] = kp_[nt]; rec[256 + j] = dec[nt] * rr_[nt];
                *(f32x4*)(rec + 320 + 4 * j) = (f32x4){vx_[nt], vx_[nt] * kr, br, 0.f};
                const float g = accG[nt][r];
                Gb[(size_t)m * RW + c] = g; BG[(size_t)m * RW + c] = rkr * vx_[nt] * g;
            }
        }
    }
}

__device__ __forceinline__ unsigned long long topk_select(const LAS float* vals, int nvis, int lane) {
    const int nreg = (nvis + 63) >> 6;
    unsigned key[64];
#pragma unroll
    for (int g = 0; g < 8; ++g) {
        if (g * 8 < nreg) {
#pragma unroll
            for (int e = 0; e < 8; ++e) { const int i = g * 8 + e; const int kidx = 64 * i + lane;
                unsigned u = 0u;
                if (kidx < nvis) { const float v = vals[kidx]; u = __builtin_bit_cast(unsigned, v); if ((u << 1) == 0u) u = 0u; u = (u & 0x80000000u) ? ~u : (u | 0x80000000u); }
                key[i] = u; }
        } else {
#pragma unroll
            for (int e = 0; e < 8; ++e) key[g * 8 + e] = 0u;
        }
    }
    unsigned long long myword = 0ull;
    const unsigned long long lt = (lane == 0) ? 0ull : (~0ull >> (64 - lane));
    if (nvis <= 256) {
#pragma unroll
        for (int i = 0; i < 4; ++i) { const unsigned long long m = __ballot(64 * i + lane < nvis); if (lane == i) myword = m; }
        return myword;
    }
    unsigned T = 0u;
    for (int bit = 31; bit >= 0; --bit) {
        const unsigned cand = T | (1u << bit); int cnt = 0;
#pragma unroll
        for (int g = 0; g < 8; ++g) if (g * 8 < nreg) {
#pragma unroll
            for (int e = 0; e < 8; ++e) cnt += __popcll(__ballot(key[g * 8 + e] >= cand));
        }
        if (cnt >= 256) T = cand;
    }
    int cgt = 0;
#pragma unroll
    for (int g = 0; g < 8; ++g) if (g * 8 < nreg) {
#pragma unroll
        for (int e = 0; e < 8; ++e) cgt += __popcll(__ballot(key[g * 8 + e] > T));
    }
    const int need = 256 - cgt; int run = 0;
#pragma unroll
    for (int g = 0; g < 8; ++g) if (g * 8 < nreg) {
#pragma unroll
        for (int e = 0; e < 8; ++e) { const int i = g * 8 + e;
            const bool eq = key[i] == T; const unsigned long long em = __ballot(eq);
            const int before = run + __popcll(em & lt);
            const bool s = (key[i] > T) || (eq && before < need); run += __popcll(em);
            const unsigned long long m = __ballot(s); if (lane == i) myword = m; }
    }
    return myword;
}
__device__ __forceinline__ void p3_topk(const Ctx& C, const void* const* in) {
    const float* QI = (const float*)(C.ws + WS_QI); const float* WI = (const float*)(C.ws + WS_WI);
    unsigned long long* MASK = (unsigned long long*)(C.ws + WS_MASK); int* SEL = (int*)(C.ws + WS_SEL);
    const int lane = C.lane, wave = C.wave, hi = lane >> 5;
    constexpr int NU_P = MP / 8, NU = NU_P + BS;
    gu32* qctr = (gu32*)(C.ws + WS_CTL) + CW_Q;
    volatile LAS unsigned* qslot = (volatile LAS unsigned*)(C.lds + MISC_OFF + 64);
    for (;;) {
        __syncthreads();
        if (C.tid == 0) *qslot = __hip_atomic_fetch_add(qctr, 1u, __ATOMIC_RELAXED, __HIP_MEMORY_SCOPE_AGENT);
        __syncthreads();
        const int qu = (int)*qslot;
        if (qu >= NU) break;
        const int unit = (qu < BS) ? NU_P + qu : qu - BS;
        LAS float* selvals; int selnvis, seltgt;
        if (unit < NU_P) {
            LAS float* idx = (LAS float*)C.lds;
            const int b = unit & 3, t0 = (511 - (unit >> 2)) * 8, nkeys = t0 + 8;
            const int rho = lane & 31, q = rho >> 2, hh = rho & 3;
            const float* qrow = QI + ((size_t)(b * TP + t0 + q)) * 256 + hh * 64 + 8 * hi;
            bf16x8 af[4];
#pragma unroll
            for (int s = 0; s < 4; ++s) af[s] = pack_bf8(*(const f32x4*)(qrow + 16 * s), *(const f32x4*)(qrow + 16 * s + 4));
            f32x4 wiv[4];
#pragma unroll
            for (int g = 0; g < 4; ++g) wiv[g] = *(const f32x4*)(WI + ((size_t)(b * TP + t0 + 2 * g + hi)) * 4) * 0.125f;
            const float* KI = C.out + O_KIP + (size_t)b * TP * 64;
            const int ntile = (nkeys + 31) >> 5;
            for (int rr_ = 0; rr_ < (PROBE_PHASE == 30 ? 2 : 1); ++rr_) {
            f32x4 kn[8];
            if (wave < ntile) { const float* kr_ = KI + (size_t)(wave * 32 + rho) * 64 + 8 * hi;
#pragma unroll
                for (int s = 0; s < 4; ++s) { kn[2 * s] = *(const f32x4*)(kr_ + 16 * s); kn[2 * s + 1] = *(const f32x4*)(kr_ + 16 * s + 4); } }
            for (int tile = wave; tile < ntile; tile += 8) {
                const int key = tile * 32 + rho;
                f32x4 kc[8];
#pragma unroll
                for (int s = 0; s < 8; ++s) kc[s] = kn[s];
                if (tile + 8 < ntile) { const float* kr_ = KI + (size_t)(key + 256) * 64 + 8 * hi;
#pragma unroll
                    for (int s = 0; s < 4; ++s) { kn[2 * s] = *(const f32x4*)(kr_ + 16 * s); kn[2 * s + 1] = *(const f32x4*)(kr_ + 16 * s + 4); } }
                f32x16 acc;
#pragma unroll
                for (int r = 0; r < 16; ++r) acc[r] = 0.f;
#pragma unroll
                for (int s = 0; s < 4; ++s) { const bf16x8 bf = pack_bf8(kc[2 * s], kc[2 * s + 1]);
                    acc = __builtin_amdgcn_mfma_f32_32x32x16_bf16(af[s], bf, acc, 0, 0, 0); }
#pragma unroll
                for (int g = 0; g < 4; ++g) {
                    float v = 0.f;
#pragma unroll
                    for (int e = 0; e < 4; ++e) v += wiv[g][e] * fmaxf(acc[4 * g + e], 0.f);
                    idx[(2 * g + hi) * 4096 + key] = v;
                }
            }
            }
            __syncthreads();
            selvals = idx + wave * 4096; selnvis = t0 + wave + 1; seltgt = b * TP + t0 + wave;
        } else {
            const int b = unit - NU_P;
            LAS float* qis = (LAS float*)C.lds;
            LAS float* wis = qis + 1024;
            LAS float* idx = qis + 1280;
            if (C.tid < 256) { const int row = C.tid >> 4, c4 = (C.tid & 15) * 4;
                *(LAS f32x4*)(qis + row * 64 + c4) = *(const f32x4*)(QI + ((size_t)(MP + b * 4 + (row >> 2))) * 256 + (row & 3) * 64 + c4); }
            if (C.tid < 16) wis[C.tid] = WI[((size_t)(MP + b * 4 + (C.tid >> 2))) * 4 + (C.tid & 3)] * 0.125f;
            __syncthreads();
            const int* pt = (const int*)in[5] + b * NPAGES;
            for (int s = C.tid; s < LS; s += NTHR) {
                const float* krow = (s < PAST) ? INF(4) + ((size_t)pt[s >> 7] * 128 + (s & 127)) * 64 : C.out + O_KIS + (size_t)(b * 4 + (s - PAST)) * 64;
                f32x4 kx[16];
#pragma unroll
                for (int i = 0; i < 16; ++i) kx[i] = *(const f32x4*)(krow + 4 * i);
#pragma unroll
                for (int t = 0; t < 4; ++t) {
                    float v = 0.f;
#pragma unroll
                    for (int hh = 0; hh < 4; ++hh) {
                        float d0 = 0.f, d1 = 0.f;
#pragma unroll
                        for (int i = 0; i < 16; i += 2) { const f32x4 qa = *(const LAS f32x4*)(qis + (t * 4 + hh) * 64 + 4 * i), qb = *(const LAS f32x4*)(qis + (t * 4 + hh) * 64 + 4 * i + 4);
                            d0 += kx[i][0] * qa[0] + kx[i][1] * qa[1] + kx[i][2] * qa[2] + kx[i][3] * qa[3];
                            d1 += kx[i + 1][0] * qb[0] + kx[i + 1][1] * qb[1] + kx[i + 1][2] * qb[2] + kx[i + 1][3] * qb[3]; }
                        v += wis[t * 4 + hh] * fmaxf(d0 + d1, 0.f);
                    }
                    idx[t * 2112 + s] = v;
                }
            }
            __syncthreads();
            selvals = idx + (wave & 3) * 2112; selnvis = PAST + (wave & 3) + 1; seltgt = (wave < 4) ? b * 4 + wave : -1;
        }
        if (seltgt >= 0) {
            unsigned long long w = topk_select(selvals, selnvis, lane);
            if (PROBE_PHASE == 31) { asm volatile("" ::: "memory"); w = topk_select(selvals, selnvis, lane); }
            if (unit < NU_P) MASK[(size_t)seltgt * 64 + lane] = w;
            else {
                int cnt = __popcll(w), pre = cnt;
#pragma unroll
                for (int o = 1; o < 64; o <<= 1) { const int x = __shfl_up(pre, o); if (lane >= o) pre += x; }
                int pos = pre - cnt; int* sel = SEL + (size_t)seltgt * 256;
                while (w) { const int bit = __builtin_ctzll(w); if (pos < 256) sel[pos] = 64 * lane + bit; ++pos; w &= w - 1; }
            }
        }
    }
}

struct ScanVec { f32x4 w, kk, b, k, wr, tri; };
__device__ __forceinline__ f32x2 fma2(f32x2 a, f32x2 b, f32x2 c) { return __builtin_elementwise_fma(a, b, c); }
__device__ __forceinline__ float scan_step(f32x2& S01, f32x2& S23, const ScanVec& x) {
    f32x2 q1 = S01 * (f32x2){x.kk[0], x.kk[1]}; q1 = fma2(S23, (f32x2){x.kk[2], x.kk[3]}, q1);
    f32x2 q2 = S01 * (f32x2){x.wr[0], x.wr[1]}; q2 = fma2(S23, (f32x2){x.wr[2], x.wr[3]}, q2);
    float p1 = q1[0] + q1[1], p2 = q2[0] + q2[1];
    const f32x2 vv = (f32x2){x.tri[0], x.tri[0]};
    f32x2 t01 = vv * (f32x2){x.k[0], x.k[1]}; t01 = fma2(S01, (f32x2){x.w[0], x.w[1]}, t01);
    f32x2 t23 = vv * (f32x2){x.k[2], x.k[3]}; t23 = fma2(S23, (f32x2){x.w[2], x.w[3]}, t23);
    p1 = sum16(p1); p2 = sum16(p2);
    const f32x2 nsa = (f32x2){-p1, -p1};
    S01 = fma2(nsa, (f32x2){x.b[0], x.b[1]}, t01); S23 = fma2(nsa, (f32x2){x.b[2], x.b[3]}, t23);
    return p2 - p1 * x.tri[2] + x.tri[1];
}
__device__ __forceinline__ void p4_scan(const Ctx& C, const void* const* in) {
    const float* SCAN = (const float*)(C.ws + WS_SCAN); float* YST = (float*)(C.ws + WS_YS); float* YSS = YST + (size_t)MP * RW;
    const int lane = C.lane, wave = C.wave, rg = lane >> 4, jl = lane & 15;
    {
        const float* st = INF(6);
        for (int u = C.vcu * NWAVES + wave; u < BS * 8 * 16; u += C.G * NWAVES) {
            const int bh = u >> 4, b = bh >> 3, h = bh & 7, i = (u & 15) * 4 + rg;
            const f32x4 s4 = *(const f32x4*)(st + ((size_t)bh * 64 + i) * 64 + 4 * jl);
            f32x2 S01 = (f32x2){s4[0], s4[1]}, S23 = (f32x2){s4[2], s4[3]};
#pragma unroll
            for (int t = 0; t < 4; ++t) {
                const int m = MP + b * 4 + t; const float* rec = SCAN + ((size_t)m * 8 + h) * SREC;
                ScanVec x; x.w = *(const f32x4*)(rec + 4 * jl); x.kk = *(const f32x4*)(rec + 64 + 4 * jl); x.b = *(const f32x4*)(rec + 128 + 4 * jl);
                x.k = *(const f32x4*)(rec + 192 + 4 * jl); x.wr = *(const f32x4*)(rec + 256 + 4 * jl); x.tri = *(const f32x4*)(rec + 320 + 4 * i);
                const float y = scan_step(S01, S23, x);
                if (jl == 0) YSS[(size_t)(b * 4 + t) * RW + h * 64 + i] = y;
            }
            *(f32x4*)(C.out + O_WKVS + ((size_t)bh * 64 + i) * 64 + 4 * jl) = (f32x4){S01[0], S01[1], S23[0], S23[1]};
        }
    }
    __syncthreads();
    constexpr int CH = 16, CHB = CH * SREC * 4;
    for (int unit = C.vcu; unit < 128; unit += C.G) {
        const int bh = unit >> 2, b = bh >> 3, h = bh & 7, i = (unit & 3) * 16 + (wave & 3) * 4 + rg;
        const float* base = SCAN + ((size_t)(b * TP) * 8 + h) * SREC;
        const int ltid = C.tid - 256;
        const unsigned lv = (unsigned)jl * 16u, lt = 1280u + (unsigned)i * 16u;
#define SC_BAR() do { asm volatile("" ::: "memory"); __builtin_amdgcn_s_barrier(); asm volatile("" ::: "memory"); } while (0)
        if (wave >= 4) {
            unsigned goff[9];
#pragma unroll
            for (int k_ = 0; k_ < 9; ++k_) { const unsigned q_ = (unsigned)ltid + 256u * k_; const unsigned s_ = q_ / 144u, off_ = q_ - s_ * 144u; goff[k_] = s_ * (8u * SREC * 4u) + off_ * 16u; }
            f32x4 sA[9], sB[9], sC[9];
#define SC_GLOAD(ST, c_) do { const char* cbase_ = (const char*)(base + (size_t)(c_) * CH * 8 * SREC); _Pragma("unroll") for (int k_ = 0; k_ < 9; ++k_) ST[k_] = *(const f32x4*)(cbase_ + goff[k_]); } while (0)
#define SC_LSTORE(ST, boff_) do { _Pragma("unroll") for (int k_ = 0; k_ < 9; ++k_) *(LAS f32x4*)(C.lds + (boff_) + (ltid + 256 * k_) * 16) = ST[k_]; } while (0)
            SC_GLOAD(sA, 0); SC_GLOAD(sB, 1); SC_LSTORE(sA, 0); SC_LSTORE(sB, CHB);
            SC_GLOAD(sA, 2); SC_GLOAD(sB, 3); SC_GLOAD(sC, 4);
            asm volatile("s_waitcnt lgkmcnt(0)" ::: "memory"); SC_BAR();
            int b2 = 2 * CHB;
#define SC_LSUB(ST, c_) do { if ((c_) < TP / CH) { if ((c_) + 2 < TP / CH) SC_LSTORE(ST, b2); if ((c_) + 5 < TP / CH) SC_GLOAD(ST, (c_) + 5); \
                b2 = (b2 == 2 * CHB) ? 0 : b2 + CHB; asm volatile("s_waitcnt lgkmcnt(0)" ::: "memory"); SC_BAR(); } } while (0)
            for (int ch = 0; ch < TP / CH; ch += 3) { SC_LSUB(sA, ch); SC_LSUB(sB, ch + 1); SC_LSUB(sC, ch + 2); }
#undef SC_LSUB
#undef SC_GLOAD
#undef SC_LSTORE
        } else {
            SC_BAR();
            f32x2 S01 = (f32x2){0.f, 0.f}, S23 = (f32x2){0.f, 0.f};
            float* yrow = YST + ((size_t)bh * 64 + i) * TP + jl;
#define SC_LD(X, bufb, s_) do { const LAS unsigned char* r_ = C.lds + (bufb) + (s_) * (SREC * 4); \
            X.w = *(const LAS f32x4*)(r_ + lv); X.kk = *(const LAS f32x4*)(r_ + 256 + lv); X.b = *(const LAS f32x4*)(r_ + 512 + lv); \
            X.k = *(const LAS f32x4*)(r_ + 768 + lv); X.wr = *(const LAS f32x4*)(r_ + 1024 + lv); X.tri = *(const LAS f32x4*)(r_ + lt); } while (0)
            ScanVec xa, xb;
            SC_LD(xa, 0, 0);
            int cb = 0, nb = CHB;
            for (int ch = 0; ch < TP / CH; ++ch) {
                float ykeep = 0.f;
#define SC_STEP(XC, XN, s_) do { if ((s_) + 1 < CH) SC_LD(XN, cb, (s_) + 1); else if (ch + 1 < TP / CH) SC_LD(XN, nb, 0); \
                    __builtin_amdgcn_sched_barrier(0); \
                    { const float y_ = scan_step(S01, S23, XC); ykeep = (jl == (s_)) ? y_ : ykeep; asm volatile("" :: "v"(XC.tri[3])); } \
                    __builtin_amdgcn_sched_barrier(0); } while (0)
                SC_STEP(xa, xb, 0); SC_STEP(xb, xa, 1); SC_STEP(xa, xb, 2); SC_STEP(xb, xa, 3);
                SC_STEP(xa, xb, 4); SC_STEP(xb, xa, 5); SC_STEP(xa, xb, 6); SC_STEP(xb, xa, 7);
                SC_STEP(xa, xb, 8); SC_STEP(xb, xa, 9); SC_STEP(xa, xb, 10); SC_STEP(xb, xa, 11);
                SC_STEP(xa, xb, 12); SC_STEP(xb, xa, 13); SC_STEP(xa, xb, 14); SC_STEP(xb, xa, 15);
                yrow[ch * CH] = ykeep;
                cb = nb; nb = (nb == 2 * CHB) ? 0 : nb + CHB;
                SC_BAR();
            }
#undef SC_STEP
#undef SC_LD
            *(f32x4*)(C.out + O_WKVP + ((size_t)bh * 64 + i) * 64 + 4 * jl) = (f32x4){S01[0], S01[1], S23[0], S23[1]};
        }
#undef SC_BAR
        __syncthreads();
    }
}
__device__ __forceinline__ float wave_sum_fast(float x) { x = sum16(x); x += __shfl_xor(x, 16); x += __shfl_xor(x, 32); return x; }
__device__ __forceinline__ void p5_post(const Ctx& C, const void* const* in) {
    const float* YST = (const float*)(C.ws + WS_YS); const float* YSS = YST + (size_t)MP * RW;
    const float* Gb = (const float*)(C.ws + WS_G); const float* BG = (const float*)(C.ws + WS_BG); bf16* MIX = (bf16*)(C.ws + WS_MIX);
    const int c = C.tid, h = C.wave, j = C.lane;
    const float gg = INF(20)[c], gb = INF(21)[c];
    for (int u = C.vcu; u < MT / 16; u += C.G) {
        const int m0 = u * 16;
        float yv[16];
        if (m0 < MP) { const int b = m0 >> 12, t0 = m0 & (TP - 1); const float* yp = YST + ((size_t)(b * 8 + h) * 64 + j) * TP + t0;
#pragma unroll
            for (int q = 0; q < 4; ++q) { const f32x4 v = *(const f32x4*)(yp + 4 * q); yv[4 * q] = v[0]; yv[4 * q + 1] = v[1]; yv[4 * q + 2] = v[2]; yv[4 * q + 3] = v[3]; }
        } else {
#pragma unroll
            for (int t = 0; t < 16; ++t) yv[t] = YSS[(size_t)(m0 - MP + t) * RW + c];
        }
#pragma unroll
        for (int t = 0; t < 16; ++t) {
            const int m = m0 + t; const float y = yv[t];
            const float mu = wave_sum_fast(y) * (1.f / 64.f); const float d = y - mu; const float var = wave_sum_fast(d * d) * (1.f / 64.f);
            const float yn = d * rsqrtf(var + GN_EPS) * gg + gb;
            const float o = yn * Gb[(size_t)m * RW + c] + BG[(size_t)m * RW + c];
            MIX[(size_t)m * DM + c] = (bf16)f2bf(o);
        }
    }
}
__device__ __forceinline__ int t5_bucket(int d) {
    if (d < 16) return d;
    int b = 16;
    b += (d >= 19); b += (d >= 21); b += (d >= 24); b += (d >= 27); b += (d >= 31); b += (d >= 35); b += (d >= 40); b += (d >= 46);
    b += (d >= 52); b += (d >= 59); b += (d >= 67); b += (d >= 77); b += (d >= 87); b += (d >= 99); b += (d >= 113);
    return b;
}
constexpr int KROW = 72, VROW = 68;
constexpr int ATT_KB = 64 * KROW * 2, ATT_VB = 64 * VROW * 2;
__device__ __forceinline__ void attn_prompt_unit(const Ctx& C, int b, int h, int qb, const LAS float* btab) {
    const bf16* QB = (const bf16*)(C.ws + WS_QB); const bf16* KB = (const bf16*)(C.ws + WS_KB); const bf16* VB = (const bf16*)(C.ws + WS_VB);
    const unsigned long long* MASK = (const unsigned long long*)(C.ws + WS_MASK); bf16* MIX = (bf16*)(C.ws + WS_MIX);
    LAS unsigned char* kbuf = C.lds; LAS unsigned char* vbuf = C.lds + 2 * ATT_KB;
    const int lane = C.lane, wave = C.wave, r32 = lane & 31, hi = lane >> 5;
    const int q0 = qb * 256, qw0 = q0 + wave * 32, q = qw0 + r32;
    const size_t rowb = (size_t)b * TP;
    const int NT = (q0 + 256) / 64;
    bf16x8 qf[4];
#pragma unroll
    for (int s = 0; s < 4; ++s) qf[s] = *(const bf16x8*)(QB + (rowb + q) * RW + h * 64 + 16 * s + 8 * hi);
    const unsigned long long* mrow = MASK + (rowb + q) * 64;
    const int srow = C.tid >> 3, sch = C.tid & 7;
    const bf16* kg = KB + (rowb + srow) * RW + h * 64 + sch * 8; const bf16* vg = VB + (rowb + srow) * RW + h * 64 + sch * 8;
    v4u kst, vst;
#define ATT_GLOAD(t) do { kst = *(const v4u*)(kg + (size_t)(t) * 64 * RW); vst = *(const v4u*)(vg + (size_t)(t) * 64 * RW); } while (0)
#define ATT_LSTORE(bi) do { *(LAS v4u*)(kbuf + (bi) * ATT_KB + srow * (KROW * 2) + sch * 16) = kst; \
        LAS unsigned short* vt_ = (LAS unsigned short*)(vbuf + (bi) * ATT_VB) + (sch * 8) * VROW + srow; \
        vt_[0 * VROW] = (unsigned short)(vst.x & 0xffffu); vt_[1 * VROW] = (unsigned short)(vst.x >> 16); vt_[2 * VROW] = (unsigned short)(vst.y & 0xffffu); vt_[3 * VROW] = (unsigned short)(vst.y >> 16); \
        vt_[4 * VROW] = (unsigned short)(vst.z & 0xffffu); vt_[5 * VROW] = (unsigned short)(vst.z >> 16); vt_[6 * VROW] = (unsigned short)(vst.w & 0xffffu); vt_[7 * VROW] = (unsigned short)(vst.w >> 16); } while (0)
    __syncthreads();
    ATT_GLOAD(0); ATT_LSTORE(0);
    __syncthreads();
    f32x16 o0, o1;
#pragma unroll
    for (int r = 0; r < 16; ++r) { o0[r] = 0.f; o1[r] = 0.f; }
    float mrun = -1e30f, lrun = 0.f;
    unsigned long long mw = mrow[0];
    for (int t = 0; t < NT; ++t) {
        const int bi = t & 1;
        if (t + 1 < NT) ATT_GLOAD(t + 1);
        const unsigned long long mcur = mw; if (t + 1 < NT) mw = mrow[t + 1];
        const int kv0 = t * 64;
        if (kv0 <= qw0 + 31) {
            f32x16 p0, p1;
#pragma unroll
            for (int r = 0; r < 16; ++r) { p0[r] = 0.f; p1[r] = 0.f; }
            const LAS unsigned char* kb0 = kbuf + bi * ATT_KB + r32 * (KROW * 2) + hi * 16;
#pragma unroll
            for (int s = 0; s < 4; ++s) {
                const bf16x8 ka = *(const LAS bf16x8*)(kb0 + s * 32), kb2 = *(const LAS bf16x8*)(kb0 + 32 * (KROW * 2) + s * 32);
                p0 = __builtin_amdgcn_mfma_f32_32x32x16_bf16(ka, qf[s], p0, 0, 0, 0);
                p1 = __builtin_amdgcn_mfma_f32_32x32x16_bf16(kb2, qf[s], p1, 0, 0, 0);
            }
            if (kv0 + 63 + 113 > qw0) {
#pragma unroll
                for (int r = 0; r < 16; ++r) { const int kv = kv0 + (r & 3) + 8 * (r >> 2) + 4 * hi;
                    int d0 = q - kv; d0 = d0 < 0 ? 0 : (d0 > 127 ? 127 : d0); int d1 = q - kv - 32; d1 = d1 < 0 ? 0 : (d1 > 127 ? 127 : d1);
                    p0[r] += btab[h * 128 + d0]; p1[r] += btab[h * 128 + d1]; }
            }
            float mx = p0[0];
#pragma unroll
            for (int r = 1; r < 16; ++r) mx = fmaxf(mx, p0[r]);
#pragma unroll
            for (int r = 0; r < 16; ++r) mx = fmaxf(mx, p1[r]);
            mx = fmaxf(mx, __shfl_xor(mx, 32));
            const float mnew = fmaxf(mrun, mx);
            const float alpha = __builtin_amdgcn_exp2f(mrun - mnew);
            mrun = mnew;
            const unsigned wlo = (unsigned)mcur >> (4 * hi), whi = (unsigned)(mcur >> 32) >> (4 * hi);
            float ls = 0.f;
#pragma unroll
            for (int r = 0; r < 16; ++r) { const int pos = (r & 3) + 8 * (r >> 2);
                const int m0 = __builtin_amdgcn_sbfe(wlo, pos, 1), m1 = __builtin_amdgcn_sbfe(whi, pos, 1);
                const float e0 = __builtin_amdgcn_exp2f(p0[r] - mnew), e1 = __builtin_amdgcn_exp2f(p1[r] - mnew);
                p0[r] = __builtin_bit_cast(float, __builtin_bit_cast(int, e0) & m0); p1[r] = __builtin_bit_cast(float, __builtin_bit_cast(int, e1) & m1);
                ls += p0[r] + p1[r]; }
            lrun = lrun * alpha + ls;
            if (__any(alpha != 1.f)) {
#pragma unroll
                for (int r = 0; r < 16; ++r) { o0[r] *= alpha; o1[r] *= alpha; }
            }
            const LAS unsigned char* vb0 = vbuf + bi * ATT_VB + r32 * (VROW * 2) + hi * 8;
#pragma unroll
            for (int jj = 0; jj < 4; ++jj) {
                f32x4 pa, pb;
                if (jj == 0) { pa = (f32x4){p0[0], p0[1], p0[2], p0[3]}; pb = (f32x4){p0[4], p0[5], p0[6], p0[7]}; }
                else if (jj == 1) { pa = (f32x4){p0[8], p0[9], p0[10], p0[11]}; pb = (f32x4){p0[12], p0[13], p0[14], p0[15]}; }
                else if (jj == 2) { pa = (f32x4){p1[0], p1[1], p1[2], p1[3]}; pb = (f32x4){p1[4], p1[5], p1[6], p1[7]}; }
                else { pa = (f32x4){p1[8], p1[9], p1[10], p1[11]}; pb = (f32x4){p1[12], p1[13], p1[14], p1[15]}; }
                const bf16x8 pf = pack_bf8(pa, pb);
                typedef unsigned u32x2 __attribute__((ext_vector_type(2)));
                const u32x2 a0 = *(const LAS u32x2*)(vb0 + jj * 32), a1 = *(const LAS u32x2*)(vb0 + jj * 32 + 16);
                const u32x2 c0 = *(const LAS u32x2*)(vb0 + 32 * (VROW * 2) + jj * 32), c1 = *(const LAS u32x2*)(vb0 + 32 * (VROW * 2) + jj * 32 + 16);
                const bf16x8 va = __builtin_bit_cast(bf16x8, (v4u){a0.x, a0.y, a1.x, a1.y}), vc = __builtin_bit_cast(bf16x8, (v4u){c0.x, c0.y, c1.x, c1.y});
                o0 = __builtin_amdgcn_mfma_f32_32x32x16_bf16(va, pf, o0, 0, 0, 0);
                o1 = __builtin_amdgcn_mfma_f32_32x32x16_bf16(vc, pf, o1, 0, 0, 0);
            }
        }
        if (t + 1 < NT) ATT_LSTORE(bi ^ 1);
        __syncthreads();
    }
#undef ATT_GLOAD
#undef ATT_LSTORE
    const float ltot = lrun + __shfl_xor(lrun, 32);
    const float inv = 1.f / ltot;
    bf16* orow = MIX + (rowb + q) * DM + RW + h * 64;
#pragma unroll
    for (int g = 0; g < 4; ++g) {
        const int d = 8 * g + 4 * hi;
        typedef unsigned u32x2 __attribute__((ext_vector_type(2)));
        u32x2 w0, w1;
        w0.x = pk2(o0[4 * g] * inv, o0[4 * g + 1] * inv); w0.y = pk2(o0[4 * g + 2] * inv, o0[4 * g + 3] * inv);
        w1.x = pk2(o1[4 * g] * inv, o1[4 * g + 1] * inv); w1.y = pk2(o1[4 * g + 2] * inv, o1[4 * g + 3] * inv);
        *(u32x2*)(orow + d) = w0; *(u32x2*)(orow + 32 + d) = w1;
    }
}
__device__ __forceinline__ void attn_sample_pair(const Ctx& C, const void* const* in, int pair, const LAS float* btab, LAS float* comb) {
    const bf16* QB = (const bf16*)(C.ws + WS_QB); const int* SEL = (const int*)(C.ws + WS_SEL); bf16* MIX = (bf16*)(C.ws + WS_MIX);
    const int lane = C.lane, hh = lane >> 3, ch = lane & 7, wq = C.wave >> 2, part = C.wave & 3;
    const int qi_ = pair * 2 + wq, b = qi_ >> 2, t = qi_ & 3, m = MP + qi_, qpos = PAST + t;
    float qv[8];
    { const v4u qq = *(const v4u*)(QB + (size_t)m * RW + hh * 64 + ch * 8);
      qv[0] = bf2f(qq.x & 0xffffu); qv[1] = bf2f(qq.x >> 16); qv[2] = bf2f(qq.y & 0xffffu); qv[3] = bf2f(qq.y >> 16);
      qv[4] = bf2f(qq.z & 0xffffu); qv[5] = bf2f(qq.z >> 16); qv[6] = bf2f(qq.w & 0xffffu); qv[7] = bf2f(qq.w >> 16); }
    const int* pt = (const int*)in[5] + b * NPAGES;
    const int* sel = SEL + (size_t)qi_ * 256 + part * 64;
    const float* ck = INF(2); const float* cv = INF(3);
    float acc[8] = {0.f, 0.f, 0.f, 0.f, 0.f, 0.f, 0.f, 0.f}; float mrun = -1e30f, lrun = 0.f;
    for (int j0 = 0; j0 < 64; j0 += 8) {
        f32x4 k0[8], k1[8], v0[8], v1[8]; float bias[8];
#pragma unroll
        for (int u = 0; u < 8; ++u) {
            const int s = sel[j0 + u];
            const float *kr, *vr;
            if (s < PAST) { const size_t row = (size_t)pt[s >> 7] * 128 + (s & 127); kr = ck + row * RW; vr = cv + row * RW; }
            else { const size_t row = (size_t)(b * 4 + (s - PAST)); kr = C.out + O_KS + row * RW; vr = C.out + O_VS + row * RW; }
            kr += hh * 64 + ch * 8; vr += hh * 64 + ch * 8;
            k0[u] = *(const f32x4*)kr; k1[u] = *(const f32x4*)(kr + 4); v0[u] = *(const f32x4*)vr; v1[u] = *(const f32x4*)(vr + 4);
            int d = qpos - s; d = d < 0 ? 0 : (d > 127 ? 127 : d); bias[u] = btab[1024 + hh * 128 + d];
        }
#pragma unroll
        for (int u = 0; u < 8; ++u) {
            float p = qv[0] * k0[u][0] + qv[1] * k0[u][1] + qv[2] * k0[u][2] + qv[3] * k0[u][3] + qv[4] * k1[u][0] + qv[5] * k1[u][1] + qv[6] * k1[u][2] + qv[7] * k1[u][3];
            p = sum8(p) + bias[u];
            const float mnew = fmaxf(mrun, p); const float alpha = __builtin_amdgcn_exp2f(mrun - mnew), e = __builtin_amdgcn_exp2f(p - mnew);
            mrun = mnew; lrun = lrun * alpha + e;
            acc[0] = acc[0] * alpha + e * v0[u][0]; acc[1] = acc[1] * alpha + e * v0[u][1]; acc[2] = acc[2] * alpha + e * v0[u][2]; acc[3] = acc[3] * alpha + e * v0[u][3];
            acc[4] = acc[4] * alpha + e * v1[u][0]; acc[5] = acc[5] * alpha + e * v1[u][1]; acc[6] = acc[6] * alpha + e * v1[u][2]; acc[7] = acc[7] * alpha + e * v1[u][3];
        }
    }
    LAS float* cw = comb + ((wq * 4 + part) * 64 + lane) * 12;
    *(LAS f32x4*)cw = (f32x4){acc[0], acc[1], acc[2], acc[3]}; *(LAS f32x4*)(cw + 4) = (f32x4){acc[4], acc[5], acc[6], acc[7]}; *(LAS f32x2*)(cw + 8) = (f32x2){mrun, lrun};
    __syncthreads();
    if (part == 0) {
        float M = mrun;
#pragma unroll
        for (int p = 1; p < 4; ++p) M = fmaxf(M, comb[((wq * 4 + p) * 64 + lane) * 12 + 8]);
        float f = __builtin_amdgcn_exp2f(mrun - M), L = lrun * f;
#pragma unroll
        for (int e = 0; e < 8; ++e) acc[e] *= f;
#pragma unroll
        for (int p = 1; p < 4; ++p) { const LAS float* cp = comb + ((wq * 4 + p) * 64 + lane) * 12; const f32x4 a0 = *(const LAS f32x4*)cp, a1 = *(const LAS f32x4*)(cp + 4); const f32x2 ml = *(const LAS f32x2*)(cp + 8);
            const float fp = __builtin_amdgcn_exp2f(ml[0] - M); L += ml[1] * fp;
            acc[0] += a0[0] * fp; acc[1] += a0[1] * fp; acc[2] += a0[2] * fp; acc[3] += a0[3] * fp; acc[4] += a1[0] * fp; acc[5] += a1[1] * fp; acc[6] += a1[2] * fp; acc[7] += a1[3] * fp; }
        const float inv = 1.f / L;
        v4u w; w.x = pk2(acc[0] * inv, acc[1] * inv); w.y = pk2(acc[2] * inv, acc[3] * inv); w.z = pk2(acc[4] * inv, acc[5] * inv); w.w = pk2(acc[6] * inv, acc[7] * inv);
        *(v4u*)(MIX + (size_t)m * DM + RW + hh * 64 + ch * 8) = w;
    }
    __syncthreads();
}
__device__ __forceinline__ void p5_attn(const Ctx& C, const void* const* in, int rep_s, int rep_p) {
    LAS float* btab = (LAS float*)(C.lds + 2 * ATT_KB + 2 * ATT_VB);
    const float* rb = INF(9);
    for (int i = C.tid; i < 1024; i += NTHR) { const int hh = i >> 7, d = i & 127; const float bv = rb[t5_bucket(d) * 8 + hh];
        btab[i] = (bv - rb[31 * 8 + hh]) * LOG2E; btab[1024 + i] = bv * LOG2E; }
    __syncthreads();
    for (int rr = 0; rr < rep_s; ++rr) for (int pr = C.vcu; pr < MS / 2; pr += C.G) attn_sample_pair(C, in, pr, btab, btab + 2048);
    for (int rr = 0; rr < rep_p; ++rr) for (int u = C.vcu; u < 512; u += C.G) {
        const int bh = (u & 255) >> 3, s = u & 7, qb = (u < 256) ? s : 15 - s;
        attn_prompt_unit(C, bh >> 3, bh & 7, qb, btab);
    }
}

__device__ __forceinline__ void ln_rows(const Ctx& C, const float* Z, const float* g, const float* bt, float* outP, float* outS, bf16* ob) {
    const int gw = C.vcu * NWAVES + C.wave, NGW = C.G * NWAVES;
    f32x4 gv[4], bv[4];
#pragma unroll
    for (int j = 0; j < 4; ++j) { gv[j] = *((const f32x4*)g + C.lane + 64 * j); bv[j] = *((const f32x4*)bt + C.lane + 64 * j); }
    for (int m = gw; m < MT; m += NGW) {
        const f32x4* zr = (const f32x4*)(Z + (size_t)m * DM) + C.lane;
        f32x4 v[4]; float s = 0.f;
#pragma unroll
        for (int j = 0; j < 4; ++j) { v[j] = zr[64 * j]; s += (v[j].x + v[j].y) + (v[j].z + v[j].w); }
        const float mean = wave_sum(s) * (1.f / DM); float s2 = 0.f;
#pragma unroll
        for (int j = 0; j < 4; ++j) { v[j] = v[j] - mean; s2 += (v[j].x * v[j].x + v[j].y * v[j].y) + (v[j].z * v[j].z + v[j].w * v[j].w); }
        const float rstd = rsqrtf(wave_sum(s2) * (1.f / DM) + LN_EPS);
        float* orow = (m < MP) ? outP + (size_t)m * DM : outS + (size_t)(m - MP) * DM;
#pragma unroll
        for (int j = 0; j < 4; ++j) { const f32x4 o = v[j] * rstd * gv[j] + bv[j]; *((f32x4*)orow + C.lane + 64 * j) = o;
            if (ob) *((unsigned long long*)(ob + (size_t)m * DM) + C.lane + 64 * j) = (unsigned long long)pk2(o.x, o.y) | ((unsigned long long)pk2(o.z, o.w) << 32); }
    }
}

__device__ __forceinline__ void p9_conv(const Ctx& C, const void* const* in) {
    const bf16* UC = (const bf16*)(C.ws + WS_UC); const bf16* UL = (const bf16*)(C.ws + WS_UL); bf16* H = (bf16*)(C.ws + WS_H);
    const float* cw = INF(26); const float* cb = INF(27); const float* cst = INF(8);
    constexpr int CPR = FF / 8;
    const long total = (long)MT * CPR;
    for (long it = (long)C.vcu * NTHR + C.tid; it < total; it += (long)C.G * NTHR) {
        const int m = (int)(it / CPR), c = (int)(it - (long)m * CPR) * 8;
        int t; const float* prev = nullptr;
        if (m < MP) t = m & (TP - 1); else { const int ms = m - MP; t = ms & 3; prev = cst + (size_t)(ms >> 2) * 2 * FF; }
        float u0[8], u1[8], u2[8], ul[8];
        { const v4u a = *(const v4u*)(UC + (size_t)m * FF + c); const v4u l = *(const v4u*)(UL + (size_t)m * FF + c);
          u2[0] = bf2f(a.x & 0xffffu); u2[1] = bf2f(a.x >> 16); u2[2] = bf2f(a.y & 0xffffu); u2[3] = bf2f(a.y >> 16); u2[4] = bf2f(a.z & 0xffffu); u2[5] = bf2f(a.z >> 16); u2[6] = bf2f(a.w & 0xffffu); u2[7] = bf2f(a.w >> 16);
          ul[0] = bf2f(l.x & 0xffffu); ul[1] = bf2f(l.x >> 16); ul[2] = bf2f(l.y & 0xffffu); ul[3] = bf2f(l.y >> 16); ul[4] = bf2f(l.z & 0xffffu); ul[5] = bf2f(l.z >> 16); ul[6] = bf2f(l.w & 0xffffu); ul[7] = bf2f(l.w >> 16); }
        if (t >= 1) { const v4u a = *(const v4u*)(UC + (size_t)(m - 1) * FF + c);
          u1[0] = bf2f(a.x & 0xffffu); u1[1] = bf2f(a.x >> 16); u1[2] = bf2f(a.y & 0xffffu); u1[3] = bf2f(a.y >> 16); u1[4] = bf2f(a.z & 0xffffu); u1[5] = bf2f(a.z >> 16); u1[6] = bf2f(a.w & 0xffffu); u1[7] = bf2f(a.w >> 16); }
        else { for (int e = 0; e < 8; ++e) u1[e] = prev ? prev[FF + c + e] : 0.f; }
        if (t >= 2) { const v4u a = *(const v4u*)(UC + (size_t)(m - 2) * FF + c);
          u0[0] = bf2f(a.x & 0xffffu); u0[1] = bf2f(a.x >> 16); u0[2] = bf2f(a.y & 0xffffu); u0[3] = bf2f(a.y >> 16); u0[4] = bf2f(a.z & 0xffffu); u0[5] = bf2f(a.z >> 16); u0[6] = bf2f(a.w & 0xffffu); u0[7] = bf2f(a.w >> 16); }
        else { for (int e = 0; e < 8; ++e) u0[e] = prev ? prev[t * FF + c + e] : 0.f; }
        float hv[8];
#pragma unroll
        for (int e = 0; e < 8; ++e) { const float cv = u0[e] * cw[c + e] + u1[e] * cw[FF + c + e] + u2[e] * cw[2 * FF + c + e] + cb[c + e];
            hv[e] = cv / (1.f + __expf(-cv)) * ul[e]; }
        v4u w; w.x = pk2(hv[0], hv[1]); w.y = pk2(hv[2], hv[3]); w.z = pk2(hv[4], hv[5]); w.w = pk2(hv[6], hv[7]);
        *(v4u*)(H + (size_t)m * FF + c) = w;
    }
}

#ifndef PROBE_PHASE
#define PROBE_PHASE -1
#endif
struct Args { const void* in[31]; float* out; unsigned char* ws; int ph_lo, ph_hi; };
__global__ void __launch_bounds__(NTHR, 2) fwd_kernel(Args args) {
    extern __shared__ __attribute__((aligned(16))) unsigned char lds_raw[];
    Ctx C;
    C.lds = (LAS unsigned char*)lds_raw; C.tid = threadIdx.x; C.lane = C.tid & 63; C.wave = __builtin_amdgcn_readfirstlane(C.tid >> 6);
    C.G = gridDim.x; { const int bx = blockIdx.x; C.vcu = (C.G % 8 == 0) ? (bx % 8) * (C.G / 8) + bx / 8 : bx; }
    C.out = args.out; C.ws = args.ws;
    const void* const* in = args.in;
    volatile LAS unsigned* MISC = (volatile LAS unsigned*)(C.lds + MISC_OFF);
    for (int u = C.tid; u < (LDS_BYTES - LDSCTL_OFF) / 4; u += NTHR) ((LAS unsigned*)(C.lds + LDSCTL_OFF))[u] = 0u;
    __syncthreads();
    const int lo = args.ph_lo, hi = args.ph_hi;
    const bool multi = (hi - lo) > 1;
    XcdBarrier bar; bar.bar = (unsigned*)(C.ws + WS_CTL) + CW_BAR; bar.x = 0; bar.st = nullptr;
    if (multi) bar = xcd_barrier_post((unsigned*)(C.ws + WS_CTL) + CW_BAR, MISC + 8);
#define IN(k) (lo <= (k) && (k) < hi)
#define SEAM(k) do { if (IN(k) && IN((k) + 1)) xcd_barrier(bar); } while (0)
    bf16* XB = (bf16*)(C.ws + WS_XB); bf16* MIX = (bf16*)(C.ws + WS_MIX); bf16* X1B = (bf16*)(C.ws + WS_X1B); bf16* HB = (bf16*)(C.ws + WS_H);
    float* Z = (float*)(C.ws + WS_Z); float* X1 = (float*)(C.ws + WS_X1);

#define RUN0 do { p0_prologue(C, in); } while (0)
#define RUN1 do { pg8::Gemm g{XB, (const bf16*)(C.ws + WS_WIN), MT, NINP, DM}; pg8::StaticOrder S; S.init(MT, NINP, C.G, (int)blockIdx.x); \
        pg8::EpiIn E{(float*)(C.ws + WS_PRW), (bf16*)(C.ws + WS_QB), (bf16*)(C.ws + WS_KB), (bf16*)(C.ws + WS_VB), (float*)(C.ws + WS_QI), (float*)(C.ws + WS_WI), C.out}; \
        pg8::gemm_phase<pg8::EpiIn, pg8::StaticOrder, true, true>(C.lds, g, S, E); } while (0)
#define RUN2 do { p2_prep(C, in); } while (0)
#define RUN3 do { p4_scan(C, in); p3_topk(C, in); } while (0)
#define RUN4 do { } while (0)
#define RUN5 do { p5_post(C, in); if (PROBE_PHASE == 50) { __syncthreads(); p5_post(C, in); } p5_attn(C, in, PROBE_PHASE == 51 ? 2 : 1, PROBE_PHASE == 52 ? 2 : 1); } while (0)
#define RUN6 do { pg8::Gemm g{MIX, (const bf16*)(C.ws + WS_WOUT), MT, DM, DM}; pg8::StaticOrder S; S.init(MT, DM, C.G, (int)blockIdx.x); \
        pg8::EpiRes E{INF(0), INF(1), Z}; pg8::gemm_phase<pg8::EpiRes, pg8::StaticOrder, true, true>(C.lds, g, S, E); } while (0)
#define RUN7 do { ln_rows(C, Z, INF(23), INF(24), X1, X1 + (size_t)MP * DM, X1B); } while (0)
#define RUN8 do { pg8::Gemm g{X1B, (const bf16*)(C.ws + WS_WUP), MT, NUP, DM}; pg8::StaticOrder S; S.init(MT, NUP, C.G, (int)blockIdx.x); \
        pg8::EpiUp E{(bf16*)(C.ws + WS_UC), (bf16*)(C.ws + WS_UL), C.out}; pg8::gemm_phase<pg8::EpiUp, pg8::StaticOrder, true, true>(C.lds, g, S, E); } while (0)
#define RUN9 do { p9_conv(C, in); } while (0)
#define RUN10 do { pg8::Gemm g{HB, (const bf16*)(C.ws + WS_WDN), MT, DM, FF}; pg8::StaticOrder S; S.init(MT, DM, C.G, (int)blockIdx.x); \
        pg8::EpiRes E{X1, X1 + (size_t)MP * DM, Z}; pg8::gemm_phase<pg8::EpiRes, pg8::StaticOrder, true, true>(C.lds, g, S, E); } while (0)
#define RUN11 do { ln_rows(C, Z, INF(29), INF(30), C.out + O_YP, C.out + O_YS, nullptr); } while (0)
#define PHASE(k, RUN) do { if (IN(k)) { RUN; if (PROBE_PHASE == (k)) { __syncthreads(); xcd_barrier(bar); RUN; } } SEAM(k); } while (0)
    PHASE(0, RUN0); PHASE(1, RUN1); PHASE(2, RUN2); PHASE(3, RUN3); PHASE(4, RUN4); PHASE(5, RUN5);
    PHASE(6, RUN6); PHASE(7, RUN7); PHASE(8, RUN8); PHASE(9, RUN9); PHASE(10, RUN10); PHASE(11, RUN11);
#undef IN
#undef SEAM
}

#ifndef N_LAUNCH_MODE
#define N_LAUNCH_MODE 1
#endif
extern "C" void kernel_launch(void* const* d_in, const int* in_sizes, int n_in, void* d_out, int out_size, void* d_ws, size_t ws_size, hipStream_t stream) {
    static int grid = 0;
    if (grid == 0) {
        if (n_in != 31 || out_size != (int)O_END || ws_size < WS_END) { fprintf(stderr, "kernel_launch: unexpected shapes (n_in %d, out %d, ws %zu)\n", n_in, out_size, ws_size); grid = -1; return; }
        int dev = 0, cus = 0, per_cu = 0;
        if (hipGetDevice(&dev) != hipSuccess || hipDeviceGetAttribute(&cus, hipDeviceAttributeMultiprocessorCount, dev) != hipSuccess) { grid = -1; return; }
        if (hipFuncSetAttribute((const void*)fwd_kernel, hipFuncAttributeMaxDynamicSharedMemorySize, LDS_BYTES) != hipSuccess) { fprintf(stderr, "kernel_launch: hipFuncSetAttribute failed\n"); grid = -1; return; }
        if (hipOccupancyMaxActiveBlocksPerMultiprocessor(&per_cu, (const void*)fwd_kernel, NTHR, LDS_BYTES) != hipSuccess || per_cu < 1) fprintf(stderr, "kernel_launch: occupancy query says %d\n", per_cu);
        (void)hipGetLastError();
        grid = cus;
    }
    if (grid < 0) return;
    (void)hipMemsetAsync((char*)d_ws + WS_CTL, 0, CTL_ZERO_BYTES, stream);
    Args a{};
    for (int i = 0; i < 31; ++i) a.in[i] = d_in[i];
    a.out = (float*)d_out; a.ws = (unsigned char*)d_ws;
#if N_LAUNCH_MODE == 1
    a.ph_lo = 0; a.ph_hi = NPHASE;
    hipLaunchKernelGGL(fwd_kernel, dim3(grid), dim3(NTHR), LDS_BYTES, stream, a);
#else
    for (int p = 0; p < NPHASE; ++p) { a.ph_lo = p; a.ph_hi = p + 1; hipLaunchKernelGGL(fwd_kernel, dim3(grid), dim3(NTHR), LDS_BYTES, stream, a); }
#endif
    const hipError_t le = hipPeekAtLastError();
    if (le != hipSuccess) fprintf(stderr, "kernel_launch: launch failed: %s\n", hipGetErrorName(le));
}
```

```cpp
#include <hip/hip_runtime.h>
#include <cstdio>
#include <cstdint>
namespace pg8 {
#define PG8_LAS __attribute__((address_space(3)))
typedef unsigned short bf16_t;
typedef short bf16x8 __attribute__((ext_vector_type(8)));
typedef float f32x4 __attribute__((ext_vector_type(4)));
typedef unsigned u32x4 __attribute__((ext_vector_type(4)));
constexpr int BM = 256, BK = 64, HALF = 128, HTB = HALF * BK * 2  , STAGE_BYTES = 8 * HTB, NXCD = 8, WGM = 8;

__host__ __device__ __forceinline__ int lds_byte(int r, int c) { const int st = (r >> 4) * 2 + (c >> 5), rr = r & 15, cc = c & 31, ob = rr * 64 + cc * 2; return st * 1024 + (ob ^ (((ob >> 9) & 1) << 5)); }
__host__ __device__ __forceinline__ void stage_rc(int b, int& R, int& C) { const int st = b / 1024, sb = b % 1024, swz = sb ^ (((sb >> 9) & 1) << 5); R = (st >> 1) * 16 + swz / 64; C = (st & 1) * 32 + (swz % 64) / 2; }
__host__ __device__ __forceinline__ int perm32(int rho) { const int n = rho >> 4, i = rho & 15; return 8 * (i >> 2) + 4 * n + (i & 3); }

struct Unit { int pm, pn; };
struct Gemm { const bf16_t* A; const bf16_t* Bt; int M, N, K; };

struct StaticOrder {
    int nM, nN, nwg, G, c;
    __host__ __device__ void init(int M, int N, int G_, int c_) { nM = M / BM; nN = N / BM; nwg = nM * nN; G = G_; c = c_; }
    __host__ __device__ bool next(int i, Unit& u) const {
        const long L = (long)i * G + c; if (L >= nwg) return false;
        int wgid = (int)L; { const int q = nwg / NXCD, r = nwg % NXCD, xcd = wgid % NXCD, off = wgid / NXCD; wgid = (xcd < r ? xcd * (q + 1) : r * (q + 1) + (xcd - r) * q) + off; }
        const int nig = WGM * nN, gid = wgid / nig, fm = gid * WGM, gsz = (nM - fm) < WGM ? (nM - fm) : WGM;
        u.pm = fm + ((wgid % nig) % gsz); u.pn = (wgid % nig) / gsz; return true;
    }
    __device__ __forceinline__ void a_ready(const Unit&) const {}
    __device__ __forceinline__ void done(const Unit&) const {}
};

__device__ __forceinline__ unsigned cvt_pk_bf16(float lo, float hi) { unsigned r; asm volatile("v_cvt_pk_bf16_f32 %0, %1, %2" : "=v"(r) : "v"(lo), "v"(hi)); return r; }
typedef float f32x2 __attribute__((ext_vector_type(2)));
template <class Epi, class Sched, bool ALIGN_EPI = false, bool SP2 = false>
__device__ __forceinline__ void gemm_phase(PG8_LAS unsigned char* lds, const Gemm g, const Sched& S, const Epi& E) {
    const int tid = threadIdx.x, wid = __builtin_amdgcn_readfirstlane(tid >> 6), lane = tid & 63, wr = wid >> 2, wc = wid & 3, fr = lane & 15, fq = lane >> 4;
    const int K = g.K, nt = K / BK;
    unsigned voffA[2], voffB[2];
#pragma unroll
    for (int i = 0; i < 2; ++i) { int R, C; stage_rc(tid * 16 + i * 8192, R, C); const int Rb = Epi::PERM ? ((R & ~31) + perm32(R & 31)) : R;
        voffA[i] = (unsigned)(R * K + C) * 2u; voffB[i] = (unsigned)(Rb * K + C) * 2u; }
    const size_t kstep = (size_t)(BK * 2);
    const size_t hstep = (size_t)HALF * K * 2;
    const size_t tstep = 2 * hstep;
    const unsigned ldsw = (unsigned)wid * 1024u;
    const int aoff = lds_byte(wr * 64 + fr, fq * 8), boff = lds_byte(wc * 32 + fr, fq * 8);
#define PG8_SA(b, h) (((b) * 2 + (h)) * HTB)
#define PG8_SB(b, h) ((4 + (b) * 2 + (h)) * HTB)
#define PG8_STAGE(bufoff, gbase, voff) do { _Pragma("unroll") for (int _i = 0; _i < 2; ++_i) \
        __builtin_amdgcn_global_load_lds((const unsigned*)((const char*)(gbase) + (voff)[_i]), (PG8_LAS unsigned*)(lds + (bufoff) + ldsw + _i * 8192), 16, 0, 0); } while (0)
#define PG8_LDA(dst, b, h) do { _Pragma("unroll") for (int m = 0; m < 4; ++m) _Pragma("unroll") for (int k = 0; k < 2; ++k) dst[m][k] = *(const PG8_LAS bf16x8*)(lds + PG8_SA(b, h) + aoff + m * 2048 + k * 1024); } while (0)
#define PG8_LDB(dst, b, h) do { _Pragma("unroll") for (int n = 0; n < 2; ++n) _Pragma("unroll") for (int k = 0; k < 2; ++k) dst[n][k] = *(const PG8_LAS bf16x8*)(lds + PG8_SB(b, h) + boff + n * 2048 + k * 1024); } while (0)
#define PG8_MMA(ai, bj, At, Bt) do { __builtin_amdgcn_s_setprio(1); _Pragma("unroll") for (int m = 0; m < 4; ++m) _Pragma("unroll") for (int n = 0; n < 2; ++n) _Pragma("unroll") for (int k = 0; k < 2; ++k) \
        acc[ai][bj][m][n] = __builtin_amdgcn_mfma_f32_16x16x32_bf16(Bt[n][k], At[m][k], acc[ai][bj][m][n], 0, 0, 0); __builtin_amdgcn_s_setprio(0); } while (0)
#define PG8_WAIT_V(n) asm volatile("s_waitcnt vmcnt(" #n ")" ::: "memory")
#define PG8_WAIT_L(n) asm volatile("s_waitcnt lgkmcnt(" #n ")" ::: "memory")
#define PG8_BAR __builtin_amdgcn_s_barrier()
#define PG8_SCHED __builtin_amdgcn_sched_barrier(0)
    Unit cur, nxt; int ui = 0;
    if (!S.next(0, cur)) return;
    f32x4 acc[2][2][4][2];
#pragma unroll
    for (int a = 0; a < 2; ++a)
#pragma unroll
        for (int b = 0; b < 2; ++b)
#pragma unroll
            for (int m = 0; m < 4; ++m)
#pragma unroll
                for (int n = 0; n < 2; ++n) acc[a][b][m][n] = (f32x4){0.f, 0.f, 0.f, 0.f};
    bf16x8 At[4][2], B0[2][2], B1[2][2];
    const char* cA = (const char*)g.A + (size_t)cur.pm * tstep; const char* cB = (const char*)g.Bt + (size_t)cur.pn * tstep;
    S.a_ready(cur);
    if constexpr (SP2) {
        PG8_STAGE(PG8_SB(0, 0), cB, voffB); PG8_STAGE(PG8_SB(0, 1), cB + hstep, voffB); PG8_STAGE(PG8_SA(0, 0), cA, voffA); PG8_STAGE(PG8_SA(0, 1), cA + hstep, voffA);
        if (wr == 1) PG8_BAR;
        PG8_WAIT_V(2); PG8_BAR;
        PG8_STAGE(PG8_SB(1, 0), cB + kstep, voffB); PG8_STAGE(PG8_SA(1, 0), cA + kstep, voffA); PG8_STAGE(PG8_SB(1, 1), cB + hstep + kstep, voffB);
        PG8_WAIT_V(6); PG8_BAR;
    } else {
        PG8_STAGE(PG8_SB(0, 0), cB, voffB); PG8_STAGE(PG8_SA(0, 0), cA, voffA); PG8_STAGE(PG8_SB(0, 1), cB + hstep, voffB); PG8_STAGE(PG8_SA(0, 1), cA + hstep, voffA);
        if (wr == 1) PG8_BAR;
        PG8_WAIT_V(4); PG8_BAR;
        PG8_STAGE(PG8_SB(1, 0), cB + kstep, voffB); PG8_STAGE(PG8_SA(1, 0), cA + kstep, voffA); PG8_STAGE(PG8_SB(1, 1), cB + hstep + kstep, voffB);
        PG8_WAIT_V(6); PG8_BAR;
    }
    for (;;) {
        const bool has_next = S.next(ui + 1, nxt);
        const char* nA = has_next ? (const char*)g.A + (size_t)nxt.pm * tstep : cA; const char* nB = has_next ? (const char*)g.Bt + (size_t)nxt.pn * tstep : cB;
        for (int t = 0; t < nt; t += 2) {
            const bool last = (t == nt - 2);
            const char* a1 = cA + (size_t)(t + 1) * kstep;
            const char* a2 = last ? nA : cA + (size_t)(t + 2) * kstep; const char* b2 = last ? nB : cB + (size_t)(t + 2) * kstep;
            const char* a3 = a2 + kstep; const char* b3 = b2 + kstep;
            if (last && has_next) S.a_ready(nxt);
            if constexpr (SP2) {
            PG8_LDB(B0, 0, 0); PG8_LDB(B1, 0, 1); PG8_SCHED; PG8_LDA(At, 0, 0); PG8_STAGE(PG8_SA(1, 1), a1 + hstep, voffA);
            PG8_WAIT_V(8); PG8_WAIT_L(0); PG8_BAR; PG8_MMA(0, 0, At, B0); PG8_MMA(0, 1, At, B1); PG8_BAR; PG8_SCHED;
            PG8_LDA(At, 0, 1); PG8_STAGE(PG8_SB(0, 0), b2, voffB); PG8_STAGE(PG8_SB(0, 1), b2 + hstep, voffB); PG8_STAGE(PG8_SA(0, 0), a2, voffA);
            PG8_WAIT_V(8); PG8_WAIT_L(0); PG8_BAR; PG8_MMA(1, 0, At, B0); PG8_MMA(1, 1, At, B1); PG8_BAR; PG8_SCHED;
            PG8_LDB(B0, 1, 0); PG8_LDB(B1, 1, 1); PG8_SCHED; PG8_LDA(At, 1, 0); PG8_STAGE(PG8_SA(0, 1), a2 + hstep, voffA);
            PG8_WAIT_V(8); PG8_WAIT_L(0); PG8_BAR; PG8_MMA(0, 0, At, B0); PG8_MMA(0, 1, At, B1); PG8_BAR; PG8_SCHED;
            PG8_LDA(At, 1, 1); PG8_STAGE(PG8_SB(1, 0), b3, voffB); PG8_STAGE(PG8_SB(1, 1), b3 + hstep, voffB); PG8_STAGE(PG8_SA(1, 0), a3, voffA);
            PG8_WAIT_V(8); PG8_WAIT_L(0); PG8_BAR; PG8_MMA(1, 0, At, B0); PG8_MMA(1, 1, At, B1); PG8_BAR; PG8_SCHED;
            } else {
            PG8_LDB(B0, 0, 0); PG8_SCHED; PG8_LDA(At, 0, 0); PG8_STAGE(PG8_SA(1, 1), a1 + hstep, voffA);
            PG8_WAIT_L(8); PG8_BAR; PG8_WAIT_L(0); PG8_MMA(0, 0, At, B0); PG8_BAR; PG8_SCHED;
            PG8_LDB(B1, 0, 1); PG8_STAGE(PG8_SB(0, 0), b2, voffB);
            PG8_BAR; PG8_WAIT_L(0); PG8_MMA(0, 1, At, B1); PG8_BAR;
            PG8_LDA(At, 0, 1); PG8_STAGE(PG8_SA(0, 0), a2, voffA);
            PG8_BAR; PG8_WAIT_L(0); PG8_MMA(1, 0, At, B0); PG8_BAR; PG8_SCHED;
            PG8_STAGE(PG8_SB(0, 1), b2 + hstep, voffB);
            PG8_WAIT_V(6); PG8_BAR; PG8_MMA(1, 1, At, B1); PG8_BAR;
            PG8_LDB(B0, 1, 0); PG8_SCHED; PG8_LDA(At, 1, 0); PG8_STAGE(PG8_SA(0, 1), a2 + hstep, voffA);
            PG8_WAIT_L(8); PG8_BAR; PG8_WAIT_L(0); PG8_MMA(0, 0, At, B0); PG8_BAR; PG8_SCHED;
            PG8_LDB(B1, 1, 1); PG8_STAGE(PG8_SB(1, 0), b3, voffB);
            PG8_BAR; PG8_WAIT_L(0); PG8_MMA(0, 1, At, B1); PG8_BAR;
            PG8_LDA(At, 1, 1); PG8_STAGE(PG8_SA(1, 0), a3, voffA);
            PG8_BAR; PG8_WAIT_L(0); PG8_MMA(1, 0, At, B0); PG8_BAR; PG8_SCHED;
            PG8_STAGE(PG8_SB(1, 1), b3 + hstep, voffB);
            PG8_WAIT_V(6); PG8_BAR; PG8_MMA(1, 1, At, B1); PG8_BAR;
            }
        }
        if constexpr (ALIGN_EPI) { if (wr == 0) PG8_BAR; }
        if constexpr (!Epi::AFTER_DRAIN) { E(acc, cur, wr, wc, fr, fq); S.done(cur); }
        if (!has_next) break;
#pragma unroll
        for (int a = 0; a < 2; ++a)
#pragma unroll
            for (int b = 0; b < 2; ++b)
#pragma unroll
                for (int m = 0; m < 4; ++m)
#pragma unroll
                    for (int n = 0; n < 2; ++n) acc[a][b][m][n] = (f32x4){0.f, 0.f, 0.f, 0.f};
        cur = nxt; cA = nA; cB = nB; ++ui;
        if constexpr (ALIGN_EPI) { if (wr == 1) PG8_BAR; }
    }
    PG8_WAIT_V(0);
    if constexpr (!ALIGN_EPI) { if (wr == 0) PG8_BAR; }
    PG8_BAR;
    if constexpr (Epi::AFTER_DRAIN) { E.fused(acc, cur, wr, wc, fr, fq, lds, wid, lane); S.done(cur); }
#undef PG8_SA
#undef PG8_SB
#undef PG8_STAGE
#undef PG8_LDA
#undef PG8_LDB
#undef PG8_MMA
#undef PG8_WAIT_V
#undef PG8_WAIT_L
#undef PG8_BAR
#undef PG8_SCHED
}
}
#define GAS __attribute__((address_space(1)))
#define LAS __attribute__((address_space(3)))
typedef unsigned short bf16;
typedef unsigned v4u __attribute__((ext_vector_type(4)));
typedef float f32x4 __attribute__((ext_vector_type(4)));
typedef short bf16x8 __attribute__((ext_vector_type(8)));
typedef GAS unsigned gu32;
typedef GAS unsigned long long gu64;
#define RLX_AGENT __ATOMIC_RELAXED, __HIP_MEMORY_SCOPE_AGENT
#define LDS_WAIT() asm volatile("s_waitcnt lgkmcnt(0)" ::: "memory")
#define VM_WAIT() asm volatile("s_waitcnt vmcnt(0)" ::: "memory")
__device__ __forceinline__ unsigned long long rt() { return __builtin_amdgcn_s_memrealtime(); }
__device__ __forceinline__ unsigned f2bf(float f) { unsigned u = __builtin_bit_cast(unsigned, f); return (u + 0x7fffu + ((u >> 16) & 1u)) >> 16; }
typedef float pk2_f32x2 __attribute__((ext_vector_type(2))); typedef __bf16 pk2_bf16x2 __attribute__((ext_vector_type(2)));
__device__ __forceinline__ unsigned pk2(float lo, float hi) { pk2_f32x2 v = {lo, hi}; pk2_bf16x2 b = __builtin_convertvector(v, pk2_bf16x2); return __builtin_bit_cast(unsigned, b); }

#define XB_TMO      128
#define XB_XCNT(j)  (256  + 64 * (j))
#define XB_XSUB(j)  (1280 + 64 * (j))
#define XB_XGEN(j)  (2304 + 64 * (j))
#define XB_TOP      3328
#define XB_TOPGEN   3392
#define XCD_BAR_WORDS 3456
#define XB_SPIN_CAP (1u << 18)

__device__ __forceinline__ unsigned xb_ld(unsigned* p)              { return __hip_atomic_load(p, __ATOMIC_RELAXED, __HIP_MEMORY_SCOPE_AGENT); }
__device__ __forceinline__ unsigned xb_add(unsigned* p, unsigned v) { return __hip_atomic_fetch_add(p, v, __ATOMIC_RELAXED, __HIP_MEMORY_SCOPE_AGENT); }
__device__ __forceinline__ unsigned xb_xcc_id() { return (unsigned)__builtin_amdgcn_s_getreg((3 << 11) | 20) & 0xFu; }
#define XB_SPIN(cond, bar) do { unsigned _sp = 0; while (cond) { __builtin_amdgcn_s_sleep(1); \
    if ((++_sp & 255u) == 0u) { if (xb_ld(&(bar)[XB_TMO])) break; if (_sp > XB_SPIN_CAP) { atomicAdd(&(bar)[XB_TMO], 1u); break; } } } } while (0)

struct XcdBarrier {
    unsigned* bar; unsigned x;
    volatile LAS unsigned* st;
};

__device__ __forceinline__ XcdBarrier xcd_barrier_post(unsigned* bar, volatile LAS unsigned* st) {
    XcdBarrier b; b.bar = bar; b.x = xb_xcc_id(); b.st = st;
    if (threadIdx.x == 0) (void)xb_add(&bar[XB_XCNT(b.x)], 1u);
    return b;
}
__device__ __forceinline__ void xcd_barrier_complete(unsigned* bar, unsigned x, unsigned& nloc, unsigned& nx) {
    const unsigned G = gridDim.x * gridDim.y * gridDim.z;
    unsigned sum, cnt, mine, sp = 0u;
    for (;;) {
        sum = 0u; cnt = 0u; mine = 0u;
#pragma unroll
        for (unsigned j = 0; j < 16; ++j) { const unsigned c = xb_ld(&bar[XB_XCNT(j)]); sum += c; cnt += (c > 0u) ? 1u : 0u; mine = (j == x) ? c : mine; }
        if (sum == G) break;
        __builtin_amdgcn_s_sleep(1);
        if ((++sp & 255u) == 0u) { if (xb_ld(&bar[XB_TMO])) break; if (sp > XB_SPIN_CAP) { atomicAdd(&bar[XB_TMO], 1u); break; } }
    }
    nloc = mine > 0u ? mine : 1u; nx = cnt > 0u ? cnt : 1u;
}

__device__ __forceinline__ void xcd_barrier(const XcdBarrier& b) {
    asm volatile("s_waitcnt vmcnt(0)" ::: "memory");
    __syncthreads();
    if (threadIdx.x == 0) {
        unsigned* bar = b.bar;
        __builtin_amdgcn_s_waitcnt(0);
        unsigned nloc = b.st[0], nx = b.st[1];
        if (nloc == 0u) { xcd_barrier_complete(bar, b.x, nloc, nx); b.st[0] = nloc; b.st[1] = nx; }
        const unsigned old = xb_add(&bar[XB_XSUB(b.x)], 1u);
        const unsigned gen = old / nloc;
        if (old + 1u == (gen + 1u) * nloc) {
            __builtin_amdgcn_fence(__ATOMIC_RELEASE, "agent");
            asm volatile("s_waitcnt vmcnt(0)" ::: "memory");
            const unsigned og = xb_add(&bar[XB_TOP], 1u);
            const unsigned tg = og / nx;
            if (og + 1u == (tg + 1u) * nx) xb_add(&bar[XB_TOPGEN], 1u);
            else XB_SPIN(xb_ld(&bar[XB_TOPGEN]) == tg, bar);
            __builtin_amdgcn_fence(__ATOMIC_ACQUIRE, "agent");
            xb_add(&bar[XB_XGEN(b.x)], 1u);
            asm volatile("s_waitcnt vmcnt(0)" ::: "memory");
        } else {
            XB_SPIN(xb_ld(&bar[XB_XGEN(b.x)]) == gen, bar);
            __builtin_amdgcn_fence(__ATOMIC_ACQUIRE, "agent");
            asm volatile("s_waitcnt vmcnt(0)" ::: "memory");
        }
    }
    __syncthreads();
}
#ifndef PROBE_PHASE
#define PROBE_PHASE -1
#endif
constexpr int TP = 4096, BP = 4, MP = BP * TP;
constexpr int BS = 128, TS = 4, MS = BS * TS;
constexpr int MT = MP + MS;
constexpr int DM = 1024, RW = 512, SC = 1792, NINP = 3840, FF = 2816, NUP = 5632;
constexpr int PAST = 2048, NPAGES = 16, LS = PAST + TS;
constexpr float ALPHA = 1.189207115002721f;
constexpr float LN_EPS = 1e-5f, GN_EPS = 64e-5f;
constexpr float QSCALE = 0.125f * 1.4426950408889634f;
constexpr float LOG2E = 1.4426950408889634f;
constexpr size_t O_YP = 0, O_YS = 16777216, O_KP = 17301504, O_VP = 25690112, O_KIP = 34078720, O_WKVP = 35127296, O_SHP = 35258368, O_CVP = 35265536,
                 O_KS = 35288064, O_VS = 35550208, O_KIS = 35812352, O_WKVS = 35845120, O_SHS = 40039424, O_CVS = 40268800, O_END = 40989696;

namespace pg8 {
__device__ __forceinline__ u32x4 pack8(const f32x4 a, const f32x4 b) { u32x4 w; w.x = cvt_pk_bf16(a[0], a[1]); w.y = cvt_pk_bf16(a[2], a[3]); w.z = cvt_pk_bf16(b[0], b[1]); w.w = cvt_pk_bf16(b[2], b[3]); return w; }
struct EpiIn {
    static constexpr bool PERM = true, AFTER_DRAIN = false;
    float* prw; bf16_t* qb; bf16_t* kb; bf16_t* vb; float* qi; float* wi; float* out;
    __device__ __forceinline__ void operator()(const f32x4 (&acc)[2][2][4][2], const Unit& u, int wr, int wc, int fr, int fq) const {
        const int pn = u.pn; const bool samp = u.pm >= 64;
#pragma unroll
        for (int ai = 0; ai < 2; ++ai)
#pragma unroll
            for (int m = 0; m < 4; ++m) {
                const int row = u.pm * BM + ai * HALF + wr * 64 + m * 16 + fr;
                const int rs = row - MP;
#pragma unroll
                for (int bj = 0; bj < 2; ++bj) {
                    const int col = pn * BM + bj * HALF + wc * 32 + 8 * fq;
                    const f32x4 v0 = acc[ai][bj][m][0], v1 = acc[ai][bj][m][1];
                    if (pn < 7) {
                        float* p = prw + (size_t)row * SC + col; *(f32x4*)p = v0; *(f32x4*)(p + 4) = v1;
                        const bool last = samp ? ((rs & 3) == 3) : ((row & (TP - 1)) == TP - 1);
                        if (last) { float* o = samp ? out + O_SHS + (size_t)(rs >> 2) * SC + col : out + O_SHP + (size_t)(row >> 12) * SC + col; *(f32x4*)o = v0; *(f32x4*)(o + 4) = v1; }
                    } else if (pn < 9) {
                        const int c = col - 1792; *(u32x4*)(qb + (size_t)row * RW + c) = pack8(v0 * QSCALE, v1 * QSCALE);
                    } else if (pn < 11) {
                        const int c = col - 2304; float* o = samp ? out + O_KS + (size_t)rs * RW + c : out + O_KP + (size_t)row * RW + c; *(f32x4*)o = v0; *(f32x4*)(o + 4) = v1;
                        *(u32x4*)(kb + (size_t)row * RW + c) = pack8(v0, v1);
                    } else if (pn < 13) {
                        const int c = col - 2816; float* o = samp ? out + O_VS + (size_t)rs * RW + c : out + O_VP + (size_t)row * RW + c; *(f32x4*)o = v0; *(f32x4*)(o + 4) = v1;
                        *(u32x4*)(vb + (size_t)row * RW + c) = pack8(v0, v1);
                    } else if (pn == 13) {
                        const int c = col - 3328; float* o = qi + (size_t)row * 256 + c; *(f32x4*)o = v0; *(f32x4*)(o + 4) = v1;
                    } else {
                        const int c = col - 3584;
                        if (c < 64) { float* o = samp ? out + O_KIS + (size_t)rs * 64 + c : out + O_KIP + (size_t)row * 64 + c; *(f32x4*)o = v0; *(f32x4*)(o + 4) = v1; }
                        else if (c == 64) { *(f32x4*)(wi + (size_t)row * 4) = v0 * 0.5f; }
                    }
                }
            }
    }
};
struct EpiRes {
    static constexpr bool PERM = true, AFTER_DRAIN = false;
    const float* resP; const float* resS; float* out;
    __device__ __forceinline__ void operator()(const f32x4 (&acc)[2][2][4][2], const Unit& u, int wr, int wc, int fr, int fq) const {
        const bool samp = u.pm >= 64;
#pragma unroll
        for (int ai = 0; ai < 2; ++ai)
#pragma unroll
            for (int m = 0; m < 4; ++m) {
                const int row = u.pm * BM + ai * HALF + wr * 64 + m * 16 + fr;
                const float* rr = samp ? resS + (size_t)(row - MP) * DM : resP + (size_t)row * DM;
#pragma unroll
                for (int bj = 0; bj < 2; ++bj) {
                    const int col = u.pn * BM + bj * HALF + wc * 32 + 8 * fq;
                    const f32x4 r0 = *(const f32x4*)(rr + col), r1 = *(const f32x4*)(rr + col + 4);
                    float* o = out + (size_t)row * DM + col;
                    *(f32x4*)o = r0 * ALPHA + acc[ai][bj][m][0]; *(f32x4*)(o + 4) = r1 * ALPHA + acc[ai][bj][m][1];
                }
            }
    }
};
struct EpiUp {
    static constexpr bool PERM = true, AFTER_DRAIN = false;
    bf16_t* uc; bf16_t* ul; float* out;
    __device__ __forceinline__ void operator()(const f32x4 (&acc)[2][2][4][2], const Unit& u, int wr, int wc, int fr, int fq) const {
        const bool samp = u.pm >= 64;
#pragma unroll
        for (int ai = 0; ai < 2; ++ai)
#pragma unroll
            for (int m = 0; m < 4; ++m) {
                const int row = u.pm * BM + ai * HALF + wr * 64 + m * 16 + fr;
                const int c = u.pn * HALF + wc * 32 + 8 * fq;
                *(u32x4*)(uc + (size_t)row * FF + c) = pack8(acc[ai][0][m][0], acc[ai][0][m][1]);
                *(u32x4*)(ul + (size_t)row * FF + c) = pack8(acc[ai][1][m][0], acc[ai][1][m][1]);
                if (samp) { const int rs = row - MP, t = rs & 3; if (t >= 2) { float* o = out + O_CVS + ((size_t)(rs >> 2) * 2 + (t - 2)) * FF + c; *(f32x4*)o = acc[ai][0][m][0]; *(f32x4*)(o + 4) = acc[ai][0][m][1]; } }
                else { const int t = row & (TP - 1); if (t >= TP - 2) { float* o = out + O_CVP + ((size_t)(row >> 12) * 2 + (t - (TP - 2))) * FF + c; *(f32x4*)o = acc[ai][0][m][0]; *(f32x4*)(o + 4) = acc[ai][0][m][1]; } }
            }
    }
};
}
constexpr size_t MiB = 1u << 20;
constexpr size_t WS_CTL = 0, CTL_ZERO_BYTES = 1 * MiB;
constexpr size_t WS_WIN = 2 * MiB;
constexpr size_t WS_WOUT = 10 * MiB;
constexpr size_t WS_WUP = 12 * MiB;
constexpr size_t WS_WDN = 24 * MiB;
constexpr size_t WS_LW = 30 * MiB;
constexpr size_t WS_XB = 32 * MiB;
constexpr size_t WS_PRW = 66 * MiB;
constexpr size_t WS_QB = 182 * MiB;
constexpr size_t WS_KB = 199 * MiB;
constexpr size_t WS_VB = 216 * MiB;
constexpr size_t WS_QI = 233 * MiB;
constexpr size_t WS_WI = 250 * MiB;
constexpr size_t WS_SCAN = 1024 * MiB;
constexpr size_t WS_G = 454 * MiB;
constexpr size_t WS_BG = 251 * MiB;
constexpr size_t WS_YS = 489 * MiB;
constexpr size_t WS_MASK = 523 * MiB;
constexpr size_t WS_SEL = 532 * MiB;
constexpr size_t WS_MIX = 533 * MiB;
constexpr size_t WS_Z = 567 * MiB;
constexpr size_t WS_X1 = 634 * MiB;
constexpr size_t WS_X1B = 701 * MiB;
constexpr size_t WS_UC = 735 * MiB;
constexpr size_t WS_UL = 826 * MiB;
constexpr size_t WS_H = 917 * MiB;
constexpr size_t WS_END = 1330 * MiB;
constexpr int CW_BAR = 4096;
constexpr int CW_Q = 64;
constexpr int SREC = 576;

constexpr int RING_BYTES = 131072, LDSCTL_OFF = RING_BYTES, MISC_OFF = LDSCTL_OFF + 320, LDS_BYTES = 147456;
constexpr int NWAVES = 8, NTHR = 512;
constexpr int NPHASE = 12;

__device__ __forceinline__ float bf2f(unsigned short h) { return __builtin_bit_cast(float, (unsigned)h << 16); }
__device__ __forceinline__ float wave_sum(float v) {
#pragma unroll
    for (int o = 1; o < 64; o <<= 1) v += __shfl_xor(v, o);
    return v;
}
template <int CTRL> __device__ __forceinline__ float dppf(float x) { return __builtin_bit_cast(float, __builtin_amdgcn_update_dpp(0, __builtin_bit_cast(int, x), CTRL, 0xf, 0xf, true)); }
__device__ __forceinline__ float sum16(float x) {
    x += dppf<0xB1>(x); x += dppf<0x4E>(x); x += dppf<0x141>(x); x += dppf<0x140>(x); return x;
}
__device__ __forceinline__ float sum8(float x) {
    x += dppf<0xB1>(x); x += dppf<0x4E>(x); x += dppf<0x141>(x); return x;
}
__device__ __forceinline__ bf16x8 pack_bf8(const f32x4 a, const f32x4 b) {
    v4u w; w.x = pk2(a[0], a[1]); w.y = pk2(a[2], a[3]); w.z = pk2(b[0], b[1]); w.w = pk2(b[2], b[3]); return __builtin_bit_cast(bf16x8, w);
}
typedef float f32x16 __attribute__((ext_vector_type(16)));
typedef float f32x2 __attribute__((ext_vector_type(2)));

struct Ctx {
    LAS unsigned char* lds; int tid, lane, wave, vcu, G;
    const void* const* in_; float* out; unsigned char* ws;
};
#define INF(k) ((const float*)in[k])

template <int MODE> __device__ __forceinline__ void p0_tr_item(const float* W, int K, int N, int nblk, bf16* WT, LAS float* scr, int item, int lane) {
    const int kb = item / nblk, nb = item % nblk, k0 = 64 * kb, n0 = 32 * nb;
    const int nl0 = lane & 31; const bool okn = (n0 + nl0) < N;
#pragma unroll 8
    for (int i = 0; i < 32; ++i) { const int kk = 2 * i + (lane >> 5); scr[kk * 33 + nl0] = okn ? W[(size_t)(k0 + kk) * N + n0 + nl0] : 0.f; }
    asm volatile("s_waitcnt lgkmcnt(0)" ::: "memory");
    const int c = lane & 7;
#pragma unroll
    for (int j = 0; j < 4; ++j) { const int nl = (lane >> 3) + 8 * j; const int n = n0 + nl; const LAS float* s = scr + (8 * c) * 33 + nl;
        int row = n;
        if (MODE == 2) row = (n < FF) ? 256 * (n >> 7) + (n & 127) : 256 * ((n - FF) >> 7) + 128 + ((n - FF) & 127);
        v4u o; o.x = pk2(s[0 * 33], s[1 * 33]); o.y = pk2(s[2 * 33], s[3 * 33]); o.z = pk2(s[4 * 33], s[5 * 33]); o.w = pk2(s[6 * 33], s[7 * 33]);
        *(GAS v4u*)(WT + (size_t)row * K + k0 + 8 * c) = o; }
    asm volatile("s_waitcnt lgkmcnt(0)" ::: "memory");
}
__device__ __forceinline__ void p0_prologue(const Ctx& C, const void* const* in) {
    LAS float* scr = (LAS float*)(C.lds + C.wave * 16384);
    const int gw = C.vcu * NWAVES + C.wave, NGW = C.G * NWAVES;
    constexpr int I_IN = 16 * 120, I_OUT = 16 * 32, I_UP = 16 * 176, I_DN = 44 * 32, NITEMS = I_IN + I_OUT + I_UP + I_DN;
    bf16* win = (bf16*)(C.ws + WS_WIN); bf16* wout = (bf16*)(C.ws + WS_WOUT); bf16* wup = (bf16*)(C.ws + WS_WUP); bf16* wdn = (bf16*)(C.ws + WS_WDN);
    for (int it = gw; it < NITEMS; it += NGW) {
        int r = it;
        if (r < I_IN) { p0_tr_item<0>(INF(10), DM, 3652, 120, win, scr, r, C.lane); continue; } r -= I_IN;
        if (r < I_OUT) { p0_tr_item<0>(INF(22), DM, DM, 32, wout, scr, r, C.lane); continue; } r -= I_OUT;
        if (r < I_UP) { p0_tr_item<2>(INF(25), DM, NUP, 176, wup, scr, r, C.lane); continue; } r -= I_UP;
        p0_tr_item<0>(INF(28), FF, DM, 32, wdn, scr, r, C.lane);
    }
    {
        bf16* lw = (bf16*)(C.ws + WS_LW);
        for (int e = C.vcu * NTHR + C.tid; e < 512 * 256; e += C.G * NTHR) { const int ch = e & 511, k = e >> 9;
            const float v = (k < 64) ? INF(13)[k * RW + ch] : (k < 128) ? INF(15)[(k - 64) * RW + ch] : INF(16)[(k - 128) * RW + ch];
            lw[(size_t)ch * 256 + k] = (bf16)f2bf(v); }
    }
    bf16* xb = (bf16*)(C.ws + WS_XB);
    for (int m = gw; m < MT; m += NGW) {
        const float* xr = (m < MP) ? INF(0) + (size_t)m * DM : INF(1) + (size_t)(m - MP) * DM;
        const GAS f32x4* x4 = (const GAS f32x4*)xr + C.lane;
        GAS unsigned long long* o8 = (GAS unsigned long long*)(xb + (size_t)m * DM) + C.lane;
#pragma unroll
        for (int j = 0; j < 4; ++j) { const f32x4 v = x4[64 * j]; o8[64 * j] = (unsigned long long)pk2(v.x, v.y) | ((unsigned long long)pk2(v.z, v.w) << 32); }
    }
}

__device__ __forceinline__ float sigmoidf_(float x) { return 1.f / (1.f + __expf(-x)); }
__device__ __forceinline__ float sum32h(float x) {
    x = sum16(x);
    return x + __shfl_xor(x, 16);
}
constexpr int ACT_PITCH = 264;
__device__ __forceinline__ void p2_prep(const Ctx& C, const void* const* in) {
    LAS unsigned short* act = (LAS unsigned short*)C.lds;
    const float* PRW = (const float*)(C.ws + WS_PRW);
    float* SCAN = (float*)(C.ws + WS_SCAN); float* Gb = (float*)(C.ws + WS_G); float* BG = (float*)(C.ws + WS_BG);
    const bf16* LW = (const bf16*)(C.ws + WS_LW);
    const float* smu = INF(11); const float* sst = INF(7);
    const int h = C.wave, lane = C.lane, n32 = lane & 31, hi = lane >> 5;
    float mu_r[2], mu_k[2], mu_v[2], w0[2], a0[2], kkc[2], kac[2], rkc[2];
#pragma unroll
    for (int nt = 0; nt < 2; ++nt) { const int c = 64 * h + 32 * nt + n32; mu_r[nt] = smu[c]; mu_k[nt] = smu[RW + c]; mu_v[nt] = smu[2 * RW + c];
        w0[nt] = INF(12)[c]; a0[nt] = INF(14)[c]; kkc[nt] = INF(17)[c]; kac[nt] = INF(18)[c]; rkc[nt] = INF(19)[c]; }
    for (int tile = C.vcu; tile < MT / 32; tile += C.G) {
        const int m0 = tile * 32;
        __syncthreads();
        {
            const int tok = C.tid >> 4, cg = C.tid & 15, m = m0 + tok, col0 = 1536 + cg * 16;
            const float* prow = PRW + (size_t)m * SC + col0; const float* pprev = prow - SC; bool zero = false;
            if (m < MP) { zero = (m & (TP - 1)) == 0; } else { const int ms = m - MP; if ((ms & 3) == 0) pprev = sst + (size_t)(ms >> 2) * SC + col0; }
            f32x4 sv[4];
#pragma unroll
            for (int i = 0; i < 4; ++i) {
                const f32x4 p = *(const f32x4*)(prow + 4 * i); f32x4 q = (f32x4){0.f, 0.f, 0.f, 0.f}; if (!zero) q = *(const f32x4*)(pprev + 4 * i);
                const f32x4 mu = *(const f32x4*)(smu + col0 + 4 * i); f32x4 s = p + (q - p) * mu;
                if (cg < 4) { for (int e = 0; e < 4; ++e) { const float ex = __expf(2.f * s[e]); s[e] = 1.f - 2.f / (ex + 1.f); } }
                else if (cg >= 8) { for (int e = 0; e < 4; ++e) s[e] = sigmoidf_(s[e]); }
                sv[i] = s;
            }
            LAS unsigned short* dst = act + tok * ACT_PITCH + cg * 16;
            *(LAS v4u*)dst = (v4u){pk2(sv[0][0], sv[0][1]), pk2(sv[0][2], sv[0][3]), pk2(sv[1][0], sv[1][1]), pk2(sv[1][2], sv[1][3])};
            *(LAS v4u*)(dst + 8) = (v4u){pk2(sv[2][0], sv[2][1]), pk2(sv[2][2], sv[2][3]), pk2(sv[3][0], sv[3][1]), pk2(sv[3][2], sv[3][3])};
        }
        __syncthreads();
        f32x16 accW[2], accA[2], accG[2];
#pragma unroll
        for (int nt = 0; nt < 2; ++nt)
#pragma unroll
            for (int r = 0; r < 16; ++r) { accW[nt][r] = 0.f; accA[nt][r] = 0.f; accG[nt][r] = 0.f; }
        {
            const LAS unsigned short* arow = act + n32 * ACT_PITCH + 8 * hi;
#pragma unroll
            for (int nt = 0; nt < 2; ++nt) {
                const bf16* brow = LW + (size_t)(64 * h + 32 * nt + n32) * 256 + 8 * hi;
#pragma unroll
                for (int s = 0; s < 16; ++s) {
                    const bf16x8 af = *(const LAS bf16x8*)(arow + 16 * s); const bf16x8 bfr = *(const bf16x8*)(brow + 16 * s);
                    if (s < 4) accW[nt] = __builtin_amdgcn_mfma_f32_32x32x16_bf16(af, bfr, accW[nt], 0, 0, 0);
                    else if (s < 8) accA[nt] = __builtin_amdgcn_mfma_f32_32x32x16_bf16(af, bfr, accA[nt], 0, 0, 0);
                    else accG[nt] = __builtin_amdgcn_mfma_f32_32x32x16_bf16(af, bfr, accG[nt], 0, 0, 0);
                }
            }
        }
#pragma unroll
        for (int r = 0; r < 16; ++r) {
            const int tk = (r & 3) + 8 * (r >> 2) + 4 * hi, m = m0 + tk;
            const float* pc = PRW + (size_t)m * SC; const float* pp = pc - SC; bool zero = false;
            if (m < MP) { zero = (m & (TP - 1)) == 0; } else { const int ms = m - MP; if ((ms & 3) == 0) pp = sst + (size_t)(ms >> 2) * SC; }
            float rr_[2], kx_[2], vx_[2], dec[2], aa_[2], kk_[2], kp_[2];
            float s_kk = 0.f;
#pragma unroll
            for (int nt = 0; nt < 2; ++nt) {
                const int c = 64 * h + 32 * nt + n32;
                const float pr = pc[c], pk = pc[RW + c], pv = pc[2 * RW + c];
                float qr = 0.f, qk = 0.f, qv = 0.f; if (!zero) { qr = pp[c]; qk = pp[RW + c]; qv = pp[2 * RW + c]; }
                rr_[nt] = pr + (qr - pr) * mu_r[nt]; kx_[nt] = pk + (qk - pk) * mu_k[nt]; vx_[nt] = pv + (qv - pv) * mu_v[nt];
                const float u = w0[nt] + accW[nt][r];
                const float wlog = -__logf(1.f + __expf(-u)) - 0.5f;
                dec[nt] = __expf(-__expf(wlog));
                aa_[nt] = sigmoidf_(a0[nt] + accA[nt][r]);
                kk_[nt] = kx_[nt] * kkc[nt]; s_kk += kk_[nt] * kk_[nt];
                kp_[nt] = kx_[nt] * (1.f + (aa_[nt] - 1.f) * kac[nt]);
            }
            const float rn = rsqrtf(fmaxf(sum32h(s_kk), 1e-24f));
            float s_br = 0.f, s_kr = 0.f, s_rkr = 0.f; float bb_[2];
#pragma unroll
            for (int nt = 0; nt < 2; ++nt) { kk_[nt] *= rn; bb_[nt] = kk_[nt] * aa_[nt]; s_br += bb_[nt] * rr_[nt]; s_kr += kp_[nt] * rr_[nt]; s_rkr += rr_[nt] * kp_[nt] * rkc[nt]; }
            const float br = sum32h(s_br), kr = sum32h(s_kr), rkr = sum32h(s_rkr);
            float* rec = SCAN + ((size_t)m * 8 + h) * SREC;
#pragma unroll
            for (int nt = 0; nt < 2; ++nt) {
                const int j = 32 * nt + n32, c = 64 * h + j;
                rec[j] = dec[nt]; rec[64 + j] = kk_[nt]; rec[128 + j] = bb_[nt]; rec[192 + j] = kp_[nt]; rec[256 + j] = dec[nt] * rr_[nt];
                *(f32x4*)(rec + 320 + 4 * j) = (f32x4){vx_[nt], vx_[nt] * kr, br, 0.f};
                const float g = accG[nt][r];
                Gb[(size_t)m * RW + c] = g; BG[(size_t)m * RW + c] = rkr * vx_[nt] * g;
            }
        }
    }
}

__device__ __forceinline__ unsigned okey(float v) { unsigned u = __builtin_bit_cast(unsigned, v); if ((u << 1) == 0u) u = 0u; return (u & 0x80000000u) ? ~u : (u | 0x80000000u); }
__device__ __forceinline__ int tk_bin(float v) { return (int)__builtin_amdgcn_fmed3f(v * 128.f + 512.f, 0.f, 1023.f); }
template <int I> __device__ __forceinline__ void wl_set(int& wlo, int& whi, unsigned long long m) {
    asm volatile("s_nop 1\n\tv_writelane_b32 %0, %2, %4\n\tv_writelane_b32 %1, %3, %4" : "+v"(wlo), "+v"(whi) : "s"((int)(unsigned)m), "s"((int)(unsigned)(m >> 32)), "n"(I));
}
#define TK_R8(M, b) M(b) M(b + 1) M(b + 2) M(b + 3) M(b + 4) M(b + 5) M(b + 6) M(b + 7)
#define TK_ALL(M) do { if (0 < nreg) { TK_R8(M, 0) } if (8 < nreg) { TK_R8(M, 8) } if (16 < nreg) { TK_R8(M, 16) } if (24 < nreg) { TK_R8(M, 24) } \
                       if (32 < nreg) { TK_R8(M, 32) } if (40 < nreg) { TK_R8(M, 40) } if (48 < nreg) { TK_R8(M, 48) } if (56 < nreg) { TK_R8(M, 56) } } while (0)
__device__ __forceinline__ unsigned long long topk_select(LAS float* vals, int nvis, int lane_in) {
    int lane = lane_in; asm volatile("" : "+v"(lane));
    const int nreg = (nvis + 63) >> 6;
    const unsigned long long lt = (lane == 0) ? 0ull : (~0ull >> (64 - lane));
    int wlo = 0, whi = 0;
    if (nvis <= 256) {
#define TK_VIS(i) { const unsigned long long m_ = __ballot(64 * (i) + lane < nvis); wl_set<(i)>(wlo, whi, m_); }
        TK_VIS(0) TK_VIS(1) TK_VIS(2) TK_VIS(3)
#undef TK_VIS
        return ((unsigned long long)(unsigned)whi << 32) | (unsigned)wlo;
    }
    float val[64];
    const LAS float* vlane = vals + lane;
#pragma unroll
    for (int g = 0; g < 8; ++g) {
        if (g * 8 < nreg) {
#pragma unroll
            for (int e = 0; e < 8; ++e) { const int i = g * 8 + e; val[i] = (lane < nvis - 64 * i) ? vlane[64 * i] : -__builtin_inff(); }
        } else {
#pragma unroll
            for (int e = 0; e < 8; ++e) val[g * 8 + e] = -__builtin_inff();
        }
    }
    asm volatile("s_waitcnt lgkmcnt(0)" ::: "memory");
    LAS unsigned* hist = (LAS unsigned*)vals;
    LAS unsigned* cand = hist + 1024;
#pragma unroll
    for (int k = 0; k < 4; ++k) *(LAS v4u*)(hist + lane * 16 + 4 * k) = (v4u){0u, 0u, 0u, 0u};
    asm volatile("s_waitcnt lgkmcnt(0)" ::: "memory");
#define TK_HIST(i) { __hip_atomic_fetch_add(hist + tk_bin(val[i]), 1u, __ATOMIC_RELAXED, __HIP_MEMORY_SCOPE_WORKGROUP); }
    TK_ALL(TK_HIST);
#undef TK_HIST
    asm volatile("s_waitcnt lgkmcnt(0)" ::: "memory");
    unsigned hb[16];
#pragma unroll
    for (int k = 0; k < 4; ++k) { const v4u h4 = *(const LAS v4u*)(hist + lane * 16 + 4 * k); hb[4 * k] = h4.x; hb[4 * k + 1] = h4.y; hb[4 * k + 2] = h4.z; hb[4 * k + 3] = h4.w; }
    unsigned csum = 0;
#pragma unroll
    for (int k = 0; k < 16; ++k) csum += hb[k];
    unsigned pre = csum;
#pragma unroll
    for (int o = 1; o < 64; o <<= 1) { const unsigned x = __shfl_up(pre, o); if (lane >= o) pre += x; }
    const unsigned total = __builtin_amdgcn_readlane(pre, 63);
    const unsigned above = total - pre;
    const unsigned long long lm = __ballot(above < 256u && above + csum >= 256u);
    const int L = __builtin_ctzll(lm);
    unsigned run = above; int bloc = 0; unsigned gtl = 0, cel = 0; bool found = false;
#pragma unroll
    for (int k = 15; k >= 0; --k) { const bool hit = !found && (run + hb[k] >= 256u); if (hit) { bloc = k; gtl = run; cel = hb[k]; found = true; } run += hb[k]; }
    const int bstar = L * 16 + __builtin_amdgcn_readlane(bloc, L);
    const int cgt = __builtin_amdgcn_readlane((int)gtl, L), ce = __builtin_amdgcn_readlane((int)cel, L);
    const int need = 256 - cgt;
    if (bstar > 0 && ce <= 512) {
        int ncand = 0;
#define TK_CLS(i) { const int bn_ = tk_bin(val[i]); const unsigned long long m_ = __ballot(bn_ > bstar), em_ = __ballot(bn_ == bstar); wl_set<(i)>(wlo, whi, m_); \
            if (em_) { if (bn_ == bstar) { const int pos_ = ncand + __popcll(em_ & lt); cand[2 * pos_] = okey(val[i]); cand[2 * pos_ + 1] = (unsigned)(64 * (i) + lane); } ncand += __popcll(em_); } }
        TK_ALL(TK_CLS);
#undef TK_CLS
        if (lane < 64) { hist[2 * lane] = 0u; hist[2 * lane + 1] = 0u; }
        asm volatile("s_waitcnt lgkmcnt(0)" ::: "memory");
        const int nr = (ce + 63) >> 6;
        unsigned ck[8];
        const LAS unsigned* cl = cand + 2 * lane;
#pragma unroll
        for (int j = 0; j < 8; ++j) { ck[j] = 0u; if (j < nr) { if (lane < ce - 64 * j) ck[j] = cl[128 * j]; } }
        unsigned T = 0u;
        if (need < ce) {
            for (int bit = 31; bit >= 0; --bit) {
                const unsigned cnd = T | (1u << bit); int cnt = 0;
#pragma unroll
                for (int j = 0; j < 8; ++j) if (j < nr) cnt += __popcll(__ballot(ck[j] >= cnd));
                if (cnt >= need) T = cnd;
            }
        }
        int cg2 = 0;
#pragma unroll
        for (int j = 0; j < 8; ++j) if (j < nr) cg2 += __popcll(__ballot(ck[j] > T));
        const bool all = !(need < ce);
        const int need2 = need - cg2; int run2 = 0;
#pragma unroll
        for (int j = 0; j < 8; ++j) if (j < nr) {
            const bool in = lane < ce - 64 * j;
            const bool eq = in && ck[j] == T; const unsigned long long em = __ballot(eq);
            const int before = run2 + __popcll(em & lt);
            const bool s = in && (all || ck[j] > T || (eq && before < need2)); run2 += __popcll(em);
            if (s) { const unsigned ki = cl[128 * j + 1]; __hip_atomic_fetch_or(hist + (ki >> 5), 1u << (ki & 31u), __ATOMIC_RELAXED, __HIP_MEMORY_SCOPE_WORKGROUP); }
        }
        asm volatile("s_waitcnt lgkmcnt(0)" ::: "memory");
        wlo |= (int)hist[2 * lane]; whi |= (int)hist[2 * lane + 1];
        return ((unsigned long long)(unsigned)whi << 32) | (unsigned)wlo;
    }
    unsigned T = 0u;
    for (int bit = 31; bit >= 0; --bit) {
        const unsigned cnd = T | (1u << bit); int cnt = 0;
#pragma unroll
        for (int g = 0; g < 8; ++g) if (g * 8 < nreg) {
#pragma unroll
            for (int e = 0; e < 8; ++e) cnt += __popcll(__ballot(val[g * 8 + e] > -__builtin_inff() && okey(val[g * 8 + e]) >= cnd));
        }
        if (cnt >= 256) T = cnd;
    }
    int cg3 = 0;
#pragma unroll
    for (int g = 0; g < 8; ++g) if (g * 8 < nreg) {
#pragma unroll
        for (int e = 0; e < 8; ++e) cg3 += __popcll(__ballot(val[g * 8 + e] > -__builtin_inff() && okey(val[g * 8 + e]) > T));
    }
    const int need3 = 256 - cg3; int run3 = 0;
#define TK_FB(i) { const bool vis_ = val[i] > -__builtin_inff(); const unsigned kx_ = okey(val[i]); const bool eq_ = vis_ && kx_ == T; const unsigned long long em_ = __ballot(eq_); \
        const int before_ = run3 + __popcll(em_ & lt); const bool s_ = vis_ && (kx_ > T || (eq_ && before_ < need3)); run3 += __popcll(em_); wl_set<(i)>(wlo, whi, __ballot(s_)); }
    TK_ALL(TK_FB);
#undef TK_FB
    return ((unsigned long long)(unsigned)whi << 32) | (unsigned)wlo;
}
#undef TK_ALL
#undef TK_R8
__device__ __forceinline__ void p3_topk(const Ctx& C, const void* const* in) {
    const float* QI = (const float*)(C.ws + WS_QI); const float* WI = (const float*)(C.ws + WS_WI);
    unsigned long long* MASK = (unsigned long long*)(C.ws + WS_MASK); int* SEL = (int*)(C.ws + WS_SEL);
    const int lane = C.lane, wave = C.wave, hi = lane >> 5;
    constexpr int NU_P = MP / 8, NU = NU_P + BS;
    gu32* qctr = (gu32*)(C.ws + WS_CTL) + CW_Q;
    volatile LAS unsigned* qslot = (volatile LAS unsigned*)(C.lds + MISC_OFF + 64);
    for (;;) {
        __syncthreads();
        if (C.tid == 0) *qslot = __hip_atomic_fetch_add(qctr, 1u, __ATOMIC_RELAXED, __HIP_MEMORY_SCOPE_AGENT);
        __syncthreads();
        const int qu = (int)*qslot;
        if (qu >= NU) break;
        const int unit = (qu < BS) ? NU_P + qu : qu - BS;
        LAS float* selvals; int selnvis, seltgt;
        if (unit < NU_P) {
            LAS float* idx = (LAS float*)C.lds;
            const int b = unit & 3, t0 = (511 - (unit >> 2)) * 8, nkeys = t0 + 8;
            const int rho = lane & 31, q = rho >> 2, hh = rho & 3;
            const float* qrow = QI + ((size_t)(b * TP + t0 + q)) * 256 + hh * 64 + 8 * hi;
            bf16x8 af[4];
#pragma unroll
            for (int s = 0; s < 4; ++s) af[s] = pack_bf8(*(const f32x4*)(qrow + 16 * s), *(const f32x4*)(qrow + 16 * s + 4));
            f32x4 wiv[4];
#pragma unroll
            for (int g = 0; g < 4; ++g) wiv[g] = *(const f32x4*)(WI + ((size_t)(b * TP + t0 + 2 * g + hi)) * 4) * 0.125f;
            const float* KI = C.out + O_KIP + (size_t)b * TP * 64;
            const int ntile = (nkeys + 31) >> 5;
            for (int rr_ = 0; rr_ < (PROBE_PHASE == 30 ? 2 : 1); ++rr_) {
            f32x4 kn[8];
            if (wave < ntile) { const float* kr_ = KI + (size_t)(wave * 32 + rho) * 64 + 8 * hi;
#pragma unroll
                for (int s = 0; s < 4; ++s) { kn[2 * s] = *(const f32x4*)(kr_ + 16 * s); kn[2 * s + 1] = *(const f32x4*)(kr_ + 16 * s + 4); } }
            for (int tile = wave; tile < ntile; tile += 8) {
                const int key = tile * 32 + rho;
                f32x4 kc[8];
#pragma unroll
                for (int s = 0; s < 8; ++s) kc[s] = kn[s];
                if (tile + 8 < ntile) { const float* kr_ = KI + (size_t)(key + 256) * 64 + 8 * hi;
#pragma unroll
                    for (int s = 0; s < 4; ++s) { kn[2 * s] = *(const f32x4*)(kr_ + 16 * s); kn[2 * s + 1] = *(const f32x4*)(kr_ + 16 * s + 4); } }
                f32x16 acc;
#pragma unroll
                for (int r = 0; r < 16; ++r) acc[r] = 0.f;
#pragma unroll
                for (int s = 0; s < 4; ++s) { const bf16x8 bf = pack_bf8(kc[2 * s], kc[2 * s + 1]);
                    acc = __builtin_amdgcn_mfma_f32_32x32x16_bf16(af[s], bf, acc, 0, 0, 0); }
#pragma unroll
                for (int g = 0; g < 4; ++g) {
                    float v = 0.f;
#pragma unroll
                    for (int e = 0; e < 4; ++e) v += wiv[g][e] * fmaxf(acc[4 * g + e], 0.f);
                    idx[(2 * g + hi) * 4096 + key] = v;
                }
            }
            }
            __syncthreads();
            selvals = idx + wave * 4096; selnvis = t0 + wave + 1; seltgt = b * TP + t0 + wave;
        } else {
            const int b = unit - NU_P;
            LAS float* qis = (LAS float*)C.lds;
            LAS float* wis = qis + 1024;
            LAS float* idx = qis + 1280;
            if (C.tid < 256) { const int row = C.tid >> 4, c4 = (C.tid & 15) * 4;
                *(LAS f32x4*)(qis + row * 64 + c4) = *(const f32x4*)(QI + ((size_t)(MP + b * 4 + (row >> 2))) * 256 + (row & 3) * 64 + c4); }
            if (C.tid < 16) wis[C.tid] = WI[((size_t)(MP + b * 4 + (C.tid >> 2))) * 4 + (C.tid & 3)] * 0.125f;
            __syncthreads();
            const int* pt = (const int*)in[5] + b * NPAGES;
            for (int s = C.tid; s < LS; s += NTHR) {
                const float* krow = (s < PAST) ? INF(4) + ((size_t)pt[s >> 7] * 128 + (s & 127)) * 64 : C.out + O_KIS + (size_t)(b * 4 + (s - PAST)) * 64;
                f32x4 kx[16];
#pragma unroll
                for (int i = 0; i < 16; ++i) kx[i] = *(const f32x4*)(krow + 4 * i);
#pragma unroll
                for (int t = 0; t < 4; ++t) {
                    float v = 0.f;
#pragma unroll
                    for (int hh = 0; hh < 4; ++hh) {
                        float d0 = 0.f, d1 = 0.f;
#pragma unroll
                        for (int i = 0; i < 16; i += 2) { const f32x4 qa = *(const LAS f32x4*)(qis + (t * 4 + hh) * 64 + 4 * i), qb = *(const LAS f32x4*)(qis + (t * 4 + hh) * 64 + 4 * i + 4);
                            d0 += kx[i][0] * qa[0] + kx[i][1] * qa[1] + kx[i][2] * qa[2] + kx[i][3] * qa[3];
                            d1 += kx[i + 1][0] * qb[0] + kx[i + 1][1] * qb[1] + kx[i + 1][2] * qb[2] + kx[i + 1][3] * qb[3]; }
                        v += wis[t * 4 + hh] * fmaxf(d0 + d1, 0.f);
                    }
                    idx[t * 2112 + s] = v;
                }
            }
            __syncthreads();
            selvals = idx + (wave & 3) * 2112; selnvis = PAST + (wave & 3) + 1; seltgt = (wave < 4) ? b * 4 + wave : -1;
        }
        if (seltgt >= 0) {
            unsigned long long w = topk_select(selvals, selnvis, lane);
            if (PROBE_PHASE == 31) { asm volatile("" ::: "memory"); w = topk_select(selvals, selnvis, lane); }
            if (unit < NU_P) MASK[(size_t)seltgt * 64 + lane] = w;
            else {
                int cnt = __popcll(w), pre = cnt;
#pragma unroll
                for (int o = 1; o < 64; o <<= 1) { const int x = __shfl_up(pre, o); if (lane >= o) pre += x; }
                int pos = pre - cnt; int* sel = SEL + (size_t)seltgt * 256;
                while (w) { const int bit = __builtin_ctzll(w); if (pos < 256) sel[pos] = 64 * lane + bit; ++pos; w &= w - 1; }
            }
        }
    }
}

struct ScanVec { f32x4 w, kk, b, k, wr, tri; };
__device__ __forceinline__ f32x2 fma2(f32x2 a, f32x2 b, f32x2 c) { return __builtin_elementwise_fma(a, b, c); }
__device__ __forceinline__ float scan_step(f32x2& S01, f32x2& S23, const ScanVec& x) {
    f32x2 q1 = S01 * (f32x2){x.kk[0], x.kk[1]}; q1 = fma2(S23, (f32x2){x.kk[2], x.kk[3]}, q1);
    f32x2 q2 = S01 * (f32x2){x.wr[0], x.wr[1]}; q2 = fma2(S23, (f32x2){x.wr[2], x.wr[3]}, q2);
    float p1 = q1[0] + q1[1], p2 = q2[0] + q2[1];
    const f32x2 vv = (f32x2){x.tri[0], x.tri[0]};
    f32x2 t01 = vv * (f32x2){x.k[0], x.k[1]}; t01 = fma2(S01, (f32x2){x.w[0], x.w[1]}, t01);
    f32x2 t23 = vv * (f32x2){x.k[2], x.k[3]}; t23 = fma2(S23, (f32x2){x.w[2], x.w[3]}, t23);
    p1 = sum16(p1); p2 = sum16(p2);
    const f32x2 nsa = (f32x2){-p1, -p1};
    S01 = fma2(nsa, (f32x2){x.b[0], x.b[1]}, t01); S23 = fma2(nsa, (f32x2){x.b[2], x.b[3]}, t23);
    return p2 - p1 * x.tri[2] + x.tri[1];
}
__device__ __forceinline__ void p4_scan(const Ctx& C, const void* const* in) {
    const float* SCAN = (const float*)(C.ws + WS_SCAN); float* YST = (float*)(C.ws + WS_YS); float* YSS = YST + (size_t)MP * RW;
    const int lane = C.lane, wave = C.wave, rg = lane >> 4, jl = lane & 15;
    {
        const float* st = INF(6);
        for (int u = C.vcu * NWAVES + wave; u < BS * 8 * 16; u += C.G * NWAVES) {
            const int bh = u >> 4, b = bh >> 3, h = bh & 7, i = (u & 15) * 4 + rg;
            const f32x4 s4 = *(const f32x4*)(st + ((size_t)bh * 64 + i) * 64 + 4 * jl);
            f32x2 S01 = (f32x2){s4[0], s4[1]}, S23 = (f32x2){s4[2], s4[3]};
#pragma unroll
            for (int t = 0; t < 4; ++t) {
                const int m = MP + b * 4 + t; const float* rec = SCAN + ((size_t)m * 8 + h) * SREC;
                ScanVec x; x.w = *(const f32x4*)(rec + 4 * jl); x.kk = *(const f32x4*)(rec + 64 + 4 * jl); x.b = *(const f32x4*)(rec + 128 + 4 * jl);
                x.k = *(const f32x4*)(rec + 192 + 4 * jl); x.wr = *(const f32x4*)(rec + 256 + 4 * jl); x.tri = *(const f32x4*)(rec + 320 + 4 * i);
                const float y = scan_step(S01, S23, x);
                if (jl == 0) YSS[(size_t)(b * 4 + t) * RW + h * 64 + i] = y;
            }
            *(f32x4*)(C.out + O_WKVS + ((size_t)bh * 64 + i) * 64 + 4 * jl) = (f32x4){S01[0], S01[1], S23[0], S23[1]};
        }
    }
    __syncthreads();
    constexpr int CH = 16, CHB = CH * SREC * 4;
    for (int unit = C.vcu; unit < 128; unit += C.G) {
        const int bh = unit >> 2, b = bh >> 3, h = bh & 7, i = (unit & 3) * 16 + (wave & 3) * 4 + rg;
        const float* base = SCAN + ((size_t)(b * TP) * 8 + h) * SREC;
        const int ltid = C.tid - 256;
        const unsigned lv = (unsigned)jl * 16u, lt = 1280u + (unsigned)i * 16u;
#define SC_BAR() do { asm volatile("" ::: "memory"); __builtin_amdgcn_s_barrier(); asm volatile("" ::: "memory"); } while (0)
        if (wave >= 4) {
            unsigned goff[9];
#pragma unroll
            for (int k_ = 0; k_ < 9; ++k_) { const unsigned q_ = (unsigned)ltid + 256u * k_; const unsigned s_ = q_ / 144u, off_ = q_ - s_ * 144u; goff[k_] = s_ * (8u * SREC * 4u) + off_ * 16u; }
            f32x4 sA[9], sB[9], sC[9];
#define SC_GLOAD(ST, c_) do { const char* cbase_ = (const char*)(base + (size_t)(c_) * CH * 8 * SREC); _Pragma("unroll") for (int k_ = 0; k_ < 9; ++k_) ST[k_] = *(const f32x4*)(cbase_ + goff[k_]); } while (0)
#define SC_LSTORE(ST, boff_) do { _Pragma("unroll") for (int k_ = 0; k_ < 9; ++k_) *(LAS f32x4*)(C.lds + (boff_) + (ltid + 256 * k_) * 16) = ST[k_]; } while (0)
            SC_GLOAD(sA, 0); SC_GLOAD(sB, 1); SC_LSTORE(sA, 0); SC_LSTORE(sB, CHB);
            SC_GLOAD(sA, 2); SC_GLOAD(sB, 3); SC_GLOAD(sC, 4);
            asm volatile("s_waitcnt lgkmcnt(0)" ::: "memory"); SC_BAR();
            int b2 = 2 * CHB;
#define SC_LSUB(ST, c_) do { if ((c_) < TP / CH) { if ((c_) + 2 < TP / CH) SC_LSTORE(ST, b2); if ((c_) + 5 < TP / CH) SC_GLOAD(ST, (c_) + 5); \
                b2 = (b2 == 2 * CHB) ? 0 : b2 + CHB; asm volatile("s_waitcnt lgkmcnt(0)" ::: "memory"); SC_BAR(); } } while (0)
            for (int ch = 0; ch < TP / CH; ch += 3) { SC_LSUB(sA, ch); SC_LSUB(sB, ch + 1); SC_LSUB(sC, ch + 2); }
#undef SC_LSUB
#undef SC_GLOAD
#undef SC_LSTORE
        } else {
            SC_BAR();
            f32x2 S01 = (f32x2){0.f, 0.f}, S23 = (f32x2){0.f, 0.f};
            float* yrow = YST + ((size_t)bh * 64 + i) * TP + jl;
#define SC_LD(X, bufb, s_) do { const LAS unsigned char* r_ = C.lds + (bufb) + (s_) * (SREC * 4); \
            X.w = *(const LAS f32x4*)(r_ + lv); X.kk = *(const LAS f32x4*)(r_ + 256 + lv); X.b = *(const LAS f32x4*)(r_ + 512 + lv); \
            X.k = *(const LAS f32x4*)(r_ + 768 + lv); X.wr = *(const LAS f32x4*)(r_ + 1024 + lv); X.tri = *(const LAS f32x4*)(r_ + lt); } while (0)
            ScanVec xa, xb;
            SC_LD(xa, 0, 0);
            int cb = 0, nb = CHB;
            for (int ch = 0; ch < TP / CH; ++ch) {
                float ykeep = 0.f;
#define SC_STEP(XC, XN, s_) do { if ((s_) + 1 < CH) SC_LD(XN, cb, (s_) + 1); else if (ch + 1 < TP / CH) SC_LD(XN, nb, 0); \
                    __builtin_amdgcn_sched_barrier(0); \
                    { const float y_ = scan_step(S01, S23, XC); ykeep = (jl == (s_)) ? y_ : ykeep; asm volatile("" :: "v"(XC.tri[3])); } \
                    __builtin_amdgcn_sched_barrier(0); } while (0)
                SC_STEP(xa, xb, 0); SC_STEP(xb, xa, 1); SC_STEP(xa, xb, 2); SC_STEP(xb, xa, 3);
                SC_STEP(xa, xb, 4); SC_STEP(xb, xa, 5); SC_STEP(xa, xb, 6); SC_STEP(xb, xa, 7);
                SC_STEP(xa, xb, 8); SC_STEP(xb, xa, 9); SC_STEP(xa, xb, 10); SC_STEP(xb, xa, 11);
                SC_STEP(xa, xb, 12); SC_STEP(xb, xa, 13); SC_STEP(xa, xb, 14); SC_STEP(xb, xa, 15);
                yrow[ch * CH] = ykeep;
                cb = nb; nb = (nb == 2 * CHB) ? 0 : nb + CHB;
                SC_BAR();
            }
#undef SC_STEP
#undef SC_LD
            *(f32x4*)(C.out + O_WKVP + ((size_t)bh * 64 + i) * 64 + 4 * jl) = (f32x4){S01[0], S01[1], S23[0], S23[1]};
        }
#undef SC_BAR
        __syncthreads();
    }
}
__device__ __forceinline__ float wave_sum_fast(float x) { x = sum16(x); x += __shfl_xor(x, 16); x += __shfl_xor(x, 32); return x; }
__device__ __forceinline__ void p5_post(const Ctx& C, const void* const* in) {
    const float* YST = (const float*)(C.ws + WS_YS); const float* YSS = YST + (size_t)MP * RW;
    const float* Gb = (const float*)(C.ws + WS_G); const float* BG = (const float*)(C.ws + WS_BG); bf16* MIX = (bf16*)(C.ws + WS_MIX);
    const int c = C.tid, h = C.wave, j = C.lane;
    const float gg = INF(20)[c], gb = INF(21)[c];
    for (int u = C.vcu; u < MT / 16; u += C.G) {
        const int m0 = u * 16;
        float yv[16];
        if (m0 < MP) { const int b = m0 >> 12, t0 = m0 & (TP - 1); const float* yp = YST + ((size_t)(b * 8 + h) * 64 + j) * TP + t0;
#pragma unroll
            for (int q = 0; q < 4; ++q) { const f32x4 v = *(const f32x4*)(yp + 4 * q); yv[4 * q] = v[0]; yv[4 * q + 1] = v[1]; yv[4 * q + 2] = v[2]; yv[4 * q + 3] = v[3]; }
        } else {
#pragma unroll
            for (int t = 0; t < 16; ++t) yv[t] = YSS[(size_t)(m0 - MP + t) * RW + c];
        }
#pragma unroll
        for (int t = 0; t < 16; ++t) {
            const int m = m0 + t; const float y = yv[t];
            const float mu = wave_sum_fast(y) * (1.f / 64.f); const float d = y - mu; const float var = wave_sum_fast(d * d) * (1.f / 64.f);
            const float yn = d * rsqrtf(var + GN_EPS) * gg + gb;
            const float o = yn * Gb[(size_t)m * RW + c] + BG[(size_t)m * RW + c];
            MIX[(size_t)m * DM + c] = (bf16)f2bf(o);
        }
    }
}
__device__ __forceinline__ int t5_bucket(int d) {
    if (d < 16) return d;
    int b = 16;
    b += (d >= 19); b += (d >= 21); b += (d >= 24); b += (d >= 27); b += (d >= 31); b += (d >= 35); b += (d >= 40); b += (d >= 46);
    b += (d >= 52); b += (d >= 59); b += (d >= 67); b += (d >= 77); b += (d >= 87); b += (d >= 99); b += (d >= 113);
    return b;
}
constexpr int KROW = 72, VROW = 68;
constexpr int ATT_KB = 64 * KROW * 2, ATT_VB = 64 * VROW * 2;
__device__ __forceinline__ void attn_prompt_unit(const Ctx& C, int b, int h, int qb, const LAS float* btab) {
    const bf16* QB = (const bf16*)(C.ws + WS_QB); const bf16* KB = (const bf16*)(C.ws + WS_KB); const bf16* VB = (const bf16*)(C.ws + WS_VB);
    const unsigned long long* MASK = (const unsigned long long*)(C.ws + WS_MASK); bf16* MIX = (bf16*)(C.ws + WS_MIX);
    LAS unsigned char* kbuf = C.lds; LAS unsigned char* vbuf = C.lds + 2 * ATT_KB;
    const int lane = C.lane, wave = C.wave, r32 = lane & 31, hi = lane >> 5;
    const int q0 = qb * 256, qw0 = q0 + wave * 32, q = qw0 + r32;
    const size_t rowb = (size_t)b * TP;
    const int NT = (q0 + 256) / 64;
    bf16x8 qf[4];
#pragma unroll
    for (int s = 0; s < 4; ++s) qf[s] = *(const bf16x8*)(QB + (rowb + q) * RW + h * 64 + 16 * s + 8 * hi);
    const unsigned long long* mrow = MASK + (rowb + q) * 64;
    const int srow = C.tid >> 3, sch = C.tid & 7;
    const bf16* kg = KB + (rowb + srow) * RW + h * 64 + sch * 8; const bf16* vg = VB + (rowb + srow) * RW + h * 64 + sch * 8;
    v4u kst, vst;
#define ATT_GLOAD(t) do { kst = *(const v4u*)(kg + (size_t)(t) * 64 * RW); vst = *(const v4u*)(vg + (size_t)(t) * 64 * RW); } while (0)
#define ATT_LSTORE(bi) do { *(LAS v4u*)(kbuf + (bi) * ATT_KB + srow * (KROW * 2) + sch * 16) = kst; \
        LAS unsigned short* vt_ = (LAS unsigned short*)(vbuf + (bi) * ATT_VB) + (sch * 8) * VROW + srow; \
        vt_[0 * VROW] = (unsigned short)(vst.x & 0xffffu); vt_[1 * VROW] = (unsigned short)(vst.x >> 16); vt_[2 * VROW] = (unsigned short)(vst.y & 0xffffu); vt_[3 * VROW] = (unsigned short)(vst.y >> 16); \
        vt_[4 * VROW] = (unsigned short)(vst.z & 0xffffu); vt_[5 * VROW] = (unsigned short)(vst.z >> 16); vt_[6 * VROW] = (unsigned short)(vst.w & 0xffffu); vt_[7 * VROW] = (unsigned short)(vst.w >> 16); } while (0)
    __syncthreads();
    ATT_GLOAD(0); ATT_LSTORE(0);
    __syncthreads();
    f32x16 o0, o1;
#pragma unroll
    for (int r = 0; r < 16; ++r) { o0[r] = 0.f; o1[r] = 0.f; }
    float mrun = -1e30f, lrun = 0.f;
    unsigned long long mw = mrow[0];
    for (int t = 0; t < NT; ++t) {
        const int bi = t & 1;
        if (t + 1 < NT) ATT_GLOAD(t + 1);
        const unsigned long long mcur = mw; if (t + 1 < NT) mw = mrow[t + 1];
        const int kv0 = t * 64;
        if (kv0 <= qw0 + 31) {
            f32x16 p0, p1;
#pragma unroll
            for (int r = 0; r < 16; ++r) { p0[r] = 0.f; p1[r] = 0.f; }
            const LAS unsigned char* kb0 = kbuf + bi * ATT_KB + r32 * (KROW * 2) + hi * 16;
#pragma unroll
            for (int s = 0; s < 4; ++s) {
                const bf16x8 ka = *(const LAS bf16x8*)(kb0 + s * 32), kb2 = *(const LAS bf16x8*)(kb0 + 32 * (KROW * 2) + s * 32);
                p0 = __builtin_amdgcn_mfma_f32_32x32x16_bf16(ka, qf[s], p0, 0, 0, 0);
                p1 = __builtin_amdgcn_mfma_f32_32x32x16_bf16(kb2, qf[s], p1, 0, 0, 0);
            }
            if (kv0 + 63 + 113 > qw0) {
#pragma unroll
                for (int r = 0; r < 16; ++r) { const int kv = kv0 + (r & 3) + 8 * (r >> 2) + 4 * hi;
                    int d0 = q - kv; d0 = d0 < 0 ? 0 : (d0 > 127 ? 127 : d0); int d1 = q - kv - 32; d1 = d1 < 0 ? 0 : (d1 > 127 ? 127 : d1);
                    p0[r] += btab[h * 128 + d0]; p1[r] += btab[h * 128 + d1]; }
            }
            float mx = p0[0];
#pragma unroll
            for (int r = 1; r < 16; ++r) mx = fmaxf(mx, p0[r]);
#pragma unroll
            for (int r = 0; r < 16; ++r) mx = fmaxf(mx, p1[r]);
            mx = fmaxf(mx, __shfl_xor(mx, 32));
            const float mnew = fmaxf(mrun, mx);
            const float alpha = __builtin_amdgcn_exp2f(mrun - mnew);
            mrun = mnew;
            const unsigned wlo = (unsigned)mcur >> (4 * hi), whi = (unsigned)(mcur >> 32) >> (4 * hi);
            float ls = 0.f;
#pragma unroll
            for (int r = 0; r < 16; ++r) { const int pos = (r & 3) + 8 * (r >> 2);
                const int m0 = __builtin_amdgcn_sbfe(wlo, pos, 1), m1 = __builtin_amdgcn_sbfe(whi, pos, 1);
                const float e0 = __builtin_amdgcn_exp2f(p0[r] - mnew), e1 = __builtin_amdgcn_exp2f(p1[r] - mnew);
                p0[r] = __builtin_bit_cast(float, __builtin_bit_cast(int, e0) & m0); p1[r] = __builtin_bit_cast(float, __builtin_bit_cast(int, e1) & m1);
                ls += p0[r] + p1[r]; }
            lrun = lrun * alpha + ls;
            if (__any(alpha != 1.f)) {
#pragma unroll
                for (int r = 0; r < 16; ++r) { o0[r] *= alpha; o1[r] *= alpha; }
            }
            const LAS unsigned char* vb0 = vbuf + bi * ATT_VB + r32 * (VROW * 2) + hi * 8;
#pragma unroll
            for (int jj = 0; jj < 4; ++jj) {
                f32x4 pa, pb;
                if (jj == 0) { pa = (f32x4){p0[0], p0[1], p0[2], p0[3]}; pb = (f32x4){p0[4], p0[5], p0[6], p0[7]}; }
                else if (jj == 1) { pa = (f32x4){p0[8], p0[9], p0[10], p0[11]}; pb = (f32x4){p0[12], p0[13], p0[14], p0[15]}; }
                else if (jj == 2) { pa = (f32x4){p1[0], p1[1], p1[2], p1[3]}; pb = (f32x4){p1[4], p1[5], p1[6], p1[7]}; }
                else { pa = (f32x4){p1[8], p1[9], p1[10], p1[11]}; pb = (f32x4){p1[12], p1[13], p1[14], p1[15]}; }
                const bf16x8 pf = pack_bf8(pa, pb);
                typedef unsigned u32x2 __attribute__((ext_vector_type(2)));
                const u32x2 a0 = *(const LAS u32x2*)(vb0 + jj * 32), a1 = *(const LAS u32x2*)(vb0 + jj * 32 + 16);
                const u32x2 c0 = *(const LAS u32x2*)(vb0 + 32 * (VROW * 2) + jj * 32), c1 = *(const LAS u32x2*)(vb0 + 32 * (VROW * 2) + jj * 32 + 16);
                const bf16x8 va = __builtin_bit_cast(bf16x8, (v4u){a0.x, a0.y, a1.x, a1.y}), vc = __builtin_bit_cast(bf16x8, (v4u){c0.x, c0.y, c1.x, c1.y});
                o0 = __builtin_amdgcn_mfma_f32_32x32x16_bf16(va, pf, o0, 0, 0, 0);
                o1 = __builtin_amdgcn_mfma_f32_32x32x16_bf16(vc, pf, o1, 0, 0, 0);
            }
        }
        if (t + 1 < NT) ATT_LSTORE(bi ^ 1);
        __syncthreads();
    }
#undef ATT_GLOAD
#undef ATT_LSTORE
    const float ltot = lrun + __shfl_xor(lrun, 32);
    const float inv = 1.f / ltot;
    bf16* orow = MIX + (rowb + q) * DM + RW + h * 64;
#pragma unroll
    for (int g = 0; g < 4; ++g) {
        const int d = 8 * g + 4 * hi;
        typedef unsigned u32x2 __attribute__((ext_vector_type(2)));
        u32x2 w0, w1;
        w0.x = pk2(o0[4 * g] * inv, o0[4 * g + 1] * inv); w0.y = pk2(o0[4 * g + 2] * inv, o0[4 * g + 3] * inv);
        w1.x = pk2(o1[4 * g] * inv, o1[4 * g + 1] * inv); w1.y = pk2(o1[4 * g + 2] * inv, o1[4 * g + 3] * inv);
        *(u32x2*)(orow + d) = w0; *(u32x2*)(orow + 32 + d) = w1;
    }
}
__device__ __forceinline__ void attn_sample_pair(const Ctx& C, const void* const* in, int pair, const LAS float* btab, LAS float* comb) {
    const bf16* QB = (const bf16*)(C.ws + WS_QB); const int* SEL = (const int*)(C.ws + WS_SEL); bf16* MIX = (bf16*)(C.ws + WS_MIX);
    const int lane = C.lane, hh = lane >> 3, ch = lane & 7, wq = C.wave >> 2, part = C.wave & 3;
    const int qi_ = pair * 2 + wq, b = qi_ >> 2, t = qi_ & 3, m = MP + qi_, qpos = PAST + t;
    float qv[8];
    { const v4u qq = *(const v4u*)(QB + (size_t)m * RW + hh * 64 + ch * 8);
      qv[0] = bf2f(qq.x & 0xffffu); qv[1] = bf2f(qq.x >> 16); qv[2] = bf2f(qq.y & 0xffffu); qv[3] = bf2f(qq.y >> 16);
      qv[4] = bf2f(qq.z & 0xffffu); qv[5] = bf2f(qq.z >> 16); qv[6] = bf2f(qq.w & 0xffffu); qv[7] = bf2f(qq.w >> 16); }
    const int* pt = (const int*)in[5] + b * NPAGES;
    const int* sel = SEL + (size_t)qi_ * 256 + part * 64;
    const float* ck = INF(2); const float* cv = INF(3);
    float acc[8] = {0.f, 0.f, 0.f, 0.f, 0.f, 0.f, 0.f, 0.f}; float mrun = -1e30f, lrun = 0.f;
    for (int j0 = 0; j0 < 64; j0 += 8) {
        f32x4 k0[8], k1[8], v0[8], v1[8]; float bias[8];
#pragma unroll
        for (int u = 0; u < 8; ++u) {
            const int s = sel[j0 + u];
            const float *kr, *vr;
            if (s < PAST) { const size_t row = (size_t)pt[s >> 7] * 128 + (s & 127); kr = ck + row * RW; vr = cv + row * RW; }
            else { const size_t row = (size_t)(b * 4 + (s - PAST)); kr = C.out + O_KS + row * RW; vr = C.out + O_VS + row * RW; }
            kr += hh * 64 + ch * 8; vr += hh * 64 + ch * 8;
            k0[u] = *(const f32x4*)kr; k1[u] = *(const f32x4*)(kr + 4); v0[u] = *(const f32x4*)vr; v1[u] = *(const f32x4*)(vr + 4);
            int d = qpos - s; d = d < 0 ? 0 : (d > 127 ? 127 : d); bias[u] = btab[1024 + hh * 128 + d];
        }
#pragma unroll
        for (int u = 0; u < 8; ++u) {
            float p = qv[0] * k0[u][0] + qv[1] * k0[u][1] + qv[2] * k0[u][2] + qv[3] * k0[u][3] + qv[4] * k1[u][0] + qv[5] * k1[u][1] + qv[6] * k1[u][2] + qv[7] * k1[u][3];
            p = sum8(p) + bias[u];
            const float mnew = fmaxf(mrun, p); const float alpha = __builtin_amdgcn_exp2f(mrun - mnew), e = __builtin_amdgcn_exp2f(p - mnew);
            mrun = mnew; lrun = lrun * alpha + e;
            acc[0] = acc[0] * alpha + e * v0[u][0]; acc[1] = acc[1] * alpha + e * v0[u][1]; acc[2] = acc[2] * alpha + e * v0[u][2]; acc[3] = acc[3] * alpha + e * v0[u][3];
            acc[4] = acc[4] * alpha + e * v1[u][0]; acc[5] = acc[5] * alpha + e * v1[u][1]; acc[6] = acc[6] * alpha + e * v1[u][2]; acc[7] = acc[7] * alpha + e * v1[u][3];
        }
    }
    LAS float* cw = comb + ((wq * 4 + part) * 64 + lane) * 12;
    *(LAS f32x4*)cw = (f32x4){acc[0], acc[1], acc[2], acc[3]}; *(LAS f32x4*)(cw + 4) = (f32x4){acc[4], acc[5], acc[6], acc[7]}; *(LAS f32x2*)(cw + 8) = (f32x2){mrun, lrun};
    __syncthreads();
    if (part == 0) {
        float M = mrun;
#pragma unroll
        for (int p = 1; p < 4; ++p) M = fmaxf(M, comb[((wq * 4 + p) * 64 + lane) * 12 + 8]);
        float f = __builtin_amdgcn_exp2f(mrun - M), L = lrun * f;
#pragma unroll
        for (int e = 0; e < 8; ++e) acc[e] *= f;
#pragma unroll
        for (int p = 1; p < 4; ++p) { const LAS float* cp = comb + ((wq * 4 + p) * 64 + lane) * 12; const f32x4 a0 = *(const LAS f32x4*)cp, a1 = *(const LAS f32x4*)(cp + 4); const f32x2 ml = *(const LAS f32x2*)(cp + 8);
            const float fp = __builtin_amdgcn_exp2f(ml[0] - M); L += ml[1] * fp;
            acc[0] += a0[0] * fp; acc[1] += a0[1] * fp; acc[2] += a0[2] * fp; acc[3] += a0[3] * fp; acc[4] += a1[0] * fp; acc[5] += a1[1] * fp; acc[6] += a1[2] * fp; acc[7] += a1[3] * fp; }
        const float inv = 1.f / L;
        v4u w; w.x = pk2(acc[0] * inv, acc[1] * inv); w.y = pk2(acc[2] * inv, acc[3] * inv); w.z = pk2(acc[4] * inv, acc[5] * inv); w.w = pk2(acc[6] * inv, acc[7] * inv);
        *(v4u*)(MIX + (size_t)m * DM + RW + hh * 64 + ch * 8) = w;
    }
    __syncthreads();
}
__device__ __forceinline__ void p5_attn(const Ctx& C, const void* const* in, int rep_s, int rep_p) {
    LAS float* btab = (LAS float*)(C.lds + 2 * ATT_KB + 2 * ATT_VB);
    const float* rb = INF(9);
    for (int i = C.tid; i < 1024; i += NTHR) { const int hh = i >> 7, d = i & 127; const float bv = rb[t5_bucket(d) * 8 + hh];
        btab[i] = (bv - rb[31 * 8 + hh]) * LOG2E; btab[1024 + i] = bv * LOG2E; }
    __syncthreads();
    for (int rr = 0; rr < rep_s; ++rr) for (int pr = C.vcu; pr < MS / 2; pr += C.G) attn_sample_pair(C, in, pr, btab, btab + 2048);
    for (int rr = 0; rr < rep_p; ++rr) for (int u = C.vcu; u < 512; u += C.G) {
        const int bh = (u & 255) >> 3, s = u & 7, qb = (u < 256) ? s : 15 - s;
        attn_prompt_unit(C, bh >> 3, bh & 7, qb, btab);
    }
}

__device__ __forceinline__ void ln_rows(const Ctx& C, const float* Z, const float* g, const float* bt, float* outP, float* outS, bf16* ob) {
    const int gw = C.vcu * NWAVES + C.wave, NGW = C.G * NWAVES;
    f32x4 gv[4], bv[4];
#pragma unroll
    for (int j = 0; j < 4; ++j) { gv[j] = *((const f32x4*)g + C.lane + 64 * j); bv[j] = *((const f32x4*)bt + C.lane + 64 * j); }
    for (int m = gw; m < MT; m += NGW) {
        const f32x4* zr = (const f32x4*)(Z + (size_t)m * DM) + C.lane;
        f32x4 v[4]; float s = 0.f;
#pragma unroll
        for (int j = 0; j < 4; ++j) { v[j] = zr[64 * j]; s += (v[j].x + v[j].y) + (v[j].z + v[j].w); }
        const float mean = wave_sum(s) * (1.f / DM); float s2 = 0.f;
#pragma unroll
        for (int j = 0; j < 4; ++j) { v[j] = v[j] - mean; s2 += (v[j].x * v[j].x + v[j].y * v[j].y) + (v[j].z * v[j].z + v[j].w * v[j].w); }
        const float rstd = rsqrtf(wave_sum(s2) * (1.f / DM) + LN_EPS);
        float* orow = (m < MP) ? outP + (size_t)m * DM : outS + (size_t)(m - MP) * DM;
#pragma unroll
        for (int j = 0; j < 4; ++j) { const f32x4 o = v[j] * rstd * gv[j] + bv[j]; *((f32x4*)orow + C.lane + 64 * j) = o;
            if (ob) *((unsigned long long*)(ob + (size_t)m * DM) + C.lane + 64 * j) = (unsigned long long)pk2(o.x, o.y) | ((unsigned long long)pk2(o.z, o.w) << 32); }
    }
}

__device__ __forceinline__ void p9_conv(const Ctx& C, const void* const* in) {
    const bf16* UC = (const bf16*)(C.ws + WS_UC); const bf16* UL = (const bf16*)(C.ws + WS_UL); bf16* H = (bf16*)(C.ws + WS_H);
    const float* cw = INF(26); const float* cb = INF(27); const float* cst = INF(8);
    constexpr int CPR = FF / 8;
    const long total = (long)MT * CPR;
    for (long it = (long)C.vcu * NTHR + C.tid; it < total; it += (long)C.G * NTHR) {
        const int m = (int)(it / CPR), c = (int)(it - (long)m * CPR) * 8;
        int t; const float* prev = nullptr;
        if (m < MP) t = m & (TP - 1); else { const int ms = m - MP; t = ms & 3; prev = cst + (size_t)(ms >> 2) * 2 * FF; }
        float u0[8], u1[8], u2[8], ul[8];
        { const v4u a = *(const v4u*)(UC + (size_t)m * FF + c); const v4u l = *(const v4u*)(UL + (size_t)m * FF + c);
          u2[0] = bf2f(a.x & 0xffffu); u2[1] = bf2f(a.x >> 16); u2[2] = bf2f(a.y & 0xffffu); u2[3] = bf2f(a.y >> 16); u2[4] = bf2f(a.z & 0xffffu); u2[5] = bf2f(a.z >> 16); u2[6] = bf2f(a.w & 0xffffu); u2[7] = bf2f(a.w >> 16);
          ul[0] = bf2f(l.x & 0xffffu); ul[1] = bf2f(l.x >> 16); ul[2] = bf2f(l.y & 0xffffu); ul[3] = bf2f(l.y >> 16); ul[4] = bf2f(l.z & 0xffffu); ul[5] = bf2f(l.z >> 16); ul[6] = bf2f(l.w & 0xffffu); ul[7] = bf2f(l.w >> 16); }
        if (t >= 1) { const v4u a = *(const v4u*)(UC + (size_t)(m - 1) * FF + c);
          u1[0] = bf2f(a.x & 0xffffu); u1[1] = bf2f(a.x >> 16); u1[2] = bf2f(a.y & 0xffffu); u1[3] = bf2f(a.y >> 16); u1[4] = bf2f(a.z & 0xffffu); u1[5] = bf2f(a.z >> 16); u1[6] = bf2f(a.w & 0xffffu); u1[7] = bf2f(a.w >> 16); }
        else { for (int e = 0; e < 8; ++e) u1[e] = prev ? prev[FF + c + e] : 0.f; }
        if (t >= 2) { const v4u a = *(const v4u*)(UC + (size_t)(m - 2) * FF + c);
          u0[0] = bf2f(a.x & 0xffffu); u0[1] = bf2f(a.x >> 16); u0[2] = bf2f(a.y & 0xffffu); u0[3] = bf2f(a.y >> 16); u0[4] = bf2f(a.z & 0xffffu); u0[5] = bf2f(a.z >> 16); u0[6] = bf2f(a.w & 0xffffu); u0[7] = bf2f(a.w >> 16); }
        else { for (int e = 0; e < 8; ++e) u0[e] = prev ? prev[t * FF + c + e] : 0.f; }
        float hv[8];
#pragma unroll
        for (int e = 0; e < 8; ++e) { const float cv = u0[e] * cw[c + e] + u1[e] * cw[FF + c + e] + u2[e] * cw[2 * FF + c + e] + cb[c + e];
            hv[e] = cv / (1.f + __expf(-cv)) * ul[e]; }
        v4u w; w.x = pk2(hv[0], hv[1]); w.y = pk2(hv[2], hv[3]); w.z = pk2(hv[4], hv[5]); w.w = pk2(hv[6], hv[7]);
        *(v4u*)(H + (size_t)m * FF + c) = w;
    }
}

#ifndef PROBE_PHASE
#define PROBE_PHASE -1
#endif
struct Args { const void* in[31]; float* out; unsigned char* ws; int ph_lo, ph_hi; };
__global__ void __launch_bounds__(NTHR, 2) fwd_kernel(Args args) {
    extern __shared__ __attribute__((aligned(16))) unsigned char lds_raw[];
    Ctx C;
    C.lds = (LAS unsigned char*)lds_raw; C.tid = threadIdx.x; C.lane = C.tid & 63; C.wave = __builtin_amdgcn_readfirstlane(C.tid >> 6);
    C.G = gridDim.x; { const int bx = blockIdx.x; C.vcu = (C.G % 8 == 0) ? (bx % 8) * (C.G / 8) + bx / 8 : bx; }
    C.out = args.out; C.ws = args.ws;
    const void* const* in = args.in;
    volatile LAS unsigned* MISC = (volatile LAS unsigned*)(C.lds + MISC_OFF);
    for (int u = C.tid; u < (LDS_BYTES - LDSCTL_OFF) / 4; u += NTHR) ((LAS unsigned*)(C.lds + LDSCTL_OFF))[u] = 0u;
    __syncthreads();
    const int lo = args.ph_lo, hi = args.ph_hi;
    const bool multi = (hi - lo) > 1;
    XcdBarrier bar; bar.bar = (unsigned*)(C.ws + WS_CTL) + CW_BAR; bar.x = 0; bar.st = nullptr;
    if (multi) bar = xcd_barrier_post((unsigned*)(C.ws + WS_CTL) + CW_BAR, MISC + 8);
#define IN(k) (lo <= (k) && (k) < hi)
#define SEAM(k) do { if (IN(k) && IN((k) + 1)) xcd_barrier(bar); } while (0)
    bf16* XB = (bf16*)(C.ws + WS_XB); bf16* MIX = (bf16*)(C.ws + WS_MIX); bf16* X1B = (bf16*)(C.ws + WS_X1B); bf16* HB = (bf16*)(C.ws + WS_H);
    float* Z = (float*)(C.ws + WS_Z); float* X1 = (float*)(C.ws + WS_X1);

#define RUN0 do { p0_prologue(C, in); } while (0)
#define RUN1 do { pg8::Gemm g{XB, (const bf16*)(C.ws + WS_WIN), MT, NINP, DM}; pg8::StaticOrder S; S.init(MT, NINP, C.G, (int)blockIdx.x); \
        pg8::EpiIn E{(float*)(C.ws + WS_PRW), (bf16*)(C.ws + WS_QB), (bf16*)(C.ws + WS_KB), (bf16*)(C.ws + WS_VB), (float*)(C.ws + WS_QI), (float*)(C.ws + WS_WI), C.out}; \
        pg8::gemm_phase<pg8::EpiIn, pg8::StaticOrder, true, true>(C.lds, g, S, E); } while (0)
#define RUN2 do { p2_prep(C, in); } while (0)
#define RUN3 do { p4_scan(C, in); p3_topk(C, in); } while (0)
#define RUN4 do { } while (0)
#define RUN5 do { p5_post(C, in); if (PROBE_PHASE == 50) { __syncthreads(); p5_post(C, in); } p5_attn(C, in, PROBE_PHASE == 51 ? 2 : 1, PROBE_PHASE == 52 ? 2 : 1); } while (0)
#define RUN6 do { pg8::Gemm g{MIX, (const bf16*)(C.ws + WS_WOUT), MT, DM, DM}; pg8::StaticOrder S; S.init(MT, DM, C.G, (int)blockIdx.x); \
        pg8::EpiRes E{INF(0), INF(1), Z}; pg8::gemm_phase<pg8::EpiRes, pg8::StaticOrder, true, true>(C.lds, g, S, E); } while (0)
#define RUN7 do { ln_rows(C, Z, INF(23), INF(24), X1, X1 + (size_t)MP * DM, X1B); } while (0)
#define RUN8 do { pg8::Gemm g{X1B, (const bf16*)(C.ws + WS_WUP), MT, NUP, DM}; pg8::StaticOrder S; S.init(MT, NUP, C.G, (int)blockIdx.x); \
        pg8::EpiUp E{(bf16*)(C.ws + WS_UC), (bf16*)(C.ws + WS_UL), C.out}; pg8::gemm_phase<pg8::EpiUp, pg8::StaticOrder, true, true>(C.lds, g, S, E); } while (0)
#define RUN9 do { p9_conv(C, in); } while (0)
#define RUN10 do { pg8::Gemm g{HB, (const bf16*)(C.ws + WS_WDN), MT, DM, FF}; pg8::StaticOrder S; S.init(MT, DM, C.G, (int)blockIdx.x); \
        pg8::EpiRes E{X1, X1 + (size_t)MP * DM, Z}; pg8::gemm_phase<pg8::EpiRes, pg8::StaticOrder, true, true>(C.lds, g, S, E); } while (0)
#define RUN11 do { ln_rows(C, Z, INF(29), INF(30), C.out + O_YP, C.out + O_YS, nullptr); } while (0)
#define PHASE(k, RUN) do { if (IN(k)) { RUN; if (PROBE_PHASE == (k)) { __syncthreads(); xcd_barrier(bar); RUN; } } SEAM(k); } while (0)
    PHASE(0, RUN0); PHASE(1, RUN1); PHASE(2, RUN2); PHASE(3, RUN3); PHASE(4, RUN4); PHASE(5, RUN5);
    PHASE(6, RUN6); PHASE(7, RUN7); PHASE(8, RUN8); PHASE(9, RUN9); PHASE(10, RUN10); PHASE(11, RUN11);
#undef IN
#undef SEAM
}

#ifndef N_LAUNCH_MODE
#define N_LAUNCH_MODE 1
#endif
extern "C" void kernel_launch(void* const* d_in, const int* in_sizes, int n_in, void* d_out, int out_size, void* d_ws, size_t ws_size, hipStream_t stream) {
    static int grid = 0;
    if (grid == 0) {
        if (n_in != 31 || out_size != (int)O_END || ws_size < WS_END) { fprintf(stderr, "kernel_launch: unexpected shapes (n_in %d, out %d, ws %zu)\n", n_in, out_size, ws_size); grid = -1; return; }
        int dev = 0, cus = 0, per_cu = 0;
        if (hipGetDevice(&dev) != hipSuccess || hipDeviceGetAttribute(&cus, hipDeviceAttributeMultiprocessorCount, dev) != hipSuccess) { grid = -1; return; }
        if (hipFuncSetAttribute((const void*)fwd_kernel, hipFuncAttributeMaxDynamicSharedMemorySize, LDS_BYTES) != hipSuccess) { fprintf(stderr, "kernel_launch: hipFuncSetAttribute failed\n"); grid = -1; return; }
        if (hipOccupancyMaxActiveBlocksPerMultiprocessor(&per_cu, (const void*)fwd_kernel, NTHR, LDS_BYTES) != hipSuccess || per_cu < 1) fprintf(stderr, "kernel_launch: occupancy query says %d\n", per_cu);
        (void)hipGetLastError();
        grid = cus;
    }
    if (grid < 0) return;
    (void)hipMemsetAsync((char*)d_ws + WS_CTL, 0, CTL_ZERO_BYTES, stream);
    Args a{};
    for (int i = 0; i < 31; ++i) a.in[i] = d_in[i];
    a.out = (float*)d_out; a.ws = (unsigned char*)d_ws;
#if N_LAUNCH_MODE == 1
    a.ph_lo = 0; a.ph_hi = NPHASE;
    hipLaunchKernelGGL(fwd_kernel, dim3(grid), dim3(NTHR), LDS_BYTES, stream, a);
#else
    for (int p = 0; p < NPHASE; ++p) { a.ph_lo = p; a.ph_hi = p + 1; hipLaunchKernelGGL(fwd_kernel, dim3(grid), dim3(NTHR), LDS_BYTES, stream, a); }
#endif
    const hipError_t le = hipPeekAtLastError();
    if (le != hipSuccess) fprintf(stderr, "kernel_launch: launch failed: %s\n", hipGetErrorName(le));
}
```
